# Optimizing an MI355X kernel written in HIP

```python
import math
import jax, jax.numpy as jnp
from jax import lax
import numpy as np

D_MODEL = 2048
BATCH = 4
SEQ = 8192
DEPTH = 4
DEC_BATCH = 8
DEC_SEQ = 64
PAST_LEN = 4096

CHUNK = 64
N_MIXERS = 2
N_MLA = (DEPTH + 1) // 2
N_SSM = DEPTH // 2
N_HEADS = 16
QK_NOPE = 128
QK_ROPE = 64
QK_HEAD = QK_NOPE + QK_ROPE
V_HEAD = 128
Q_LORA = 512
KV_LORA = 256
ROPE_THETA = 10000.0
Q_BLOCK = 128
SSM_GROUP = 16
N_GROUPS = D_MODEL // SSM_GROUP
SSM_STATE = 64
SSM_BLOCK = CHUNK
DT_MIN = 0.001
DT_MAX = 0.1
D_FF = 5632
CONV_W = 3
EPS = 1e-6

kernel_name = 'hybrid_mla_s5_convffn_stream_step'


def rms_norm(x, g):
    xf = x.astype(jnp.float32)
    y = xf * lax.rsqrt(jnp.mean(xf * xf, axis=-1, keepdims=True) + EPS)
    return (y * g.astype(jnp.float32)).astype(x.dtype)


def modulate(x, shift, scale):
    return x * (1 + scale[:, None, :]) + shift[:, None, :]


def rope(x, pos):
    half = QK_ROPE // 2
    inv = ROPE_THETA ** (-jnp.arange(half, dtype=jnp.float32) / half)
    ang = pos.astype(jnp.float32)[:, None] * inv[None, :]
    cos = jnp.cos(ang)[None, :, None, :]
    sin = jnp.sin(ang)[None, :, None, :]
    xf = x.astype(jnp.float32)
    x1, x2 = xf[..., :half], xf[..., half:]
    return jnp.concatenate([x1 * cos - x2 * sin, x1 * sin + x2 * cos], axis=-1).astype(x.dtype)


def chunk_causal_attention(q, k, v, q_pos, k_pos):
    scale = QK_HEAD ** -0.5
    k_chunk = k_pos // CHUNK

    def block(args):
        qb, pb = args
        s = jnp.einsum('bqhe,bkhe->bhqk', qb, k, preferred_element_type=jnp.float32) * scale
        allowed = k_chunk[None, :] <= (pb // CHUNK)[:, None]
        s = jnp.where(allowed[None, None], s, -jnp.inf)
        p = jax.nn.softmax(s, axis=-1).astype(v.dtype)
        return jnp.einsum('bhqk,bkhd->bqhd', p, v)

    B, Lq = q.shape[:2]
    if Lq <= Q_BLOCK:
        return block((q, q_pos))
    nb = Lq // Q_BLOCK
    qb = q.reshape(B, nb, Q_BLOCK, N_HEADS, QK_HEAD).transpose(1, 0, 2, 3, 4)
    pb = q_pos.reshape(nb, Q_BLOCK)
    o = lax.map(block, (qb, pb))
    return o.transpose(1, 0, 2, 3, 4).reshape(B, Lq, N_HEADS, V_HEAD)


def mla_keys_values(ckv, krope, w_ukv, g_kn, pos):
    B, L, _ = ckv.shape
    kv = (ckv @ w_ukv).reshape(B, L, N_HEADS, QK_NOPE + V_HEAD)
    k_nope, v = kv[..., :QK_NOPE], kv[..., QK_NOPE:]
    k_rope = jnp.broadcast_to(krope[:, :, None, :], (B, L, N_HEADS, QK_ROPE)).astype(k_nope.dtype)
    k = rms_norm(jnp.concatenate([k_nope, k_rope], axis=-1), g_kn)
    k = jnp.concatenate([k[..., :QK_NOPE], rope(k[..., QK_NOPE:], pos)], axis=-1)
    return k, v


def mla_mixer(h, past, i, prm):
    B, L, _ = h.shape
    P = 0 if past is None else past[0].shape[1]
    q_pos = P + jnp.arange(L, dtype=jnp.int32)
    q = rms_norm(h @ prm['mla_w_dq'][i], prm['mla_g_qa'][i]) @ prm['mla_w_uq'][i]
    q = rms_norm(q.reshape(B, L, N_HEADS, QK_HEAD), prm['mla_g_qn'][i])
    q = jnp.concatenate([q[..., :QK_NOPE], rope(q[..., QK_NOPE:], q_pos)], axis=-1)
    kv_a = h @ prm['mla_w_dkv'][i]
    ckv = rms_norm(kv_a[..., :KV_LORA], prm['mla_g_kva'][i])
    krope = kv_a[..., KV_LORA:]
    if past is None:
        ckv_all, krope_all = ckv, krope
    else:
        ckv_all = jnp.concatenate([past[0].astype(ckv.dtype), ckv], axis=1)
        krope_all = jnp.concatenate([past[1].astype(krope.dtype), krope], axis=1)
    k_pos = jnp.arange(P + L, dtype=jnp.int32)
    k, v = mla_keys_values(ckv_all, krope_all, prm['mla_w_ukv'][i], prm['mla_g_kn'][i], k_pos)
    o = chunk_causal_attention(q, k, v, q_pos, k_pos)
    out = o.reshape(B, L, N_HEADS * V_HEAD) @ prm['mla_w_o'][i]
    return out, ckv, krope


def linear_combine(left, right):
    a1, b1 = left
    a2, b2 = right
    return a1 * a2, a2 * b1 + b2


def s5_scan(u, h0, A_bar, B_bar, C):
    Bsz, L = u.shape[:2]
    blk = math.gcd(L, SSM_BLOCK)
    nb = L // blk
    ub = u.reshape(Bsz, nb, blk, N_GROUPS, SSM_GROUP).transpose(1, 0, 2, 3, 4)
    a = jnp.broadcast_to(A_bar[None, None], (1, blk, N_GROUPS, SSM_STATE))

    def step(h, u_blk):
        bu = jnp.einsum('blgp,gnp->blgn', u_blk.astype(jnp.complex64), B_bar)
        a_cum, x = lax.associative_scan(linear_combine, (a, bu), axis=1)
        x = x + a_cum * h[:, None]
        y = jnp.einsum('blgn,gpn->blgp', x, C).real
        return x[:, -1], y

    h_last, y = lax.scan(step, h0, ub)
    y = y.transpose(1, 0, 2, 3, 4).reshape(Bsz, L, N_GROUPS * SSM_GROUP)
    return y, h_last


def s5_mixer(h, past, i, prm):
    B, L, _ = h.shape
    A = lax.complex(prm['s5_a_re'][i].astype(jnp.float32), prm['s5_a_im'][i].astype(jnp.float32))
    dt = jnp.exp(prm['s5_log_dt'][i].astype(jnp.float32))[:, None]
    A_bar = jnp.exp(A * dt)
    Bc = lax.complex(prm['s5_b_re'][i].astype(jnp.float32), prm['s5_b_im'][i].astype(jnp.float32))
    B_bar = ((A_bar - 1) / A)[..., None] * Bc
    C = lax.complex(prm['s5_c_re'][i].astype(jnp.float32), prm['s5_c_im'][i].astype(jnp.float32))
    if past is None:
        h0 = jnp.zeros((B, N_GROUPS, SSM_STATE), jnp.complex64)
    else:
        h0 = lax.complex(past[0].astype(jnp.float32), past[1].astype(jnp.float32))
    u = h.astype(jnp.float32)
    y, h_last = s5_scan(u.reshape(B, L, N_GROUPS, SSM_GROUP), h0, A_bar, B_bar, C)
    y = y + prm['s5_d'][i].astype(jnp.float32) * u
    z = jax.nn.gelu(y).astype(h.dtype)
    out = (z @ prm['s5_w_glu'][i]) * jax.nn.sigmoid(z @ prm['s5_w_gate'][i])
    return out, h_last.real.astype(h.dtype), h_last.imag.astype(h.dtype)


def conv_ffn(h, past, l, prm):
    B, L, _ = h.shape
    g = h @ prm['ffn_w_gate'][l]
    if past is None:
        past = jnp.zeros((B, CONV_W - 1, D_FF), g.dtype)
    gp = jnp.concatenate([past.astype(g.dtype), g], axis=1)
    w = prm['ffn_conv_w'][l]
    gc = prm['ffn_conv_b'][l] + w[0] * gp[:, 0:L]
    for k in range(1, CONV_W):
        gc = gc + w[k] * gp[:, k:k + L]
    out = (jax.nn.silu(gc) * (h @ prm['ffn_w_up'][l])) @ prm['ffn_w_down'][l]
    return out, gp[:, L:]


def run_layer(l, x, c, mix_past, conv_past, prm):
    mod = jax.nn.silu(c) @ prm['w_mod'][l] + prm['b_mod'][l]
    sh_m, sc_m, gt_m, sh_f, sc_f, gt_f = jnp.split(mod, 6, axis=-1)
    h = modulate(rms_norm(x, prm['g_norm_mix'][l]), sh_m, sc_m)
    i = l // N_MIXERS
    if l % N_MIXERS == 0:
        out, s1, s2 = mla_mixer(h, mix_past, i, prm)
    else:
        out, s1, s2 = s5_mixer(h, mix_past, i, prm)
    x = x + gt_m[:, None, :] * out
    h = modulate(rms_norm(x, prm['g_norm_ffn'][l]), sh_f, sc_f)
    out, conv_new = conv_ffn(h, conv_past, l, prm)
    x = x + gt_f[:, None, :] * out
    return x, s1, s2, conv_new


def setup_inputs(seed: int = 0) -> dict:
    key = jax.random.key(seed)
    ks = iter(jax.random.split(key, 48))

    def nrm(shape, scale):
        return jax.random.normal(next(ks), shape, jnp.float32) * scale

    def gain(shape):
        return 1.0 + nrm(shape, 0.02)

    n_idx = jnp.arange(SSM_STATE, dtype=jnp.float32)
    inp = {}
    inp['x_prompt'] = nrm((BATCH, SEQ, D_MODEL), 1.0)
    inp['x_sample'] = nrm((DEC_BATCH, DEC_SEQ, D_MODEL), 1.0)
    inp['cache_mla_ckv'] = nrm((N_MLA, DEC_BATCH, PAST_LEN, KV_LORA), 1.0)
    inp['cache_mla_krope'] = nrm((N_MLA, DEC_BATCH, PAST_LEN, QK_ROPE), 1.0)
    inp['state_s5_re'] = nrm((N_SSM, DEC_BATCH, N_GROUPS, SSM_STATE), 0.1)
    inp['state_s5_im'] = nrm((N_SSM, DEC_BATCH, N_GROUPS, SSM_STATE), 0.1)
    inp['cache_ffn_conv'] = nrm((DEPTH, DEC_BATCH, CONV_W - 1, D_FF), 1.0)
    inp['c_prompt'] = nrm((BATCH, D_MODEL), 1.0)
    inp['c_sample'] = nrm((DEC_BATCH, D_MODEL), 1.0)
    inp['w_mod'] = nrm((DEPTH, D_MODEL, 6 * D_MODEL), 0.5 * D_MODEL ** -0.5)
    inp['b_mod'] = nrm((DEPTH, 6 * D_MODEL), 0.01)
    inp['g_norm_mix'] = gain((DEPTH, D_MODEL))
    inp['g_norm_ffn'] = gain((DEPTH, D_MODEL))
    inp['mla_w_dq'] = nrm((N_MLA, D_MODEL, Q_LORA), D_MODEL ** -0.5)
    inp['mla_g_qa'] = gain((N_MLA, Q_LORA))
    inp['mla_w_uq'] = nrm((N_MLA, Q_LORA, N_HEADS * QK_HEAD), Q_LORA ** -0.5)
    inp['mla_g_qn'] = gain((N_MLA, QK_HEAD))
    inp['mla_w_dkv'] = nrm((N_MLA, D_MODEL, KV_LORA + QK_ROPE), D_MODEL ** -0.5)
    inp['mla_g_kva'] = gain((N_MLA, KV_LORA))
    inp['mla_w_ukv'] = nrm((N_MLA, KV_LORA, N_HEADS * (QK_NOPE + V_HEAD)), KV_LORA ** -0.5)
    inp['mla_g_kn'] = gain((N_MLA, QK_HEAD))
    inp['mla_w_o'] = nrm((N_MLA, N_HEADS * V_HEAD, D_MODEL), (N_HEADS * V_HEAD) ** -0.5)
    inp['s5_a_re'] = -0.5 - jnp.abs(nrm((N_SSM, N_GROUPS, SSM_STATE), 0.01))
    inp['s5_a_im'] = math.pi * n_idx + nrm((N_SSM, N_GROUPS, SSM_STATE), 0.01)
    inp['s5_log_dt'] = jax.random.uniform(next(ks), (N_SSM, N_GROUPS), jnp.float32, math.log(DT_MIN), math.log(DT_MAX))
    inp['s5_b_re'] = nrm((N_SSM, N_GROUPS, SSM_STATE, SSM_GROUP), (2 * SSM_GROUP) ** -0.5)
    inp['s5_b_im'] = nrm((N_SSM, N_GROUPS, SSM_STATE, SSM_GROUP), (2 * SSM_GROUP) ** -0.5)
    inp['s5_c_re'] = nrm((N_SSM, N_GROUPS, SSM_GROUP, SSM_STATE), (2 * SSM_STATE) ** -0.5)
    inp['s5_c_im'] = nrm((N_SSM, N_GROUPS, SSM_GROUP, SSM_STATE), (2 * SSM_STATE) ** -0.5)
    inp['s5_d'] = nrm((N_SSM, D_MODEL), 1.0)
    inp['s5_w_glu'] = nrm((N_SSM, D_MODEL, D_MODEL), D_MODEL ** -0.5)
    inp['s5_w_gate'] = nrm((N_SSM, D_MODEL, D_MODEL), D_MODEL ** -0.5)
    inp['ffn_w_gate'] = nrm((DEPTH, D_MODEL, D_FF), D_MODEL ** -0.5)
    inp['ffn_w_up'] = nrm((DEPTH, D_MODEL, D_FF), D_MODEL ** -0.5)
    inp['ffn_conv_w'] = nrm((DEPTH, CONV_W, D_FF), CONV_W ** -0.5)
    inp['ffn_conv_b'] = nrm((DEPTH, D_FF), 0.01)
    inp['ffn_w_down'] = nrm((DEPTH, D_FF, D_MODEL), D_FF ** -0.5)
    return inp


def reference(x_prompt, x_sample, cache_mla_ckv, cache_mla_krope, state_s5_re, state_s5_im, cache_ffn_conv, c_prompt, c_sample, w_mod, b_mod, g_norm_mix, g_norm_ffn, mla_w_dq, mla_g_qa, mla_w_uq, mla_g_qn, mla_w_dkv, mla_g_kva, mla_w_ukv, mla_g_kn, mla_w_o, s5_a_re, s5_a_im, s5_log_dt, s5_b_re, s5_b_im, s5_c_re, s5_c_im, s5_d, s5_w_glu, s5_w_gate, ffn_w_gate, ffn_w_up, ffn_conv_w, ffn_conv_b, ffn_w_down):
    prm = dict(w_mod=w_mod, b_mod=b_mod, g_norm_mix=g_norm_mix, g_norm_ffn=g_norm_ffn,
               mla_w_dq=mla_w_dq, mla_g_qa=mla_g_qa, mla_w_uq=mla_w_uq, mla_g_qn=mla_g_qn,
               mla_w_dkv=mla_w_dkv, mla_g_kva=mla_g_kva, mla_w_ukv=mla_w_ukv, mla_g_kn=mla_g_kn,
               mla_w_o=mla_w_o, s5_a_re=s5_a_re, s5_a_im=s5_a_im, s5_log_dt=s5_log_dt,
               s5_b_re=s5_b_re, s5_b_im=s5_b_im, s5_c_re=s5_c_re, s5_c_im=s5_c_im, s5_d=s5_d,
               s5_w_glu=s5_w_glu, s5_w_gate=s5_w_gate, ffn_w_gate=ffn_w_gate, ffn_w_up=ffn_w_up,
               ffn_conv_w=ffn_conv_w, ffn_conv_b=ffn_conv_b, ffn_w_down=ffn_w_down)
    xp, xs = x_prompt, x_sample
    ckv_p, kr_p, ckv_s, kr_s = [], [], [], []
    re_p, im_p, re_s, im_s = [], [], [], []
    conv_p, conv_s = [], []
    for l in range(DEPTH):
        i = l // N_MIXERS
        if l % N_MIXERS == 0:
            past_s = (cache_mla_ckv[i], cache_mla_krope[i])
        else:
            past_s = (state_s5_re[i], state_s5_im[i])
        xp, a_p, b_p, cv_p = run_layer(l, xp, c_prompt, None, None, prm)
        xs, a_s, b_s, cv_s = run_layer(l, xs, c_sample, past_s, cache_ffn_conv[l], prm)
        if l % N_MIXERS == 0:
            ckv_p.append(a_p); kr_p.append(b_p); ckv_s.append(a_s); kr_s.append(b_s)
        else:
            re_p.append(a_p); im_p.append(b_p); re_s.append(a_s); im_s.append(b_s)
        conv_p.append(cv_p); conv_s.append(cv_s)
    new_ckv_prompt = jnp.stack(ckv_p)
    new_krope_prompt = jnp.stack(kr_p)
    new_ckv_sample = jnp.stack(ckv_s)
    new_krope_sample = jnp.stack(kr_s)
    new_s5_re_prompt = jnp.stack(re_p)
    new_s5_im_prompt = jnp.stack(im_p)
    new_s5_re_sample = jnp.stack(re_s)
    new_s5_im_sample = jnp.stack(im_s)
    new_conv_prompt = jnp.stack(conv_p)
    new_conv_sample = jnp.stack(conv_s)
    return (xp, xs, new_ckv_prompt, new_krope_prompt, new_ckv_sample, new_krope_sample, new_s5_re_prompt, new_s5_im_prompt, new_s5_re_sample, new_s5_im_sample, new_conv_prompt, new_conv_sample)
```

```cpp
#include <hip/hip_runtime.h>
#include <cstdio>
#include <cstdint>

#ifndef MK_PER_PHASE
#define MK_PER_PHASE 0
#endif

#define LAS __attribute__((address_space(3)))
#define GAS __attribute__((address_space(1)))
typedef unsigned short bf16_t;
typedef short bf16x8 __attribute__((ext_vector_type(8)));
typedef short s16x4 __attribute__((ext_vector_type(4)));
typedef float f32x4 __attribute__((ext_vector_type(4)));
typedef float f32x2 __attribute__((ext_vector_type(2)));
typedef float f32x16 __attribute__((ext_vector_type(16)));
typedef unsigned u32x4 __attribute__((ext_vector_type(4)));
typedef unsigned u32x2 __attribute__((ext_vector_type(2)));

constexpr int DM = 2048, NPROMPT = 32768, NTOK = 33280, SEQ = 8192, DSEQ = 64, PAST = 4096, SKV = 4160, NKV = 66048, DFF = 5632;
constexpr int NH = 16, DQK = 192, QLORA = 512, KVLORA = 256;
constexpr int NSLOT = 12;
constexpr int NWAVES = 8;
constexpr float EPS = 1e-6f;
constexpr int NGRP = 128, NSUB = 2304;

constexpr size_t O_Y = 0, O_CKVP = 68157440, O_KRP = 84934656, O_CKVS = 89128960, O_KRS = 89391104, O_REP = 89456640, O_IMP = 89522176,
                 O_RES = 89587712, O_IMS = 89718784, O_CONVP = 89849856, O_CONVS = 90030080, O_END = 90390528;

constexpr size_t MiB = 1u << 20;
constexpr size_t WS_CTL = 0, CTL_ZERO_BYTES = 1 * MiB, WS_ZGATE = 128 * 1024;
constexpr size_t WS_MOD = 1 * MiB;
constexpr size_t WS_A16 = 4 * MiB;
constexpr size_t WS_KRSS = 5 * MiB;
constexpr size_t WS_ROPE = 6 * MiB;
constexpr size_t WS_W = 8 * MiB;
constexpr size_t WSZ_DQKV = 4 * MiB, WSZ_UQ = 3 * MiB, WSZ_UKV = 2 * MiB, WSZ_WO = 8 * MiB, WSZ_MLA = 17 * MiB;
constexpr size_t WS_MLA = WS_W;
constexpr size_t WSZ_GG = 16 * MiB, WSZ_BTY = 24 * MiB, WSZ_BTX = 16 * MiB, WSZ_S5 = 56 * MiB;
constexpr size_t WS_S5 = WS_MLA + 2 * WSZ_MLA;
constexpr size_t WSZ_FF1 = 22 * MiB, WSZ_FFN = 66 * MiB;
constexpr size_t WS_FFN = WS_S5 + 2 * WSZ_S5;
constexpr size_t WS_H = WS_FFN + 4 * WSZ_FFN;
constexpr size_t WS_XB = WS_H + 130 * MiB;
constexpr size_t WS_BIG = WS_XB + 130 * MiB;
constexpr size_t OY_QA = 0;
constexpr size_t OY_CKV = 33 * MiB;
constexpr size_t OY_STATQ = 100 * MiB;
constexpr size_t OY_RSTDQ = 102 * MiB;
constexpr size_t OY_R = 66 * MiB;
constexpr size_t WS_Q = WS_BIG;
constexpr size_t WS_KB = WS_Q + 195 * MiB;
constexpr size_t WS_QKVA = WS_KB;
constexpr size_t WS_G = WS_BIG;
constexpr size_t WS_HID = WS_BIG + 358 * MiB;
constexpr size_t WS_PART = WS_BIG + 716 * MiB;
constexpr size_t WS_PGU = WS_BIG + 764 * MiB;
constexpr size_t WS_UP = WS_BIG;
constexpr size_t WS_XLOC = WS_BIG + 216 * MiB;
constexpr size_t WS_END = WS_KB + 645 * MiB;
static_assert(WS_END <= 1536 * MiB, "workspace map");
static_assert(WS_HID + 358 * MiB <= WS_PART && WS_PART + 48 * MiB <= WS_PGU && WS_PGU + 48 * MiB <= WS_END && WS_XLOC + 144 * MiB <= WS_PART, "aliases");

constexpr int RING_BYTES = 131072;
constexpr int MISC_OFF = RING_BYTES;
constexpr int PAR_OFF = RING_BYTES + 1024 + 4096;
constexpr int LDS_BYTES = RING_BYTES + 1024 + 4096 + 2048;

#define RLX_AGENT __ATOMIC_RELAXED, __HIP_MEMORY_SCOPE_AGENT
#define LDS_WAIT() asm volatile("s_waitcnt lgkmcnt(0)" ::: "memory")
#define VM_WAIT() asm volatile("s_waitcnt vmcnt(0)" ::: "memory")

__device__ __forceinline__ unsigned cvt_pk_bf16(float lo, float hi) { unsigned r; asm volatile("v_cvt_pk_bf16_f32 %0, %1, %2" : "=v"(r) : "v"(lo), "v"(hi)); return r; }
__device__ __forceinline__ float bf_lo(unsigned w) { return __uint_as_float(w << 16); }
__device__ __forceinline__ float bf_hi(unsigned w) { return __uint_as_float(w & 0xffff0000u); }
__device__ __forceinline__ float bf1(bf16_t b) { return __uint_as_float(((unsigned)b) << 16); }
__device__ __forceinline__ float shx(float v, int m, int lane) { return __int_as_float(__builtin_amdgcn_ds_bpermute((lane ^ m) << 2, __float_as_int(v))); }
__device__ __forceinline__ float wave_sum(float v, int lane) {
#pragma unroll
    for (int o = 1; o < 64; o <<= 1) v += shx(v, o, lane);
    return v;
}
__device__ __forceinline__ float sum16(float v, int lane) {
#pragma unroll
    for (int o = 1; o < 16; o <<= 1) v += shx(v, o, lane);
    return v;
}
__device__ __forceinline__ int slot_of_row(int r) { return r < NPROMPT ? (r >> 13) : 4 + ((r - NPROMPT) >> 6); }
__device__ __forceinline__ float fast_sigmoid(float x) { return __builtin_amdgcn_rcpf(1.0f + __builtin_amdgcn_exp2f(-1.4426950408889634f * x)); }

#ifndef GEMM_SP2
#define GEMM_SP2 true
#endif
namespace pg8 {
constexpr int BM = 256, BK = 64, HALF = 128, HTB = HALF * BK * 2, STAGE_BYTES = 8 * HTB, NXCD = 8, WGM = 8;
__host__ __device__ __forceinline__ int lds_byte(int r, int c) { const int st = (r >> 4) * 2 + (c >> 5), rr = r & 15, cc = c & 31, ob = rr * 64 + cc * 2; return st * 1024 + (ob ^ (((ob >> 9) & 1) << 5)); }
__host__ __device__ __forceinline__ void stage_rc(int b, int& R, int& C) { const int st = b / 1024, sb = b % 1024, swz = sb ^ (((sb >> 9) & 1) << 5); R = (st >> 1) * 16 + swz / 64; C = (st & 1) * 32 + (swz % 64) / 2; }
__host__ __device__ __forceinline__ int perm32(int rho) { const int n = rho >> 4, i = rho & 15; return 8 * (i >> 2) + 4 * n + (i & 3); }

struct Unit { int pm, pn, ks; size_t koff; };
struct Gemm { const bf16_t* A; const bf16_t* Bt; int lda, ldb, K; size_t ksA, ksB, tsA, tsB; };
__device__ __forceinline__ Gemm gemm_rm(const bf16_t* A, const bf16_t* Bt, int lda, int ldb, int K) { return Gemm{A, Bt, lda, ldb, K, 128, 128, (size_t)512 * lda, (size_t)512 * ldb}; }
__device__ __forceinline__ size_t tiled_off(int row, int col, int nkt) { return (((size_t)(row >> 8) * nkt + (col >> 6)) * 256 + (row & 255)) * 64 + (col & 63); }

struct StaticOrder {
    int nM, nN, nwg, G, c, pnskip = 1 << 30, pnoff = 0;
    __device__ void init(int nM_, int nN_, int G_, int c_) { nM = nM_; nN = nN_; nwg = nM * nN; G = G_; c = c_; }
    __device__ bool next(int i, Unit& u) const {
        const long L = (long)i * G + c; if (L >= nwg) return false;
        int wgid = (int)L; { const int q = nwg / NXCD, r = nwg % NXCD, xcd = wgid % NXCD, off = wgid / NXCD; wgid = (xcd < r ? xcd * (q + 1) : r * (q + 1) + (xcd - r) * q) + off; }
        const int nig = WGM * nN, gid = wgid / nig, fm = gid * WGM, gsz = (nM - fm) < WGM ? (nM - fm) : WGM;
        u.pm = fm + ((wgid % nig) % gsz); { const int p_ = (wgid % nig) / gsz; u.pn = p_ + pnoff + (p_ >= pnskip ? 1 : 0); } u.ks = 0; u.koff = 0; return true;
    }
};
struct SplitOrder {
    int c, nN, nsplit; size_t kbytes;
    __device__ bool next(int i, Unit& u) const { if (i > 0 || c >= 2 * nN * nsplit) return false; const int ks = c % nsplit, t = c / nsplit; u.pm = 128 + t / nN; u.pn = t % nN; u.ks = ks; u.koff = ks * kbytes; return true; }
};
struct GroupOrder {
    int G, c;
    __device__ bool next(int i, Unit& u) const { const int L = i * G + c; if (L >= NGRP * 9) return false; const int g = L < NGRP * 8 ? L >> 3 : L - NGRP * 8, p = L < NGRP * 8 ? (L & 7) : 8;
        u.pm = 9 * g + p; u.pn = g; u.ks = 0; u.koff = 0; return true; }
};

template <class Epi, class Sched, bool ALIGN_EPI, bool SP2 = GEMM_SP2>
__device__ __forceinline__ void gemm_phase(LAS unsigned char* lds, const Gemm g, const Sched& S, const Epi& E, const int tid) {
    const int wid = __builtin_amdgcn_readfirstlane(tid >> 6), lane = tid & 63, wr = wid >> 2, wc = wid & 3, fr = lane & 15, fq = lane >> 4;
    const int K = g.K, nt = K / BK;
    unsigned voffA[2], voffB[2];
#pragma unroll
    for (int i = 0; i < 2; ++i) { int R, C; stage_rc(tid * 16 + i * 8192, R, C); const int Rb = Epi::PERM ? ((R & ~31) + perm32(R & 31)) : R;
        const int Ra = Epi::PERMA ? ((R & ~63) + ((R & 15) << 2) + ((R >> 4) & 3)) : R;
        voffA[i] = (unsigned)(Ra * g.lda + C) * 2u; voffB[i] = (unsigned)(Rb * g.ldb + C) * 2u; }
    const size_t kstepA = g.ksA, kstepB = g.ksB;
    const size_t hstepA = (size_t)HALF * g.lda * 2, hstepB = (size_t)HALF * g.ldb * 2;
    const size_t tstepA = g.tsA, tstepB = g.tsB;
    const unsigned ldsw = (unsigned)wid * 1024u;
    const int aoff = lds_byte(wr * 64 + fr, fq * 8), boff = lds_byte(wc * 32 + fr, fq * 8);
#define PG8_SA(b, h) (((b) * 2 + (h)) * HTB)
#define PG8_SB(b, h) ((4 + (b) * 2 + (h)) * HTB)
#define PG8_STAGE(bufoff, gbase, voff) do { _Pragma("unroll") for (int _i = 0; _i < 2; ++_i) \
        __builtin_amdgcn_global_load_lds((const unsigned*)((const char*)(gbase) + (voff)[_i]), (LAS unsigned*)(lds + (bufoff) + ldsw + _i * 8192), 16, 0, 0); } while (0)
#define PG8_LDA(dst, b, h) do { _Pragma("unroll") for (int m = 0; m < 4; ++m) _Pragma("unroll") for (int k = 0; k < 2; ++k) dst[m][k] = *(const LAS bf16x8*)(lds + PG8_SA(b, h) + aoff + m * 2048 + k * 1024); } while (0)
#define PG8_LDB(dst, b, h) do { _Pragma("unroll") for (int n = 0; n < 2; ++n) _Pragma("unroll") for (int k = 0; k < 2; ++k) dst[n][k] = *(const LAS bf16x8*)(lds + PG8_SB(b, h) + boff + n * 2048 + k * 1024); } while (0)
#define PG8_MMA(ai, bj, At, Bt) do { __builtin_amdgcn_s_setprio(1); _Pragma("unroll") for (int m = 0; m < 4; ++m) _Pragma("unroll") for (int n = 0; n < 2; ++n) _Pragma("unroll") for (int k = 0; k < 2; ++k) \
        acc[ai][bj][m][n] = __builtin_amdgcn_mfma_f32_16x16x32_bf16(Bt[n][k], At[m][k], acc[ai][bj][m][n], 0, 0, 0); __builtin_amdgcn_s_setprio(0); } while (0)
#define PG8_WAIT_V(n) asm volatile("s_waitcnt vmcnt(" #n ")" ::: "memory")
#define PG8_WAIT_L(n) asm volatile("s_waitcnt lgkmcnt(" #n ")" ::: "memory")
#define PG8_WAIT_VP(n) do { if constexpr (Epi::NPRE == 0) { PG8_WAIT_V(n); } else { static_assert(Epi::NPRE == 1 && n == 8, "counts"); if (pf) PG8_WAIT_V(9); else PG8_WAIT_V(8); } } while (0)
#define PG8_BAR __builtin_amdgcn_s_barrier()
#define PG8_SCHED __builtin_amdgcn_sched_barrier(0)
    Unit cur, nxt; int ui = 0;
    if (!S.next(0, cur)) return;
    f32x4 acc[2][2][4][2];
#pragma unroll
    for (int a = 0; a < 2; ++a)
#pragma unroll
        for (int b = 0; b < 2; ++b)
#pragma unroll
            for (int m = 0; m < 4; ++m)
#pragma unroll
                for (int n = 0; n < 2; ++n) acc[a][b][m][n] = (f32x4){0.f, 0.f, 0.f, 0.f};
    bf16x8 At[4][2], B0[2][2], B1[2][2];
    const char* cA = (const char*)g.A + (size_t)cur.pm * tstepA + cur.koff; const char* cB = (const char*)g.Bt + (size_t)cur.pn * tstepB + cur.koff;
    if constexpr (SP2) {
    PG8_STAGE(PG8_SB(0, 0), cB, voffB); PG8_STAGE(PG8_SB(0, 1), cB + hstepB, voffB); PG8_STAGE(PG8_SA(0, 0), cA, voffA); PG8_STAGE(PG8_SA(0, 1), cA + hstepA, voffA);
    if (wr == 1) PG8_BAR;
    PG8_WAIT_V(2); PG8_BAR;
    PG8_STAGE(PG8_SB(1, 0), cB + kstepB, voffB); PG8_STAGE(PG8_SA(1, 0), cA + kstepA, voffA); PG8_STAGE(PG8_SB(1, 1), cB + hstepB + kstepB, voffB);
    PG8_WAIT_V(6); PG8_BAR;
    } else {
    PG8_STAGE(PG8_SB(0, 0), cB, voffB); PG8_STAGE(PG8_SA(0, 0), cA, voffA); PG8_STAGE(PG8_SB(0, 1), cB + hstepB, voffB); PG8_STAGE(PG8_SA(0, 1), cA + hstepA, voffA);
    if (wr == 1) PG8_BAR;
    PG8_WAIT_V(4); PG8_BAR;
    PG8_STAGE(PG8_SB(1, 0), cB + kstepB, voffB); PG8_STAGE(PG8_SA(1, 0), cA + kstepA, voffA); PG8_STAGE(PG8_SB(1, 1), cB + hstepB + kstepB, voffB);
    PG8_WAIT_V(6); PG8_BAR;
    }
    for (;;) {
        const bool has_next = S.next(ui + 1, nxt);
        const char* nA = has_next ? (const char*)g.A + (size_t)nxt.pm * tstepA + nxt.koff : cA; const char* nB = has_next ? (const char*)g.Bt + (size_t)nxt.pn * tstepB + nxt.koff : cB;
#pragma unroll 1
        for (int t = 0; t < nt; t += 2) {
            const bool last = (t == nt - 2);
            const char* a1 = cA + (size_t)(t + 1) * kstepA;
            const char* a2 = last ? nA : cA + (size_t)(t + 2) * kstepA; const char* b2 = last ? nB : cB + (size_t)(t + 2) * kstepB;
            const char* a3 = a2 + kstepA; const char* b3 = b2 + kstepB;
            const bool pf = Epi::NPRE > 0 && (t == nt - 4);
            if constexpr (Epi::NPRE > 0) { if (pf) E.prefetch(lds, cur, wid, lane); }
            if constexpr (SP2) {
            PG8_LDB(B0, 0, 0); PG8_LDB(B1, 0, 1); PG8_SCHED; PG8_LDA(At, 0, 0); PG8_STAGE(PG8_SA(1, 1), a1 + hstepA, voffA);
            PG8_WAIT_VP(8); PG8_WAIT_L(0); PG8_BAR; PG8_MMA(0, 0, At, B0); PG8_MMA(0, 1, At, B1); PG8_BAR; PG8_SCHED;
            PG8_LDA(At, 0, 1); PG8_STAGE(PG8_SB(0, 0), b2, voffB); PG8_STAGE(PG8_SB(0, 1), b2 + hstepB, voffB); PG8_STAGE(PG8_SA(0, 0), a2, voffA);
            PG8_WAIT_VP(8); PG8_WAIT_L(0); PG8_BAR; PG8_MMA(1, 0, At, B0); PG8_MMA(1, 1, At, B1); PG8_BAR; PG8_SCHED;
            PG8_LDB(B0, 1, 0); PG8_LDB(B1, 1, 1); PG8_SCHED; PG8_LDA(At, 1, 0); PG8_STAGE(PG8_SA(0, 1), a2 + hstepA, voffA);
            PG8_WAIT_VP(8); PG8_WAIT_L(0); PG8_BAR; PG8_MMA(0, 0, At, B0); PG8_MMA(0, 1, At, B1); PG8_BAR; PG8_SCHED;
            PG8_LDA(At, 1, 1); PG8_STAGE(PG8_SB(1, 0), b3, voffB); PG8_STAGE(PG8_SB(1, 1), b3 + hstepB, voffB); PG8_STAGE(PG8_SA(1, 0), a3, voffA);
            PG8_WAIT_VP(8); PG8_WAIT_L(0); PG8_BAR; PG8_MMA(1, 0, At, B0); PG8_MMA(1, 1, At, B1); PG8_BAR; PG8_SCHED;
            } else {
            PG8_LDB(B0, 0, 0); PG8_SCHED; PG8_LDA(At, 0, 0); PG8_STAGE(PG8_SA(1, 1), a1 + hstepA, voffA);
            PG8_WAIT_L(8); PG8_BAR; PG8_WAIT_L(0); PG8_MMA(0, 0, At, B0); PG8_BAR; PG8_SCHED;
            PG8_LDB(B1, 0, 1); PG8_STAGE(PG8_SB(0, 0), b2, voffB);
            PG8_BAR; PG8_WAIT_L(0); PG8_MMA(0, 1, At, B1); PG8_BAR;
            PG8_LDA(At, 0, 1); PG8_STAGE(PG8_SA(0, 0), a2, voffA);
            PG8_BAR; PG8_WAIT_L(0); PG8_MMA(1, 0, At, B0); PG8_BAR; PG8_SCHED;
            PG8_STAGE(PG8_SB(0, 1), b2 + hstepB, voffB);
            PG8_WAIT_V(6); PG8_BAR; PG8_MMA(1, 1, At, B1); PG8_BAR;
            PG8_LDB(B0, 1, 0); PG8_SCHED; PG8_LDA(At, 1, 0); PG8_STAGE(PG8_SA(0, 1), a2 + hstepA, voffA);
            PG8_WAIT_L(8); PG8_BAR; PG8_WAIT_L(0); PG8_MMA(0, 0, At, B0); PG8_BAR; PG8_SCHED;
            PG8_LDB(B1, 1, 1); PG8_STAGE(PG8_SB(1, 0), b3, voffB);
            PG8_BAR; PG8_WAIT_L(0); PG8_MMA(0, 1, At, B1); PG8_BAR;
            PG8_LDA(At, 1, 1); PG8_STAGE(PG8_SA(1, 0), a3, voffA);
            PG8_BAR; PG8_WAIT_L(0); PG8_MMA(1, 0, At, B0); PG8_BAR; PG8_SCHED;
            PG8_STAGE(PG8_SB(1, 1), b3 + hstepB, voffB);
            PG8_WAIT_V(6); PG8_BAR; PG8_MMA(1, 1, At, B1); PG8_BAR;
            }
        }
        if constexpr (ALIGN_EPI) { if (wr == 0) PG8_BAR; }
        E(acc, cur, wr, wc, fr, fq);
        if (!has_next) break;
#pragma unroll
        for (int a = 0; a < 2; ++a)
#pragma unroll
            for (int b = 0; b < 2; ++b)
#pragma unroll
                for (int m = 0; m < 4; ++m)
#pragma unroll
                    for (int n = 0; n < 2; ++n) acc[a][b][m][n] = (f32x4){0.f, 0.f, 0.f, 0.f};
        cur = nxt; cA = nA; cB = nB; ++ui;
        if constexpr (ALIGN_EPI) { if (wr == 1) PG8_BAR; }
    }
    PG8_WAIT_V(0);
    if constexpr (!ALIGN_EPI) { if (wr == 0) PG8_BAR; }
    PG8_BAR;
#undef PG8_SA
#undef PG8_SB
#undef PG8_STAGE
#undef PG8_LDA
#undef PG8_LDB
#undef PG8_MMA
#undef PG8_WAIT_V
#undef PG8_WAIT_VP
#undef PG8_WAIT_L
#undef PG8_BAR
#undef PG8_SCHED
}

typedef f32x4 Acc[2][2][4][2];

struct EpiF32 {
    static constexpr int NPRE = 0; static constexpr bool PERMA = false;
    static constexpr bool PERM = false;
    float* C; int ldc;
    __device__ __forceinline__ void operator()(const Acc& acc, const Unit& u, int wr, int wc, int fr, int fq) const {
        const int row0 = u.pm * BM + wr * 64 + fr, col0 = u.pn * BM + wc * 32 + 4 * fq;
#pragma unroll
        for (int ai = 0; ai < 2; ++ai)
#pragma unroll
            for (int m = 0; m < 4; ++m) { float* rowp = C + (size_t)(row0 + ai * HALF + m * 16) * ldc + col0;
#pragma unroll
                for (int bj = 0; bj < 2; ++bj)
#pragma unroll
                    for (int n = 0; n < 2; ++n) *(f32x4*)(rowp + bj * HALF + n * 16) = acc[ai][bj][m][n]; }
    }
};
__device__ __forceinline__ u32x4 pack8(const f32x4& v0, const f32x4& v1) { u32x4 w; w.x = cvt_pk_bf16(v0[0], v0[1]); w.y = cvt_pk_bf16(v0[2], v0[3]); w.z = cvt_pk_bf16(v1[0], v1[1]); w.w = cvt_pk_bf16(v1[2], v1[3]); return w; }
struct EpiBf16 {
    static constexpr int NPRE = 0; static constexpr bool PERMA = false;
    static constexpr bool PERM = true;
    bf16_t* O; int ldc; const float* rs;
    __device__ __forceinline__ void operator()(const Acc& acc, const Unit& u, int wr, int wc, int fr, int fq) const {
        const int row0 = u.pm * BM + wr * 64 + fr, col0 = u.pn * BM + wc * 32 + 8 * fq;
        float sc[2][4];
#pragma unroll
        for (int ai = 0; ai < 2; ++ai)
#pragma unroll
            for (int m = 0; m < 4; ++m) sc[ai][m] = rs[row0 + ai * HALF + m * 16];
#pragma unroll
        for (int ai = 0; ai < 2; ++ai)
#pragma unroll
            for (int m = 0; m < 4; ++m) { bf16_t* rowp = O + (size_t)(row0 + ai * HALF + m * 16) * ldc + col0;
#pragma unroll
                for (int bj = 0; bj < 2; ++bj) *(u32x4*)(rowp + bj * HALF) = pack8(acc[ai][bj][m][0] * sc[ai][m], acc[ai][bj][m][1] * sc[ai][m]); }
    }
};
struct EpiA1 {
    static constexpr int NPRE = 0; static constexpr bool PERMA = false;
    static constexpr bool PERM = true;
    float* C; bf16_t* Q; float* stat;
    __device__ __forceinline__ void operator()(const Acc& acc, const Unit& u, int wr, int wc, int fr, int fq) const {
        const int lane = fr + 16 * fq;
        const int row0 = u.pm * BM + wr * 64 + fr, col0 = u.pn * BM + wc * 32 + 8 * fq;
        if (u.pn < 2) {
#pragma unroll
            for (int ai = 0; ai < 2; ++ai)
#pragma unroll
                for (int m = 0; m < 4; ++m) { const int row = row0 + ai * HALF + m * 16; float ss = 0.f;
#pragma unroll
                    for (int bj = 0; bj < 2; ++bj) { const f32x4 a = acc[ai][bj][m][0], b = acc[ai][bj][m][1];
                        *(u32x4*)(Q + (size_t)row * QLORA + col0 + bj * HALF) = pack8(a, b);
                        ss += ((a[0] * a[0] + a[1] * a[1]) + (a[2] * a[2] + a[3] * a[3])) + ((b[0] * b[0] + b[1] * b[1]) + (b[2] * b[2] + b[3] * b[3])); }
                    ss += shx(ss, 16, lane); ss += shx(ss, 32, lane);
                    if (fq == 0) stat[(size_t)row * 8 + u.pn * 4 + wc] = ss; }
        } else {
#pragma unroll
            for (int ai = 0; ai < 2; ++ai)
#pragma unroll
                for (int m = 0; m < 4; ++m) { float* rowp = C + (size_t)(row0 + ai * HALF + m * 16) * 1024 + col0;
#pragma unroll
                    for (int bj = 0; bj < 2; ++bj) { *(f32x4*)(rowp + bj * HALF) = acc[ai][bj][m][0]; *(f32x4*)(rowp + bj * HALF + 4) = acc[ai][bj][m][1]; } }
        }
    }
};
struct EpiCkv {
    static constexpr int NPRE = 0; static constexpr bool PERMA = false;
    static constexpr bool PERM = true;
    bf16_t* ckvb; float* ckvo; const float* gkva; LAS float* scr;
    __device__ __forceinline__ void operator()(const Acc& acc, const Unit& u, int wr, int wc, int fr, int fq) const {
        const int lane = fr + 16 * fq, c0 = wc * 32 + 8 * fq;
#pragma unroll
        for (int ai = 0; ai < 2; ++ai)
#pragma unroll
            for (int m = 0; m < 4; ++m) { float ss = 0.f;
#pragma unroll
                for (int bj = 0; bj < 2; ++bj) { const f32x4 a = acc[ai][bj][m][0], b = acc[ai][bj][m][1]; ss += ((a[0] * a[0] + a[1] * a[1]) + (a[2] * a[2] + a[3] * a[3])) + ((b[0] * b[0] + b[1] * b[1]) + (b[2] * b[2] + b[3] * b[3])); }
                ss += shx(ss, 16, lane); ss += shx(ss, 32, lane);
                if (fq == 0) scr[(ai * HALF + wr * 64 + m * 16 + fr) * 4 + wc] = ss; }
        asm volatile("s_waitcnt lgkmcnt(0)\n\ts_barrier" ::: "memory");
        float rk[2][4];
#pragma unroll
        for (int ai = 0; ai < 2; ++ai)
#pragma unroll
            for (int m = 0; m < 4; ++m) { const f32x4 sp = *(const LAS f32x4*)(scr + (ai * HALF + wr * 64 + m * 16 + fr) * 4); rk[ai][m] = 1.0f / sqrtf(((sp[0] + sp[1]) + (sp[2] + sp[3])) * (1.0f / KVLORA) + EPS); }
#pragma unroll
        for (int bj = 0; bj < 2; ++bj) { const f32x4 g0 = *(const f32x4*)(gkva + bj * HALF + c0), g1 = *(const f32x4*)(gkva + bj * HALF + c0 + 4);
#pragma unroll
            for (int ai = 0; ai < 2; ++ai)
#pragma unroll
                for (int m = 0; m < 4; ++m) { const unsigned off = (unsigned)((u.pm * BM + ai * HALF + wr * 64 + m * 16 + fr) * KVLORA + c0 + bj * HALF);
                    const f32x4 a = acc[ai][bj][m][0] * rk[ai][m] * g0, b = acc[ai][bj][m][1] * rk[ai][m] * g1;
                    *(f32x4*)(ckvo + off) = a; *(f32x4*)(ckvo + off + 4) = b; *(u32x4*)(ckvb + off) = pack8(a, b); }
            asm volatile("" ::: "memory"); }
    }
};
struct EpiKV {
    static constexpr int NPRE = 0; static constexpr bool PERMA = false;
    static constexpr bool PERM = true;
    bf16_t* KV; const float* krss; const float* R; const float* gkn; LAS float* scr;
    __device__ __forceinline__ void operator()(const Acc& acc, const Unit& u, int wr, int wc, int fr, int fq) const {
        const int lane = fr + 16 * fq;
#pragma unroll
        for (int ai = 0; ai < 2; ++ai)
#pragma unroll
            for (int m = 0; m < 4; ++m) { const f32x4 a = acc[ai][0][m][0], b = acc[ai][0][m][1];
                float s = (a[0] * a[0] + a[1] * a[1]) + (a[2] * a[2] + a[3] * a[3]) + (b[0] * b[0] + b[1] * b[1]) + (b[2] * b[2] + b[3] * b[3]);
                s += shx(s, 16, lane); s += shx(s, 32, lane);
                if (fq == 0) scr[(ai * HALF + wr * 64 + m * 16 + fr) * 4 + wc] = s; }
        const int row0 = u.pm * BM + wr * 64 + fr;
        bf16_t* base = KV + (size_t)row0 * 5120 + u.pn * 320;
        const f32x4 g0 = *(const f32x4*)(gkn + wc * 32 + 8 * fq), g1 = *(const f32x4*)(gkn + wc * 32 + 8 * fq + 4);
        float kr[2][4]; f32x4 rv[2][4];
#pragma unroll
        for (int ai = 0; ai < 2; ++ai)
#pragma unroll
            for (int m = 0; m < 4; ++m) { const size_t row = (size_t)(row0 + ai * HALF + m * 16); kr[ai][m] = krss[row]; rv[ai][m] = *(const f32x4*)(R + row * 64 + wc * 16 + 4 * fq); }
        asm volatile("s_waitcnt lgkmcnt(0)\n\ts_barrier" ::: "memory");
#pragma unroll
        for (int ai = 0; ai < 2; ++ai)
#pragma unroll
            for (int m = 0; m < 4; ++m) { const int rl = ai * HALF + m * 16;
                const f32x4 sp = *(const LAS f32x4*)(scr + (rl + wr * 64 + fr) * 4);
                const float r = 1.0f / sqrtf(((sp[0] + sp[1]) + (sp[2] + sp[3]) + kr[ai][m]) * (1.0f / 192.0f) + EPS);
                bf16_t* rowp = base + (size_t)rl * 5120;
                *(u32x4*)(rowp + wc * 32 + 8 * fq) = pack8(acc[ai][0][m][0] * g0 * r, acc[ai][0][m][1] * g1 * r);
                *(u32x4*)(rowp + 192 + wc * 32 + 8 * fq) = pack8(acc[ai][1][m][0], acc[ai][1][m][1]);
                const f32x4 rr = rv[ai][m] * r;
                u32x2 w; w.x = cvt_pk_bf16(rr[0], rr[1]); w.y = cvt_pk_bf16(rr[2], rr[3]);
                *(u32x2*)(rowp + 128 + wc * 16 + 4 * fq) = w; }
    }
};
struct EpiResid {
    static constexpr int NPRE = 0; static constexpr bool PERMA = false;
    static constexpr bool PERM = true;
    const float* xin32; float* xout32; bf16_t* xb; const float* gate; int inf32, outf32;
    __device__ __forceinline__ void operator()(const Acc& acc, const Unit& u, int wr, int wc, int fr, int fq) const {
        const int col0 = u.pn * BM + wc * 32 + 8 * fq;
#pragma unroll
        for (int ai = 0; ai < 2; ++ai) {
            const int rbase = u.pm * BM + ai * HALF + wr * 64; const float* gp = gate + (size_t)slot_of_row(rbase) * 12288 + col0;
            const size_t off0 = (size_t)(rbase + fr) * DM + col0;
            f32x4 xi[4][2][2];
            if (inf32) {
#pragma unroll
                for (int m = 0; m < 4; ++m)
#pragma unroll
                    for (int bj = 0; bj < 2; ++bj)
#pragma unroll
                        for (int n = 0; n < 2; ++n) xi[m][bj][n] = *(const f32x4*)(xin32 + off0 + (size_t)m * 16 * DM + bj * HALF + n * 4);
            } else { u32x4 xr[4][2];
#pragma unroll
                for (int m = 0; m < 4; ++m)
#pragma unroll
                    for (int bj = 0; bj < 2; ++bj) xr[m][bj] = *(const u32x4*)(xb + off0 + (size_t)m * 16 * DM + bj * HALF);
#pragma unroll
                for (int m = 0; m < 4; ++m)
#pragma unroll
                    for (int bj = 0; bj < 2; ++bj) { xi[m][bj][0] = (f32x4){bf_lo(xr[m][bj].x), bf_hi(xr[m][bj].x), bf_lo(xr[m][bj].y), bf_hi(xr[m][bj].y)}; xi[m][bj][1] = (f32x4){bf_lo(xr[m][bj].z), bf_hi(xr[m][bj].z), bf_lo(xr[m][bj].w), bf_hi(xr[m][bj].w)}; } }
            f32x4 gv[2][2];
#pragma unroll
            for (int bj = 0; bj < 2; ++bj)
#pragma unroll
                for (int n = 0; n < 2; ++n) gv[bj][n] = *(const f32x4*)(gp + bj * HALF + n * 4);
#pragma unroll
            for (int m = 0; m < 4; ++m)
#pragma unroll
                for (int bj = 0; bj < 2; ++bj) { const f32x4 x0 = xi[m][bj][0] + gv[bj][0] * acc[ai][bj][m][0], x1 = xi[m][bj][1] + gv[bj][1] * acc[ai][bj][m][1]; const size_t o = off0 + (size_t)m * 16 * DM + bj * HALF;
                    if (outf32) { *(f32x4*)(xout32 + o) = x0; *(f32x4*)(xout32 + o + 4) = x1; } else *(u32x4*)(xb + o) = pack8(x0, x1); }
            asm volatile("" ::: "memory");
        }
    }
};
struct EpiGlu {
    static constexpr int NPRE = 0; static constexpr bool PERMA = false;
    static constexpr bool PERM = true;
    bf16_t* xb; const float* gate;
    __device__ __forceinline__ void operator()(const Acc& acc, const Unit& u, int wr, int wc, int fr, int fq) const {
        const int col0 = u.pn * HALF + wc * 32 + 8 * fq;
        u32x4 xr[2][4];
#pragma unroll
        for (int ai = 0; ai < 2; ++ai)
#pragma unroll
            for (int m = 0; m < 4; ++m) xr[ai][m] = *(const u32x4*)(xb + (size_t)(u.pm * BM + ai * HALF + wr * 64 + m * 16 + fr) * DM + col0);
#pragma unroll
        for (int ai = 0; ai < 2; ++ai) {
            const int rbase = u.pm * BM + ai * HALF + wr * 64; const float* gp = gate + (size_t)slot_of_row(rbase) * 12288 + col0;
            f32x4 gv[2];
#pragma unroll
            for (int n = 0; n < 2; ++n) gv[n] = *(const f32x4*)(gp + n * 4);
#pragma unroll
            for (int m = 0; m < 4; ++m) { const size_t off = (size_t)(rbase + m * 16 + fr) * DM + col0; f32x4 o[2];
#pragma unroll
                for (int n = 0; n < 2; ++n) { const f32x4 a = acc[ai][0][m][n], b = acc[ai][1][m][n]; const unsigned lo = n == 0 ? xr[ai][m].x : xr[ai][m].z, hi = n == 0 ? xr[ai][m].y : xr[ai][m].w;
                    const f32x4 xi = (f32x4){bf_lo(lo), bf_hi(lo), bf_lo(hi), bf_hi(hi)};
#pragma unroll
                    for (int j = 0; j < 4; ++j) o[n][j] = xi[j] + gv[n][j] * a[j] * fast_sigmoid(b[j]); }
                *(u32x4*)(xb + off) = pack8(o[0], o[1]); }
        }
    }
};
struct EpiGate {
    static constexpr int NPRE = 0; static constexpr bool PERMA = false;
    static constexpr bool PERM = true;
    bf16_t* G; float* convp; float* convs;
    __device__ __forceinline__ void operator()(const Acc& acc, const Unit& u, int wr, int wc, int fr, int fq) const {
        const int col0 = u.pn * BM + wc * 32 + 8 * fq;
#pragma unroll
        for (int ai = 0; ai < 2; ++ai) {
            const int rbase = u.pm * BM + ai * HALF + wr * 64; const int slot = slot_of_row(rbase);
#pragma unroll
            for (int m = 0; m < 4; ++m) { const int row = rbase + m * 16 + fr; bf16_t* rowp = G + (size_t)(row + 2 * (slot + 1)) * DFF + col0;
#pragma unroll
                for (int bj = 0; bj < 2; ++bj) *(u32x4*)(rowp + bj * HALF) = pack8(acc[ai][bj][m][0], acc[ai][bj][m][1]);
                if (m == 3 && fr >= 14) {
                    const bool lastp = (slot < 4) && ((row & (SEQ - 1)) >= SEQ - 2); const bool lasts = (slot >= 4);
                    if (lastp || lasts) { float* cp = (slot < 4 ? convp + (size_t)(slot * 2 + (row & 1)) * DFF : convs + (size_t)((slot - 4) * 2 + (row & 1)) * DFF) + col0;
#pragma unroll
                        for (int bj = 0; bj < 2; ++bj) { *(f32x4*)(cp + bj * HALF) = acc[ai][bj][m][0]; *(f32x4*)(cp + bj * HALF + 4) = acc[ai][bj][m][1]; } }
                }
            }
        }
    }
};
struct EpiUp {
    static constexpr int NPRE = 0; static constexpr bool PERMA = false;
    static constexpr bool PERM = true;
    const bf16_t* G; bf16_t* HID; const float* cw; const float* cb;
    __device__ __forceinline__ void operator()(const Acc& acc, const Unit& u, int wr, int wc, int fr, int fq) const {
        u32x4 ga[3], gb[3];
        const bf16_t* gbase = G + (size_t)(u.pm * BM + wr * 64 + fr) * DFF + u.pn * BM + wc * 32 + 8 * fq;
        const int sl0 = 2 * (slot_of_row(u.pm * BM + wr * 64) + 1), sl1 = 2 * (slot_of_row(u.pm * BM + HALF + wr * 64) + 1);
#define EU_LOAD(DST, B) do { const bf16_t* gp_ = gbase + (size_t)((((B) >> 2) & 1) * HALF + ((B) & 3) * 16 + ((((B) >> 2) & 1) ? sl1 : sl0)) * DFF + ((B) >> 3) * HALF; \
            DST[2] = *(const u32x4*)gp_; DST[1] = *(const u32x4*)(gp_ - DFF); DST[0] = *(const u32x4*)(gp_ - 2 * DFF); } while (0)
#define EU_COMP(SRC, B) do { constexpr int bj_ = (B) >> 3, ai_ = ((B) >> 2) & 1, m_ = (B) & 3; const int col_ = u.pn * BM + bj_ * HALF + wc * 32 + 8 * fq; \
            const int row_ = u.pm * BM + ai_ * HALF + wr * 64 + m_ * 16 + fr; float o_[8]; \
            _Pragma("unroll") for (int q = 0; q < 4; ++q) { \
                const float c0 = bb[2 * q] + w0[2 * q] * bf_lo(SRC[0][q]) + w1[2 * q] * bf_lo(SRC[1][q]) + w2[2 * q] * bf_lo(SRC[2][q]); \
                const float c1 = bb[2 * q + 1] + w0[2 * q + 1] * bf_hi(SRC[0][q]) + w1[2 * q + 1] * bf_hi(SRC[1][q]) + w2[2 * q + 1] * bf_hi(SRC[2][q]); \
                o_[2 * q] = c0 * fast_sigmoid(c0); o_[2 * q + 1] = c1 * fast_sigmoid(c1); } \
            const f32x4 a0 = acc[ai_][bj_][m_][0], a1 = acc[ai_][bj_][m_][1]; \
            u32x4 w_; w_.x = cvt_pk_bf16(o_[0] * a0[0], o_[1] * a0[1]); w_.y = cvt_pk_bf16(o_[2] * a0[2], o_[3] * a0[3]); w_.z = cvt_pk_bf16(o_[4] * a1[0], o_[5] * a1[1]); w_.w = cvt_pk_bf16(o_[6] * a1[2], o_[7] * a1[3]); \
            *(u32x4*)(HID + tiled_off(row_, col_, DFF / 64)) = w_; } while (0)
#define EU_PARAMS(BJ) do { const int col_ = u.pn * BM + (BJ) * HALF + wc * 32 + 8 * fq; _Pragma("unroll") for (int h = 0; h < 2; ++h) { const f32x4 a = *(const f32x4*)(cw + col_ + 4 * h), b = *(const f32x4*)(cw + DFF + col_ + 4 * h), c = *(const f32x4*)(cw + 2 * DFF + col_ + 4 * h), d = *(const f32x4*)(cb + col_ + 4 * h); \
            _Pragma("unroll") for (int j = 0; j < 4; ++j) { w0[4 * h + j] = a[j]; w1[4 * h + j] = b[j]; w2[4 * h + j] = c[j]; bb[4 * h + j] = d[j]; } } } while (0)
#define EU_STEP2(B) do { EU_LOAD(gb, (B) + 1); asm volatile("" ::: "memory"); EU_COMP(ga, B); EU_LOAD(ga, (B) + 2); asm volatile("" ::: "memory"); EU_COMP(gb, (B) + 1); } while (0)
        float w0[8], w1[8], w2[8], bb[8];
        EU_LOAD(ga, 0); EU_PARAMS(0);
        EU_STEP2(0); EU_STEP2(2); EU_STEP2(4);
        EU_LOAD(gb, 7); asm volatile("" ::: "memory"); EU_COMP(ga, 6); EU_LOAD(ga, 8); asm volatile("" ::: "memory"); EU_COMP(gb, 7);
        EU_PARAMS(1);
        EU_STEP2(8); EU_STEP2(10); EU_STEP2(12);
        EU_LOAD(gb, 15); asm volatile("" ::: "memory"); EU_COMP(ga, 14); EU_COMP(gb, 15);
#undef EU_LOAD
#undef EU_COMP
#undef EU_PARAMS
#undef EU_STEP2
    }
};
template <int CTRL> __device__ __forceinline__ float dpp_upd(float old, float src) { return __int_as_float(__builtin_amdgcn_update_dpp(__float_as_int(old), __float_as_int(src), CTRL, 0xF, 0xF, false)); }
template <int CTRL> __device__ __forceinline__ float dpp_rot(float src) { return __int_as_float(__builtin_amdgcn_mov_dpp(__float_as_int(src), CTRL, 0xF, 0xF, true)); }
struct EpiFfn {
    static constexpr bool PERM = true; static constexpr bool PERMA = true;
    static constexpr int NPRE = 1;
    __device__ __forceinline__ void prefetch(LAS unsigned char* lds, const Unit& u, int wid, int lane) const { const int a = wid >> 1; const float* src = (a < 3 ? cw + (size_t)a * DFF : cb) + u.pn * HALF + (wid & 1) * 64 + lane;
        __builtin_amdgcn_global_load_lds((const unsigned*)src, (LAS unsigned*)(lds + PAR_OFF + wid * 256), 4, 0, 0); }
    bf16_t* HID; const float* cw; const float* cb; float* convp; float* gbnd; float* defc; float* defu; LAS float* scr;
    __device__ __forceinline__ void operator()(const Acc& acc, const Unit& u, int wr, int wc, int fr, int fq) const {
        const int ch0 = u.pn * HALF + wc * 32 + 8 * fq;
#pragma unroll
        for (int ai = 0; ai < 2; ++ai) { const int k = ai * 2 + wr;
            if (fr == 15) {
#pragma unroll
                for (int rr = 0; rr < 2; ++rr) {
                    if (k < 3) { LAS float* p = scr + ((((k * 4 + wc) * 4 + fq) * 2 + rr) * 8); *(LAS f32x4*)p = acc[ai][0][2 + rr][0]; *(LAS f32x4*)(p + 4) = acc[ai][0][2 + rr][1]; }
                    else { float* p = gbnd + (size_t)(u.pm * 2 + rr) * DFF + ch0; *(f32x4*)p = acc[ai][0][2 + rr][0]; *(f32x4*)(p + 4) = acc[ai][0][2 + rr][1];
                        if ((u.pm & 31) == 31) { float* cp = convp + (size_t)((u.pm >> 5) * 2 + rr) * DFF + ch0; *(f32x4*)cp = acc[ai][0][2 + rr][0]; *(f32x4*)(cp + 4) = acc[ai][0][2 + rr][1]; } } } } }
        float w0[8], w1[8], w2[8], bb[8];
        { const LAS float* par = (const LAS float*)((LAS unsigned char*)scr + 4096) + wc * 32 + 8 * fq;
#pragma unroll
        for (int h = 0; h < 2; ++h) { const f32x4 a = *(const LAS f32x4*)(par + 4 * h), b = *(const LAS f32x4*)(par + 128 + 4 * h), c = *(const LAS f32x4*)(par + 256 + 4 * h), d = *(const LAS f32x4*)(par + 384 + 4 * h);
#pragma unroll
            for (int j = 0; j < 4; ++j) { w0[4 * h + j] = -1.4426950408889634f * a[j]; w1[4 * h + j] = -1.4426950408889634f * b[j]; w2[4 * h + j] = -1.4426950408889634f * c[j]; bb[4 * h + j] = -1.4426950408889634f * d[j]; } } }
        asm volatile("s_waitcnt lgkmcnt(0)\n\ts_barrier" ::: "memory");
#pragma unroll
        for (int ai = 0; ai < 2; ++ai) { const int k = ai * 2 + wr;
            float bm1[8], bm2[8];
            if (k >= 1) { const LAS float* p = scr + ((((k - 1) * 4 + wc) * 4 + fq) * 2) * 8; const f32x4 a = *(const LAS f32x4*)p, b = *(const LAS f32x4*)(p + 4), c = *(const LAS f32x4*)(p + 8), d = *(const LAS f32x4*)(p + 12);
#pragma unroll
                for (int j = 0; j < 4; ++j) { bm2[j] = a[j]; bm2[4 + j] = b[j]; bm1[j] = c[j]; bm1[4 + j] = d[j]; } }
            else {
#pragma unroll
                for (int e = 0; e < 8; ++e) { bm1[e] = 0.f; bm2[e] = 0.f; } }
            float s3[8], s2[8];
#pragma unroll
            for (int n = 0; n < 2; ++n)
#pragma unroll
                for (int j = 0; j < 4; ++j) { const int e = 4 * n + j; s3[e] = dpp_upd<0x111>(bm1[e], acc[ai][0][3][n][j]); s2[e] = dpp_upd<0x111>(bm2[e], acc[ai][0][2][n][j]); }
#pragma unroll
            for (int m = 0; m < 4; ++m) { const int row = u.pm * BM + ai * HALF + wr * 64 + 4 * fr + m;
                float cc[8], o[8];
#pragma unroll
                for (int n = 0; n < 2; ++n)
#pragma unroll
                    for (int j = 0; j < 4; ++j) { const int e = 4 * n + j; const float g = acc[ai][0][m][n][j];
                        const float g1 = m == 0 ? s3[e] : acc[ai][0][m > 0 ? m - 1 : 0][n][j], g2 = m == 0 ? s2[e] : (m == 1 ? s3[e] : acc[ai][0][m > 1 ? m - 2 : 0][n][j]);
                        const float c = bb[e] + w0[e] * g2 + w1[e] * g1 + w2[e] * g; cc[e] = c; o[e] = c * __builtin_amdgcn_rcpf(1.0f + __builtin_amdgcn_exp2f(c)) * acc[ai][1][m][n][j]; }
                u32x4 w_; w_.x = cvt_pk_bf16(o[0], o[1]); w_.y = cvt_pk_bf16(o[2], o[3]); w_.z = cvt_pk_bf16(o[4], o[5]); w_.w = cvt_pk_bf16(o[6], o[7]);
                *(u32x4*)(HID + tiled_off(row, ch0, DFF / 64)) = w_;
                if (m < 2 && k == 0 && fr == 0) { float* pc = defc + (size_t)(u.pm * 2 + m) * DFF + ch0; float* pu = defu + (size_t)(u.pm * 2 + m) * DFF + ch0;
                    *(f32x4*)pc = (f32x4){cc[0], cc[1], cc[2], cc[3]}; *(f32x4*)(pc + 4) = (f32x4){cc[4], cc[5], cc[6], cc[7]}; *(f32x4*)pu = acc[ai][1][m][0]; *(f32x4*)(pu + 4) = acc[ai][1][m][1]; } }
        }
    }
};
struct EpiPartial {
    static constexpr int NPRE = 0; static constexpr bool PERMA = false;
    static constexpr bool PERM = false;
    float* P; int ldc;
    __device__ __forceinline__ void operator()(const Acc& acc, const Unit& u, int wr, int wc, int fr, int fq) const {
        const int row0 = (u.pm - 128) * BM + wr * 64 + fr, col0 = u.pn * BM + wc * 32 + 4 * fq;
        float* base = P + ((size_t)u.ks * 512 + row0) * ldc + col0;
#pragma unroll
        for (int ai = 0; ai < 2; ++ai)
#pragma unroll
            for (int m = 0; m < 4; ++m) { float* rowp = base + (size_t)(ai * HALF + m * 16) * ldc;
#pragma unroll
                for (int bj = 0; bj < 2; ++bj)
#pragma unroll
                    for (int n = 0; n < 2; ++n) *(f32x4*)(rowp + bj * HALF + n * 16) = acc[ai][bj][m][n]; }
    }
};
struct EpiXloc {
    static constexpr int NPRE = 0; static constexpr bool PERMA = false;
    static constexpr bool PERM = true;
    bf16_t* X;
    __device__ __forceinline__ void operator()(const Acc& acc, const Unit& u, int wr, int wc, int fr, int fq) const {
        const int row0 = u.pm * BM + wr * 64 + fr, col0 = wc * 32 + 8 * fq;
#pragma unroll
        for (int ai = 0; ai < 2; ++ai)
#pragma unroll
            for (int m = 0; m < 4; ++m) *(u32x4*)(X + (size_t)(row0 + ai * HALF + m * 16) * 128 + col0) = pack8(acc[ai][0][m][0], acc[ai][0][m][1]);
    }
};
struct EpiY {
    static constexpr int NPRE = 0; static constexpr bool PERMA = false;
    static constexpr bool PERM = true;
    const bf16_t* UP; bf16_t* Z; const float* Dv;
    __device__ __forceinline__ void operator()(const Acc& acc, const Unit& u, int wr, int wc, int fr, int fq) const {
        const int g = u.pn, cbase = (u.pm - 9 * g) * BM;
        const int q0 = (8 * fq) & 15;
        const f32x4 d0 = *(const f32x4*)(Dv + 16 * g + q0), d1 = *(const f32x4*)(Dv + 16 * g + q0 + 4);
#pragma unroll
        for (int ai = 0; ai < 2; ++ai) {
            const int c0 = cbase + ai * HALF + wr * 64 + fr;
            u32x4 uq[4][2];
#pragma unroll
            for (int m = 0; m < 4; ++m) { const int c = c0 + m * 16 < 2080 ? c0 + m * 16 : 2079;
#pragma unroll
                for (int bj = 0; bj < 2; ++bj) uq[m][bj] = *(const u32x4*)(UP + ((size_t)g * NSUB + c) * 384 + bj * HALF + wc * 32 + 8 * fq); }
#pragma unroll
            for (int m = 0; m < 4; ++m) { const int c = c0 + m * 16;
                if (c < 2080) {
#pragma unroll
                    for (int bj = 0; bj < 2; ++bj) { const int cc = bj * HALF + wc * 32 + 8 * fq; const int t = cc >> 4;
                        const u32x4 uu = uq[m][bj];
                        const f32x4 a0 = acc[ai][bj][m][0], a1 = acc[ai][bj][m][1];
                        float y[8];
                        y[0] = a0[0] + d0[0] * bf_lo(uu[0]); y[1] = a0[1] + d0[1] * bf_hi(uu[0]); y[2] = a0[2] + d0[2] * bf_lo(uu[1]); y[3] = a0[3] + d0[3] * bf_hi(uu[1]);
                        y[4] = a1[0] + d1[0] * bf_lo(uu[2]); y[5] = a1[1] + d1[1] * bf_hi(uu[2]); y[6] = a1[2] + d1[2] * bf_lo(uu[3]); y[7] = a1[3] + d1[3] * bf_hi(uu[3]);
#pragma unroll
                        for (int j = 0; j < 8; ++j) { const float v = y[j]; const float w2 = v * (-2.3022081983f + -0.1029432395f * (v * v)); y[j] = v * __builtin_amdgcn_rcpf(1.0f + __builtin_amdgcn_exp2f(w2)); }
                        u32x4 w; w.x = cvt_pk_bf16(y[0], y[1]); w.y = cvt_pk_bf16(y[2], y[3]); w.z = cvt_pk_bf16(y[4], y[5]); w.w = cvt_pk_bf16(y[6], y[7]);
                        *(u32x4*)(Z + (size_t)(16 * c + t) * DM + 16 * g + q0) = w; }
                } }
            asm volatile("" ::: "memory");
        }
    }
};
}

namespace att {
constexpr int SHM_V = 64 * 128 * 2, SHM_K = 64 * 384, OFF_V = 0, OFF_K = 3 * SHM_V, OFF_SCR = OFF_K + 3 * SHM_K, ATT_LDS = OFF_SCR + 8 * 256;
static_assert(ATT_LDS <= 131072, "attention LDS");
constexpr float THR2 = 11.54f;
#define SBAR() __builtin_amdgcn_sched_barrier(0)
__device__ __forceinline__ int crow(int r, int hi) { return (r & 3) + 8 * (r >> 2) + 4 * hi; }
__device__ __forceinline__ int kswz(int row, int c16) { return row * 384 + ((c16 ^ ((row >> 1) & 7)) << 4); }
template <bool FX> __device__ __forceinline__ void partialSM(f32x16& p0, f32x16& p1, float& m_reg, float& mn, float& alpha, bool vis) {
  if (!vis) {
#pragma unroll
    for (int r = 0; r < 16; ++r) { p0[r] = -__builtin_inff(); p1[r] = -__builtin_inff(); } }
  if constexpr (FX) { mn = 0.f; alpha = 1.f;
#pragma unroll
    for (int r = 0; r < 16; ++r) p0[r] = __builtin_amdgcn_exp2f(p0[r]);
    return; }
  float pmax = p0[0];
#pragma unroll
  for (int r = 1; r < 16; ++r) pmax = fmaxf(pmax, p0[r]);
#pragma unroll
  for (int r = 0; r < 16; ++r) pmax = fmaxf(pmax, p1[r]);
  { auto rr = __builtin_amdgcn_permlane32_swap(__float_as_uint(pmax), __float_as_uint(pmax), false, false);
    pmax = fmaxf(__uint_as_float(rr[0]), __uint_as_float(rr[1])); }
  if (__builtin_expect(__all(pmax - m_reg <= THR2), 1)) { mn = m_reg; alpha = 1.f; }
  else { mn = fmaxf(m_reg, pmax); alpha = __builtin_amdgcn_exp2f(m_reg - mn); m_reg = mn; }
#pragma unroll
  for (int r = 0; r < 16; ++r) p0[r] = __builtin_amdgcn_exp2f(p0[r] - mn);
#pragma unroll
  for (int r = 0; r < 16; ++r) p1[r] = p1[r] - mn;
}
__device__ __forceinline__ void finishSM(f32x16& p0, f32x16& p1, float alpha, float& l_reg, bf16x8& pa0, bf16x8& pa1, bf16x8& pa2, bf16x8& pa3) {
#pragma unroll
  for (int r = 0; r < 16; ++r) p1[r] = __builtin_amdgcn_exp2f(p1[r]);
  float ps = 0;
#pragma unroll
  for (int r = 0; r < 16; ++r) ps += p0[r];
#pragma unroll
  for (int r = 0; r < 16; ++r) ps += p1[r];
  { auto rr = __builtin_amdgcn_permlane32_swap(__float_as_uint(ps), __float_as_uint(ps), false, false);
    ps = __uint_as_float(rr[0]) + __uint_as_float(rr[1]); }
  l_reg = l_reg * alpha + ps;
#define PK4(P, BASE, OUT) do { unsigned a0 = cvt_pk_bf16(P[BASE + 0], P[BASE + 1]), a1 = cvt_pk_bf16(P[BASE + 2], P[BASE + 3]);   \
    unsigned b0 = cvt_pk_bf16(P[BASE + 4], P[BASE + 5]), b1 = cvt_pk_bf16(P[BASE + 6], P[BASE + 7]);                              \
    auto r0 = __builtin_amdgcn_permlane32_swap(a0, b0, false, false); auto r1 = __builtin_amdgcn_permlane32_swap(a1, b1, false, false); \
    u32x4 w = {r0[0], r1[0], r0[1], r1[1]}; OUT = *reinterpret_cast<bf16x8*>(&w); } while (0)
  PK4(p0, 0, pa0); PK4(p0, 8, pa1); PK4(p1, 0, pa2); PK4(p1, 8, pa3);
#undef PK4
}
__device__ __forceinline__ void qkt(f32x16& p0, f32x16& p1, const bf16x8* qr, const int* kb, int so) {
  p0 = f32x16{}; p1 = f32x16{};
  const int k0 = kb[0] + so, k1 = kb[1] + so, k2 = kb[2] + so, k3 = kb[3] + so;
  bf16x8 fa[4], fb[4];
#define KADDR(d0) (((d0) & 3) == 0 ? k0 : ((d0) & 3) == 1 ? k1 : ((d0) & 3) == 2 ? k2 : k3)
#define LOADK(F, d0) do { F[0] = *(const LAS bf16x8*)(uintptr_t)(unsigned)(KADDR(d0) + ((d0) >> 2) * 128); F[1] = *(const LAS bf16x8*)(uintptr_t)(unsigned)(KADDR(d0) + ((d0) >> 2) * 128 + 32 * 384); \
    F[2] = *(const LAS bf16x8*)(uintptr_t)(unsigned)(KADDR((d0) + 1) + (((d0) + 1) >> 2) * 128); F[3] = *(const LAS bf16x8*)(uintptr_t)(unsigned)(KADDR((d0) + 1) + (((d0) + 1) >> 2) * 128 + 32 * 384); } while (0)
#define MMAK(F, d0) do { p0 = __builtin_amdgcn_mfma_f32_32x32x16_bf16(F[0], qr[d0], p0, 0, 0, 0); p1 = __builtin_amdgcn_mfma_f32_32x32x16_bf16(F[1], qr[d0], p1, 0, 0, 0); \
    p0 = __builtin_amdgcn_mfma_f32_32x32x16_bf16(F[2], qr[(d0) + 1], p0, 0, 0, 0); p1 = __builtin_amdgcn_mfma_f32_32x32x16_bf16(F[3], qr[(d0) + 1], p1, 0, 0, 0); } while (0)
  LOADK(fa, 0); SBAR(); LOADK(fb, 2); SBAR();
  MMAK(fa, 0); SBAR(); LOADK(fa, 4); SBAR();
  MMAK(fb, 2); SBAR(); LOADK(fb, 6); SBAR();
  MMAK(fa, 4); SBAR(); LOADK(fa, 8); SBAR();
  MMAK(fb, 6); SBAR(); LOADK(fb, 10); SBAR();
  MMAK(fa, 8); SBAR();
  MMAK(fb, 10); SBAR();
#undef KADDR
#undef LOADK
#undef MMAK
}
__device__ __forceinline__ int v_st(int k, int c) { const int kk = (k & ~0xC) | ((k & 4) << 1) | ((k & 8) >> 1); return ((kk >> 3) * 4 + (c >> 5)) * 512 + ((kk & 7) * 32 + (c & 31)) * 2; }
__device__ __forceinline__ int v_rd_base(int lane) { return ((lane & 3) << 3) | (((lane >> 2) & 3) << 6) | (((lane >> 4) & 1) << 5) | (((lane >> 5) & 1) << 8); }
constexpr int v_rd_off(int d0, int ks, int half) { return d0 * 512 + ks * 4096 + half * 2048; }
typedef short v4i16_t __attribute__((ext_vector_type(4)));
template <int OFF> __device__ __forceinline__ s16x4 tr_read(int vb) {
  return __builtin_bit_cast(s16x4, __builtin_amdgcn_ds_read_tr16_b64_v4i16((LAS v4i16_t*)(uintptr_t)(unsigned)(vb + OFF)));
}
template <int D0> __device__ __forceinline__ void pv_load(s16x4* f, int vb) {
  f[0] = tr_read<v_rd_off(D0, 0, 0)>(vb); f[1] = tr_read<v_rd_off(D0, 0, 1)>(vb); f[2] = tr_read<v_rd_off(D0, 1, 0)>(vb); f[3] = tr_read<v_rd_off(D0, 1, 1)>(vb);
  f[4] = tr_read<v_rd_off(D0, 2, 0)>(vb); f[5] = tr_read<v_rd_off(D0, 2, 1)>(vb); f[6] = tr_read<v_rd_off(D0, 3, 0)>(vb); f[7] = tr_read<v_rd_off(D0, 3, 1)>(vb);
}
__device__ __forceinline__ void pv_mma(f32x16& od, const s16x4* f, bf16x8 pa0, bf16x8 pa1, bf16x8 pa2, bf16x8 pa3) {
#define PK(L, H) (bf16x8){L[0], L[1], L[2], L[3], H[0], H[1], H[2], H[3]}
  od = __builtin_amdgcn_mfma_f32_32x32x16_bf16(pa0, PK(f[0], f[1]), od, 0, 0, 0);
  od = __builtin_amdgcn_mfma_f32_32x32x16_bf16(pa1, PK(f[2], f[3]), od, 0, 0, 0);
  od = __builtin_amdgcn_mfma_f32_32x32x16_bf16(pa2, PK(f[4], f[5]), od, 0, 0, 0);
  od = __builtin_amdgcn_mfma_f32_32x32x16_bf16(pa3, PK(f[6], f[7]), od, 0, 0, 0);
#undef PK
}
__device__ __forceinline__ void pv_d0(f32x16* o, int vb, bf16x8 pa0, bf16x8 pa1, bf16x8 pa2, bf16x8 pa3) {
  s16x4 va[8], vbf[8];
  pv_load<0>(va, vb); SBAR(); pv_load<1>(vbf, vb); SBAR();
  pv_mma(o[0], va, pa0, pa1, pa2, pa3); SBAR(); pv_load<2>(va, vb); SBAR();
  pv_mma(o[1], vbf, pa0, pa1, pa2, pa3); SBAR(); pv_load<3>(vbf, vb); SBAR();
  pv_mma(o[2], va, pa0, pa1, pa2, pa3); SBAR();
  pv_mma(o[3], vbf, pa0, pa1, pa2, pa3); SBAR();
}
__device__ __forceinline__ int k_src(int s) { const int row = s / 24, cp = s - row * 24, c = cp ^ ((row >> 1) & 7); return row * 5120 + c * 8; }
__device__ __forceinline__ int v_src(int s) { const int sub = s >> 5, w = s & 31, kk = (sub >> 2) * 8 + (w >> 2), c = (sub & 3) * 32 + (w & 3) * 8; const int k = (kk & ~0xC) | ((kk & 4) << 1) | ((kk & 8) >> 1); return k * 5120 + c; }
template <bool FX> __device__ __forceinline__ void attn_unit(const bf16_t* __restrict__ Qb, const bf16_t* __restrict__ Kh, const bf16_t* __restrict__ Vh, bf16_t* __restrict__ Ob,
                                          int NT, int NTreal, int nvis, int wq, int rev, LAS char* lds, const int tid, const float* __restrict__ gqn, const float* __restrict__ rope, int pos0) {
  int lane_ = tid & 63; asm volatile("" : "+v"(lane_));
  const int wid = __builtin_amdgcn_readfirstlane(tid >> 6), lane = lane_, r32 = lane & 31, hi = lane >> 5, grp = wid >> 2;
  LAS char* V_lds = lds + OFF_V; LAS char* K_lds = lds + OFF_K;
  LAS float* ws = (LAS float*)(lds + OFF_SCR) + wid * 64; LAS float* li_l = ws; LAS float* al_l = ws + 32;
  float m_reg = -1e30f, l_reg = 0; f32x16 o[4] = {}; bf16x8 qr[12];
  const bf16_t* Qw = Qb + (size_t)(wq * 32 + r32) * 3072 + hi * 8;
  {
    u32x4 raw[12];
#pragma unroll
    for (int d0 = 0; d0 < 12; ++d0) raw[d0] = *(const u32x4*)(Qw + d0 * 16);
    float ss = 0.f;
#pragma unroll
    for (int d0 = 0; d0 < 12; ++d0)
#pragma unroll
      for (int e = 0; e < 4; ++e) { const float a = bf_lo(raw[d0][e]), b = bf_hi(raw[d0][e]); ss += a * a + b * b; }
    { auto rr = __builtin_amdgcn_permlane32_swap(__float_as_uint(ss), __float_as_uint(ss), false, false); ss = __uint_as_float(rr[0]) + __uint_as_float(rr[1]); }
    const float rq = (1.0f / sqrtf(ss * (1.0f / 192.0f) + EPS)) * (0.07216878364870323f * 1.4426950408889634f);
#pragma unroll
    for (int d0 = 0; d0 < 8; ++d0) { const f32x4 g0 = *(const f32x4*)(gqn + d0 * 16 + hi * 8), g1 = *(const f32x4*)(gqn + d0 * 16 + hi * 8 + 4); u32x4 w;
      w.x = cvt_pk_bf16(bf_lo(raw[d0][0]) * rq * g0[0], bf_hi(raw[d0][0]) * rq * g0[1]); w.y = cvt_pk_bf16(bf_lo(raw[d0][1]) * rq * g0[2], bf_hi(raw[d0][1]) * rq * g0[3]);
      w.z = cvt_pk_bf16(bf_lo(raw[d0][2]) * rq * g1[0], bf_hi(raw[d0][2]) * rq * g1[1]); w.w = cvt_pk_bf16(bf_lo(raw[d0][3]) * rq * g1[2], bf_hi(raw[d0][3]) * rq * g1[3]);
      qr[d0] = *reinterpret_cast<bf16x8*>(&w); }
    const float* rt = rope + (size_t)(pos0 + wq * 32 + r32) * 64;
#pragma unroll
    for (int dd = 0; dd < 2; ++dd) {
      u32x4 w1, w2;
#pragma unroll
      for (int e2 = 0; e2 < 4; ++e2) { const int j = 16 * dd + 8 * hi + 2 * e2;
        const f32x4 cs = *(const f32x4*)(rt + 2 * j);
        const f32x2 ga = *(const f32x2*)(gqn + 128 + j), gb = *(const f32x2*)(gqn + 160 + j);
        const float x10 = bf_lo(raw[8 + dd][e2]) * rq * ga.x, x11 = bf_hi(raw[8 + dd][e2]) * rq * ga.y, x20 = bf_lo(raw[10 + dd][e2]) * rq * gb.x, x21 = bf_hi(raw[10 + dd][e2]) * rq * gb.y;
        w1[e2] = cvt_pk_bf16(x10 * cs[0] - x20 * cs[1], x11 * cs[2] - x21 * cs[3]);
        w2[e2] = cvt_pk_bf16(x10 * cs[1] + x20 * cs[0], x11 * cs[3] + x21 * cs[2]); }
      qr[8 + dd] = *reinterpret_cast<bf16x8*>(&w1); qr[10 + dd] = *reinterpret_cast<bf16x8*>(&w2); }
  }
  int kb[4];
#pragma unroll
  for (int v = 0; v < 4; ++v) kb[v] = (int)(uintptr_t)K_lds + r32 * 384 + ((((2 * v) | hi) ^ ((r32 >> 1) & 7)) << 4);
  unsigned kg[3], vg[2];
#pragma unroll
  for (int i = 0; i < 3; ++i) kg[i] = (unsigned)k_src((wid * 3 + i) * 64 + lane) * 2u;
#pragma unroll
  for (int i = 0; i < 2; ++i) vg[i] = (unsigned)v_src((wid * 2 + i) * 64 + lane) * 2u;
  const int vb0 = (int)(uintptr_t)V_lds + v_rd_base(lane);
#define DMA(jt, st) do { const int _p = rev ? NT - 1 - (jt) : (jt); const int _t = _p < NTreal ? _p : NTreal - 1; const char* _k = (const char*)(Kh + (size_t)_t * 64 * 5120); const char* _v = (const char*)(Vh + (size_t)_t * 64 * 5120); \
    _Pragma("unroll") for (int _i = 0; _i < 3; ++_i) __builtin_amdgcn_global_load_lds((const unsigned*)(_k + kg[_i]), (LAS unsigned*)(K_lds + (st) * SHM_K + (wid * 3 + _i) * 1024), 16, 0, 0); \
    _Pragma("unroll") for (int _i = 0; _i < 2; ++_i) __builtin_amdgcn_global_load_lds((const unsigned*)(_v + vg[_i]), (LAS unsigned*)(V_lds + (st) * SHM_V + (wid * 2 + _i) * 1024), 16, 0, 0); } while (0)
#define WAITBAR(N) asm volatile("s_waitcnt vmcnt(" #N ")\n\ts_barrier" ::: "memory")
#define RESC(a) do { if constexpr (!FX) if (__any((a) < 1.f)) { if (hi == 0) al_l[r32] = (a); asm volatile("s_waitcnt lgkmcnt(0)" ::: "memory"); \
    _Pragma("unroll") for (int d = 0; d < 4; ++d) _Pragma("unroll") for (int r = 0; r < 16; ++r) o[d][r] *= al_l[crow(r, hi)]; } } while (0)
#define VIS(j) ((rev ? NT - 1 - (j) : (j)) < nvis)
  if (grp) __builtin_amdgcn_s_setprio(1);
  f32x16 pA0, pA1, pB0, pB1; float mnA, mnB, alA, alB; bf16x8 pa0, pa1, pa2, pa3;
  int sp = 0, sc = 1, sn = 2;
  DMA(0, 0); DMA(1, 1);
  WAITBAR(5);
  if (VIS(0)) qkt(pA0, pA1, qr, kb, 0);
  partialSM<FX>(pA0, pA1, m_reg, mnA, alA, VIS(0));
  for (int j = 1; j + 1 < NT; j += 2) {
    WAITBAR(0);
    DMA(j + 1, sn);
    SBAR(); if (VIS(j)) qkt(pB0, pB1, qr, kb, sc * SHM_K);
    finishSM(pA0, pA1, alA, l_reg, pa0, pa1, pa2, pa3); SBAR();
    if (VIS(j - 1)) pv_d0(o, vb0 + sp * SHM_V, pa0, pa1, pa2, pa3);
    partialSM<FX>(pB0, pB1, m_reg, mnB, alB, VIS(j));
    RESC(alB);
    { const int t = sp; sp = sc; sc = sn; sn = t; }
    WAITBAR(0);
    DMA(j + 2, sn);
    SBAR(); if (VIS(j + 1)) qkt(pA0, pA1, qr, kb, sc * SHM_K);
    finishSM(pB0, pB1, alB, l_reg, pa0, pa1, pa2, pa3); SBAR();
    if (VIS(j)) pv_d0(o, vb0 + sp * SHM_V, pa0, pa1, pa2, pa3);
    partialSM<FX>(pA0, pA1, m_reg, mnA, alA, VIS(j + 1));
    RESC(alA);
    { const int t = sp; sp = sc; sc = sn; sn = t; }
  }
  WAITBAR(0);
  SBAR(); if (VIS(NT - 1)) qkt(pB0, pB1, qr, kb, sc * SHM_K);
  finishSM(pA0, pA1, alA, l_reg, pa0, pa1, pa2, pa3); SBAR();
  if (VIS(NT - 2)) pv_d0(o, vb0 + sp * SHM_V, pa0, pa1, pa2, pa3);
  partialSM<FX>(pB0, pB1, m_reg, mnB, alB, VIS(NT - 1));
  RESC(alB);
  finishSM(pB0, pB1, alB, l_reg, pa0, pa1, pa2, pa3); SBAR();
  if (VIS(NT - 1)) pv_d0(o, vb0 + sc * SHM_V, pa0, pa1, pa2, pa3);
  if (nvis > 0) {
    if (hi == 0) li_l[r32] = l_reg; asm volatile("s_waitcnt lgkmcnt(0)" ::: "memory");
    bf16_t* Ow = Ob + (size_t)(wq * 32) * 2048;
    const bool odd = (lane & 1) != 0;
#pragma unroll
    for (int r = 0; r < 16; r += 2) {
      const float ra = __builtin_amdgcn_rcpf(li_l[crow(r, hi)]), rb = __builtin_amdgcn_rcpf(li_l[crow(r + 1, hi)]);
      const int orow = odd ? crow(r + 1, hi) : crow(r, hi);
#pragma unroll
      for (int d0 = 0; d0 < 4; ++d0) {
        const float e = o[d0][r] * ra, f = o[d0][r + 1] * rb;
        const float keep = odd ? f : e, send = odd ? e : f;
        const float got = __int_as_float(__builtin_amdgcn_mov_dpp(__float_as_int(send), 0xB1, 0xF, 0xF, true));
        const unsigned w = odd ? cvt_pk_bf16(got, keep) : cvt_pk_bf16(keep, got);
        *(unsigned*)(Ow + (size_t)orow * 2048 + d0 * 32 + (r32 & ~1)) = w; } }
  }
  __builtin_amdgcn_s_setprio(0);
  asm volatile("s_waitcnt lgkmcnt(0)\n\ts_barrier" ::: "memory");
#undef DMA
#undef VIS
#undef WAITBAR
#undef RESC
}
}

#define XB_TMO      128
#define XB_XCNT(j)  (256  + 64 * (j))
#define XB_XSUB(j)  (1280 + 64 * (j))
#define XB_XGEN(j)  (2304 + 64 * (j))
#define XB_TOP      3328
#define XB_TOPGEN   3392
#define XCD_BAR_WORDS 3456
#define XB_SPIN_CAP (1u << 18)
__device__ __forceinline__ unsigned xb_ld(unsigned* p)              { return __hip_atomic_load(p, __ATOMIC_RELAXED, __HIP_MEMORY_SCOPE_AGENT); }
__device__ __forceinline__ unsigned xb_add(unsigned* p, unsigned v) { return __hip_atomic_fetch_add(p, v, __ATOMIC_RELAXED, __HIP_MEMORY_SCOPE_AGENT); }
__device__ __forceinline__ unsigned xb_xcc_id() { return (unsigned)__builtin_amdgcn_s_getreg((3 << 11) | 20) & 0xFu; }
#define XB_SPIN(cond, bar) do { unsigned _sp = 0; while (cond) { __builtin_amdgcn_s_sleep(1); \
    if ((++_sp & 255u) == 0u) { if (xb_ld(&(bar)[XB_TMO])) break; if (_sp > XB_SPIN_CAP) { atomicAdd(&(bar)[XB_TMO], 1u); break; } } } } while (0)
struct XcdBarrier { unsigned* bar; unsigned x; volatile LAS unsigned* st; };
__device__ __forceinline__ XcdBarrier xcd_barrier_post(unsigned* bar, volatile LAS unsigned* st) {
    XcdBarrier b; b.bar = bar; b.x = xb_xcc_id(); b.st = st;
    if (threadIdx.x == 0) (void)xb_add(&bar[XB_XCNT(b.x)], 1u);
    return b;
}
__device__ __forceinline__ void xcd_barrier_complete(unsigned* bar, unsigned x, unsigned& nloc, unsigned& nx) {
    const unsigned G = gridDim.x * gridDim.y * gridDim.z;
    unsigned sum, cnt, mine, sp = 0u;
    for (;;) {
        sum = 0u; cnt = 0u; mine = 0u;
#pragma unroll
        for (unsigned j = 0; j < 16; ++j) { const unsigned c = xb_ld(&bar[XB_XCNT(j)]); sum += c; cnt += (c > 0u) ? 1u : 0u; mine = (j == x) ? c : mine; }
        if (sum == G) break;
        __builtin_amdgcn_s_sleep(1);
        if ((++sp & 255u) == 0u) { if (xb_ld(&bar[XB_TMO])) break; if (sp > XB_SPIN_CAP) { atomicAdd(&bar[XB_TMO], 1u); break; } }
    }
    nloc = mine > 0u ? mine : 1u; nx = cnt > 0u ? cnt : 1u;
}
__device__ __forceinline__ void xcd_barrier(const XcdBarrier& b, const int tid) {
    asm volatile("s_waitcnt vmcnt(0)" ::: "memory");
    __syncthreads();
    if (tid == 0) {
        unsigned* bar = b.bar; asm volatile("" : "+s"(bar));
        __builtin_amdgcn_s_waitcnt(0);
        unsigned nloc = b.st[0], nx = b.st[1];
        if (nloc == 0u) { xcd_barrier_complete(bar, b.x, nloc, nx); b.st[0] = nloc; b.st[1] = nx; }
        const unsigned old = xb_add(&bar[XB_XSUB(b.x)], 1u);
        const unsigned gen = old / nloc;
        if (old + 1u == (gen + 1u) * nloc) {
            __builtin_amdgcn_fence(__ATOMIC_RELEASE, "agent");
            asm volatile("s_waitcnt vmcnt(0)" ::: "memory");
            const unsigned og = xb_add(&bar[XB_TOP], 1u);
            const unsigned tg = og / nx;
            if (og + 1u == (tg + 1u) * nx) xb_add(&bar[XB_TOPGEN], 1u);
            else XB_SPIN(xb_ld(&bar[XB_TOPGEN]) == tg, bar);
            __builtin_amdgcn_fence(__ATOMIC_ACQUIRE, "agent");
            xb_add(&bar[XB_XGEN(b.x)], 1u);
            asm volatile("s_waitcnt vmcnt(0)" ::: "memory");
        } else {
            XB_SPIN(xb_ld(&bar[XB_XGEN(b.x)]) == gen, bar);
            __builtin_amdgcn_fence(__ATOMIC_ACQUIRE, "agent");
            asm volatile("s_waitcnt vmcnt(0)" ::: "memory");
        }
    }
    __syncthreads();
}

struct Args { const float* in[37]; float* out; unsigned char* ws; int ph_lo, ph_hi; };
enum { I_XP = 0, I_XS, I_CCKV, I_CKR, I_SRE, I_SIM, I_CCONV, I_CP, I_CS, I_WMOD, I_BMOD, I_GMIX, I_GFFN, I_WDQ, I_GQA, I_WUQ, I_GQN, I_WDKV, I_GKVA, I_WUKV, I_GKN, I_WO,
       I_ARE, I_AIM, I_LDT, I_BRE, I_BIM, I_CRE, I_CIM, I_SD, I_WGLU, I_WSG, I_FG, I_FU, I_FCW, I_FCB, I_FD };

__device__ const double ROPE_INV[32] = {
 1.0, 0.7498942093324559, 0.5623413251903491, 0.4216965034285822, 0.31622776601683794, 0.23713737056616552, 0.1778279410038923, 0.1333521432163324,
 0.1, 0.07498942093324558, 0.05623413251903491, 0.04216965034285822, 0.03162277660168379, 0.023713737056616554, 0.01778279410038923, 0.01333521432163324,
 0.01, 0.007498942093324558, 0.005623413251903491, 0.004216965034285823, 0.0031622776601683794, 0.0023713737056616554, 0.0017782794100389228, 0.001333521432163324,
 0.001, 0.0007498942093324559, 0.0005623413251903491, 0.0004216965034285823, 0.00031622776601683794, 0.00023713737056616554, 0.00017782794100389227, 0.0001333521432163324 };
__device__ __forceinline__ void sincos_red(double a, float& s, float& c) {
    const double k = __builtin_rint(a * 0.15915494309189535);
    const float r = (float)__builtin_fma(-k, 6.283185307179586, a);
    s = __sinf(r); c = __cosf(r);
}

__device__ __forceinline__ void transpose_item(const float* W, int K, int N, bf16_t* WT, int row_off, int mode, LAS float* scr, int item, int lane, const float sc = 1.0f, const float* ksc = nullptr) {
    const int nblk = N / 32, kb = item / nblk, nb = item - kb * nblk, k0 = 64 * kb, n0 = 32 * nb;
#pragma unroll 8
    for (int i = 0; i < 32; ++i) { const int kk = 2 * i + (lane >> 5); scr[kk * 33 + (lane & 31)] = W[(size_t)(k0 + kk) * N + n0 + (lane & 31)] * (ksc ? ksc[k0 + kk] : 1.0f); }
    LDS_WAIT(); asm volatile("" ::: "memory");
    const int c = lane & 7;
#pragma unroll
    for (int j = 0; j < 4; ++j) { const int n = (lane >> 3) + 8 * j; const LAS float* s = scr + (8 * c) * 33 + n;
        u32x4 o; o.x = cvt_pk_bf16(sc * s[0 * 33], sc * s[1 * 33]); o.y = cvt_pk_bf16(sc * s[2 * 33], sc * s[3 * 33]); o.z = cvt_pk_bf16(sc * s[4 * 33], sc * s[5 * 33]); o.w = cvt_pk_bf16(sc * s[6 * 33], sc * s[7 * 33]);
        const int nn = n0 + n; const int drow = mode == 0 ? row_off + nn : ((nn >> 7) * 256 + (nn & 127) + (mode == 2 ? 128 : 0));
        if (mode == 3) *(u32x4*)(WT + pg8::tiled_off(nn, k0 + 8 * c, K / 64)) = o;
        else *(u32x4*)(WT + (size_t)drow * K + k0 + 8 * c) = o; }
    LDS_WAIT(); asm volatile("" ::: "memory");
}

__global__ void __launch_bounds__(NWAVES * 64, 2) fwd_kernel(Args args) {
    extern __shared__ __attribute__((aligned(16))) unsigned char lds_raw[];
    LAS unsigned char* lds = (LAS unsigned char*)lds_raw;
    volatile LAS unsigned* MISC = (volatile LAS unsigned*)(lds + MISC_OFF);
    const int tid0 = threadIdx.x; const int wave0 = __builtin_amdgcn_readfirstlane(tid0 >> 6);
    const int G = gridDim.x; const int bx = blockIdx.x; const int vcu = (G % 8 == 0) ? (bx % 8) * (G / 8) + bx / 8 : bx;
    const int NGW = G * NWAVES;
    unsigned char* ws0 = args.ws; float* out0 = args.out;
    unsigned* ctl = (unsigned*)(ws0 + WS_CTL);
    for (int u = tid0; u < 64; u += NWAVES * 64) ((LAS unsigned*)(lds + MISC_OFF))[u] = 0u;
    __syncthreads();
    XcdBarrier bar; bar.bar = ctl + 1024; bar.x = 0; bar.st = nullptr;
    if (!MK_PER_PHASE) bar = xcd_barrier_post(ctl + 1024, MISC + 8);
    const int lo = args.ph_lo, hi = args.ph_hi;
    int ph = 0;
#define PH_BEGIN if (lo <= ph && ph < hi) { int tid; asm volatile("v_mbcnt_lo_u32_b32 %0, -1, 0\n\tv_mbcnt_hi_u32_b32 %0, -1, %0" : "=v"(tid)); tid |= wave0 << 6; \
    const int lane = tid & 63, wave = __builtin_amdgcn_readfirstlane(tid >> 6), gw = vcu * NWAVES + wave; (void)lane; (void)gw; \
    __attribute__((address_space(1))) unsigned char* wsg_; __attribute__((address_space(1))) float* outg_; asm volatile("s_mov_b64 %0, %1" : "=s"(wsg_) : "s"(ws0)); asm volatile("s_mov_b64 %0, %1" : "=s"(outg_) : "s"(out0)); unsigned char* ws = (unsigned char*)wsg_; float* out = (float*)outg_; (void)ws; (void)out;
#define PH_END if (ph + 1 < hi) xcd_barrier(bar, tid); } ++ph;

#define MOD ((float*)(ws + WS_MOD))
#define A16 ((float*)(ws + WS_A16))
#define KRSS ((float*)(ws + WS_KRSS))
#define ROPE ((float*)(ws + WS_ROPE))
#define Hb ((bf16_t*)(ws + WS_H))
#define QA ((bf16_t*)((unsigned char*)out + OY_QA))
#define CKV ((bf16_t*)((unsigned char*)out + OY_CKV))
#define Rr ((float*)((unsigned char*)out + OY_R))
#define STATQ ((float*)((unsigned char*)out + OY_STATQ))
#define RSTDQ ((float*)((unsigned char*)out + OY_RSTDQ))
#define XBs ((bf16_t*)(ws + WS_XB))
#define Qb ((bf16_t*)(ws + WS_Q))
#define KB ((bf16_t*)(ws + WS_KB))
#define QKVA ((float*)(ws + WS_QKVA))
#define Gb ((bf16_t*)(ws + WS_G))
#define HID ((bf16_t*)(ws + WS_HID))
#define GBND ((float*)(ws + WS_G))
#define DEFC ((float*)(ws + WS_G + 8 * MiB))
#define DEFU ((float*)(ws + WS_G + 16 * MiB))
#define UP ((bf16_t*)(ws + WS_UP))
#define XLOC ((bf16_t*)(ws + WS_XLOC))
#define PART ((float*)(ws + WS_PART))
#define PGU ((float*)(ws + WS_PGU))

    PH_BEGIN
#ifndef NO_P0
    {
        for (int it = vcu; it < 4 * 64; it += G) {
            const int l = it >> 6, cb = it & 63;
            LAS float* sc = (LAS float*)lds;
            for (int e = tid; e < NSLOT * DM; e += NWAVES * 64) { const int s = e >> 11, k = e & 2047; const float c = s < 4 ? args.in[I_CP][s * DM + k] : args.in[I_CS][(s - 4) * DM + k]; sc[e] = c * fast_sigmoid(c); }
            __syncthreads();
            f32x4 acc[NSLOT];
#pragma unroll
            for (int s = 0; s < NSLOT; ++s) acc[s] = (f32x4){0.f, 0.f, 0.f, 0.f};
            const int lc = lane < 48 ? lane : 47;
            const float* Wp = args.in[I_WMOD] + (size_t)l * DM * 12288 + (size_t)(wave * 256) * 12288 + cb * 192 + 4 * lc;
            for (int k0 = 0; k0 < 256; k0 += 8) {
                f32x4 w[8];
#pragma unroll
                for (int kk = 0; kk < 8; ++kk) w[kk] = *(const f32x4*)(Wp + (size_t)(k0 + kk) * 12288);
#pragma unroll
                for (int s = 0; s < NSLOT; ++s) { const f32x4 c0 = *(const LAS f32x4*)(sc + s * DM + wave * 256 + k0), c1 = *(const LAS f32x4*)(sc + s * DM + wave * 256 + k0 + 4);
#pragma unroll
                    for (int kk = 0; kk < 4; ++kk) { acc[s] += c0[kk] * w[kk]; acc[s] += c1[kk] * w[4 + kk]; } }
            }
            __syncthreads();
            LAS float* red = (LAS float*)lds;
            if (lane < 48) {
#pragma unroll
                for (int s = 0; s < NSLOT; ++s) *(LAS f32x4*)(red + (wave * NSLOT + s) * 192 + 4 * lane) = acc[s]; }
            __syncthreads();
            for (int e = tid; e < NSLOT * 192; e += NWAVES * 64) { const int s = e / 192, c = e - s * 192; float v = args.in[I_BMOD][l * 12288 + cb * 192 + c];
#pragma unroll
                for (int w8 = 0; w8 < 8; ++w8) v += red[(w8 * NSLOT + s) * 192 + c];
                MOD[(size_t)(l * NSLOT + s) * 12288 + cb * 192 + c] = v; }
            __syncthreads();
        }
        for (int e = gw * 64 + lane; e < SEQ * 32; e += NGW * 64) { float s, c; sincos_red((double)(e >> 5) * ROPE_INV[e & 31], s, c); *(f32x2*)(ROPE + 2 * (size_t)e) = (f32x2){c, s}; }
        for (int it = vcu; it < 2 * NGRP; it += G) {
            const int i = it >> 7, g = it & 127;
            LAS float* pwr = (LAS float*)lds;
            LAS float* pwi = pwr + 17 * 64;
            LAS float* bbr = pwi + 17 * 64;
            LAS float* bbi = bbr + 1024;
            LAS float* ccr = bbi + 1024;
            LAS float* cci = ccr + 1024;
            LAS float* kd = cci + 1024;
            const float dt = expf(args.in[I_LDT][i * NGRP + g]);
            if (tid < 64) {
                const int n = tid; const float are = args.in[I_ARE][(i * NGRP + g) * 64 + n], aim = args.in[I_AIM][(i * NGRP + g) * 64 + n];
                const double xr = (double)are * (double)dt, xi = (double)aim * (double)dt;
                for (int d = 0; d <= 16; ++d) { float s, c; sincos_red(xi * d, s, c); const float e = expf((float)(xr * d)); pwr[d * 64 + n] = e * c; pwi[d * 64 + n] = e * s; }
                A16[((i * NGRP + g) * 64 + n) * 2] = pwr[16 * 64 + n]; A16[((i * NGRP + g) * 64 + n) * 2 + 1] = pwi[16 * 64 + n];
                const float nr = pwr[64 + n] - 1.0f, ni = pwi[64 + n]; const float den = 1.0f / (are * are + aim * aim);
                const float fr_ = (nr * are + ni * aim) * den, fi_ = (ni * are - nr * aim) * den;
                for (int p = 0; p < 16; ++p) { const float br = args.in[I_BRE][((size_t)(i * NGRP + g) * 64 + n) * 16 + p], bi = args.in[I_BIM][((size_t)(i * NGRP + g) * 64 + n) * 16 + p];
                    bbr[n * 16 + p] = fr_ * br - fi_ * bi; bbi[n * 16 + p] = fr_ * bi + fi_ * br; }
            } else {
                for (int e = tid - 64; e < 1024; e += NWAVES * 64 - 64) { ccr[e] = args.in[I_CRE][(size_t)(i * NGRP + g) * 1024 + e]; cci[e] = args.in[I_CIM][(size_t)(i * NGRP + g) * 1024 + e]; }
            }
            __syncthreads();
            for (int e = tid; e < 4096; e += NWAVES * 64) { const int d = e >> 8, q = (e >> 4) & 15, p = e & 15; float s = 0.f;
                for (int n = 0; n < 64; ++n) { const float mr = pwr[d * 64 + n] * bbr[n * 16 + p] - pwi[d * 64 + n] * bbi[n * 16 + p], mi = pwr[d * 64 + n] * bbi[n * 16 + p] + pwi[d * 64 + n] * bbr[n * 16 + p];
                    s += ccr[q * 64 + n] * mr - cci[q * 64 + n] * mi; }
                kd[e] = s; }
            __syncthreads();
            bf16_t* BtY = (bf16_t*)(ws + WS_S5 + i * WSZ_S5 + WSZ_GG) + (size_t)g * 256 * 384;
            bf16_t* BtX = (bf16_t*)(ws + WS_S5 + i * WSZ_S5 + WSZ_GG + WSZ_BTY) + (size_t)g * 256 * 256;
            for (int e = tid; e < 256 * 192; e += NWAVES * 64) { const int rr = e / 192, k2 = (e - rr * 192) * 2; const int t = rr >> 4, q = rr & 15; float v[2];
#pragma unroll
                for (int z = 0; z < 2; ++z) { const int k = k2 + z;
                    if (k < 256) { const int s = k >> 4, p = k & 15; v[z] = (s <= t) ? kd[((t - s) * 16 + q) * 16 + p] : 0.f; }
                    else if (k < 320) { const int n = k - 256; v[z] = ccr[q * 64 + n] * pwr[(t + 1) * 64 + n] - cci[q * 64 + n] * pwi[(t + 1) * 64 + n]; }
                    else { const int n = k - 320; v[z] = -(ccr[q * 64 + n] * pwi[(t + 1) * 64 + n] + cci[q * 64 + n] * pwr[(t + 1) * 64 + n]); } }
                *(unsigned*)(BtY + (size_t)rr * 384 + k2) = cvt_pk_bf16(v[0], v[1]); }
            for (int e = tid; e < 256 * 128; e += NWAVES * 64) { const int rr = e >> 7, k2 = (e & 127) * 2; float v[2];
#pragma unroll
                for (int z = 0; z < 2; ++z) { const int k = k2 + z, s = k >> 4, p = k & 15;
                    if (rr < 64) { const int n = rr; v[z] = pwr[(15 - s) * 64 + n] * bbr[n * 16 + p] - pwi[(15 - s) * 64 + n] * bbi[n * 16 + p]; }
                    else if (rr < 128) { const int n = rr - 64; v[z] = pwr[(15 - s) * 64 + n] * bbi[n * 16 + p] + pwi[(15 - s) * 64 + n] * bbr[n * 16 + p]; }
                    else v[z] = 0.f; }
                *(unsigned*)(BtX + (size_t)rr * 256 + k2) = cvt_pk_bf16(v[0], v[1]); }
            __syncthreads();
        }
        {
            LAS float* scr = (LAS float*)(lds + wave * 16384);
            constexpr int I_DQ_ = 32 * 16, I_DKV_ = 32 * 10, I_UQ_ = 8 * 96, I_UKV_ = 4 * 128, I_O_ = 32 * 64, I_MLA_ = I_DQ_ + I_DKV_ + I_UQ_ + I_UKV_ + I_O_;
            constexpr int I_GL_ = 32 * 64, I_S5_ = 2 * I_GL_;
            constexpr int I_FG_ = 32 * 176, I_FD_ = 88 * 64, I_FFN_ = 2 * I_FG_ + I_FD_;
            constexpr int NIT = 2 * I_MLA_ + 2 * I_S5_ + 4 * I_FFN_;
            for (int it = gw; it < NIT; it += NGW) {
                int r = it;
                if (r < 2 * I_MLA_) { const int i = r / I_MLA_; r -= i * I_MLA_; unsigned char* wb = ws + WS_MLA + i * WSZ_MLA;
                    if (r < I_DQ_) { transpose_item(args.in[I_WDQ] + (size_t)i * DM * QLORA, DM, QLORA, (bf16_t*)wb, 0, 0, scr, r, lane); continue; } r -= I_DQ_;
                    if (r < I_DKV_) { transpose_item(args.in[I_WDKV] + (size_t)i * DM * 320, DM, 320, (bf16_t*)wb, 512, 0, scr, r, lane); continue; } r -= I_DKV_;
                    if (r < I_UQ_) { transpose_item(args.in[I_WUQ] + (size_t)i * QLORA * 3072, QLORA, 3072, (bf16_t*)(wb + WSZ_DQKV), 0, 0, scr, r, lane, 1.0f, args.in[I_GQA] + i * QLORA); continue; }     r -= I_UQ_;
                    if (r < I_UKV_) { transpose_item(args.in[I_WUKV] + (size_t)i * KVLORA * 4096, KVLORA, 4096, (bf16_t*)(wb + WSZ_DQKV + WSZ_UQ), 0, 0, scr, r, lane); continue; } r -= I_UKV_;
                    transpose_item(args.in[I_WO] + (size_t)i * DM * DM, DM, DM, (bf16_t*)(wb + WSZ_DQKV + WSZ_UQ + WSZ_UKV), 0, 0, scr, r, lane); continue; }
                r -= 2 * I_MLA_;
                if (r < 2 * I_S5_) { const int i = r / I_S5_; r -= i * I_S5_; bf16_t* wb = (bf16_t*)(ws + WS_S5 + i * WSZ_S5);
                    if (r < I_GL_) { transpose_item(args.in[I_WGLU] + (size_t)i * DM * DM, DM, DM, wb, 0, 1, scr, r, lane); continue; } r -= I_GL_;
                    transpose_item(args.in[I_WSG] + (size_t)i * DM * DM, DM, DM, wb, 0, 2, scr, r, lane); continue; }
                r -= 2 * I_S5_;
                { const int l = r / I_FFN_; r -= l * I_FFN_; unsigned char* wb = ws + WS_FFN + l * WSZ_FFN;
                    if (r < I_FG_) { transpose_item(args.in[I_FG] + (size_t)l * DM * DFF, DM, DFF, (bf16_t*)wb, 0, 1, scr, r, lane); continue; } r -= I_FG_;
                    if (r < I_FG_) { transpose_item(args.in[I_FU] + (size_t)l * DM * DFF, DM, DFF, (bf16_t*)wb, 0, 2, scr, r, lane); continue; } r -= I_FG_;
                    transpose_item(args.in[I_FD] + (size_t)l * DFF * DM, DFF, DM, (bf16_t*)(wb + 2 * WSZ_FF1), 0, 3, scr, r, lane, -0.6931471805599453f); }
            }
            for (int i = 0; i < 2; ++i) { u32x4* z = (u32x4*)(ws + WS_MLA + i * WSZ_MLA + (size_t)832 * DM * 2);
                for (int e = gw * 64 + lane; e < 192 * DM * 2 / 16; e += NGW * 64) z[e] = (u32x4){0u, 0u, 0u, 0u}; }
        }
    }
#endif
    PH_END

    for (int l = 0; l < 4; ++l) {
        const int li = l >> 1;
#define modl (MOD + (size_t)l * NSLOT * 12288)

#define NCOL(jj) (8 * lane + 512 * ((jj) >> 1) + 4 * ((jj) & 1))
#define NORM_STORE(V, ROW, RR16) do { \
                _Pragma("unroll") for (int j = 0; j < 4; ++j) { const f32x4 h0 = V[2 * j] * rstd * mul[2 * j] + add[2 * j], h1 = V[2 * j + 1] * rstd * mul[2 * j + 1] + add[2 * j + 1]; const u32x4 w = pg8::pack8(h0, h1); \
                    if (MODE_ == 0) *(u32x4*)(Hb + (size_t)(ROW) * DM + 8 * lane + 512 * j) = w; \
                    else { const int c = ((ROW) >> 4); *(u32x4*)(UP + ((size_t)((lane >> 1) + 32 * j) * NSUB + c) * 384 + (RR16) * 16 + 8 * (lane & 1)) = w; } } } while (0)
#define NORM_STAGE(V, RR16) do { \
                _Pragma("unroll") for (int j = 0; j < 4; ++j) { const f32x4 h0 = V[2 * j] * rstd * mul[2 * j] + add[2 * j], h1 = V[2 * j + 1] * rstd * mul[2 * j + 1] + add[2 * j + 1]; \
                    *(LAS u32x4*)(lds + wave * 16384 + ((RR16) & 3) * 4096 + 16 * lane + 1024 * j) = pg8::pack8(h0, h1); } } while (0)
#define NORM_FLUSH(RR4) do { asm volatile("s_waitcnt lgkmcnt(0)" ::: "memory"); const int t_ = lane >> 4, gl_ = (lane >> 1) & 7, h_ = lane & 1; \
                _Pragma("unroll") for (int i_ = 0; i_ < 16; ++i_) { const int g_ = 8 * i_ + gl_; const u32x4 w_ = *(const LAS u32x4*)(lds + wave * 16384 + t_ * 4096 + g_ * 32 + h_ * 16); \
                    *(u32x4*)(UP + ((size_t)g_ * NSUB + gw) * 384 + ((RR4) + t_) * 16 + 8 * h_) = w_; } \
                asm volatile("s_waitcnt lgkmcnt(0)" ::: "memory"); } while (0)
#define NORM_LOADP(MULADD_SLOT, GAIN, SHOFF, SCOFF) \
            f32x4 mul[8], add[8]; \
            _Pragma("unroll") for (int jj = 0; jj < 8; ++jj) { const int col = NCOL(jj); const f32x4 gg = *(const f32x4*)((GAIN) + col); const f32x4 scv = *(const f32x4*)(modl + (MULADD_SLOT) * 12288 + (SCOFF) + col); \
                add[jj] = *(const f32x4*)(modl + (MULADD_SLOT) * 12288 + (SHOFF) + col); mul[jj] = gg * (scv + 1.0f); }
#define LD8_BF16(V0, V1, P) do { const u32x4 w_ = *(const u32x4*)(P); V0 = (f32x4){bf_lo(w_[0]), bf_hi(w_[0]), bf_lo(w_[1]), bf_hi(w_[1])}; V1 = (f32x4){bf_lo(w_[2]), bf_hi(w_[2]), bf_lo(w_[3]), bf_hi(w_[3])}; } while (0)
#define NORM_ROWS(P32, S32, GAIN, SHOFF, SCOFF, MODE, NPART, PGATE, PMODE) do { constexpr int MODE_ = MODE; \
        { const int row0 = gw * 16; const int slot = slot_of_row(row0); \
            NORM_LOADP(slot, GAIN, SHOFF, SCOFF) \
            for (int rr = 0; rr < 16; rr += 2) { \
                f32x4 va[8], vb[8]; float sa = 0.f, sb = 0.f; \
                if (P32) { const float* xs = args.in[I_XP] + (size_t)(row0 + rr) * DM; \
                    _Pragma("unroll") for (int jj = 0; jj < 8; ++jj) { va[jj] = *(const f32x4*)(xs + NCOL(jj)); vb[jj] = *(const f32x4*)(xs + DM + NCOL(jj)); } } \
                else { const bf16_t* xh = XBs + (size_t)(row0 + rr) * DM + 8 * lane; \
                    _Pragma("unroll") for (int j = 0; j < 4; ++j) { LD8_BF16(va[2 * j], va[2 * j + 1], xh + 512 * j); LD8_BF16(vb[2 * j], vb[2 * j + 1], xh + DM + 512 * j); } } \
                _Pragma("unroll") for (int jj = 0; jj < 8; ++jj) { sa += (va[jj].x * va[jj].x + va[jj].y * va[jj].y) + (va[jj].z * va[jj].z + va[jj].w * va[jj].w); sb += (vb[jj].x * vb[jj].x + vb[jj].y * vb[jj].y) + (vb[jj].z * vb[jj].z + vb[jj].w * vb[jj].w); } \
                _Pragma("unroll") for (int o_ = 1; o_ < 64; o_ <<= 1) { sa += shx(sa, o_, lane); sb += shx(sb, o_, lane); } \
                { const float rstd = 1.0f / sqrtf(sa * (1.0f / DM) + EPS); if (MODE_ == 1) NORM_STAGE(va, rr); else NORM_STORE(va, row0 + rr, rr); } \
                { const float rstd = 1.0f / sqrtf(sb * (1.0f / DM) + EPS); if (MODE_ == 1) NORM_STAGE(vb, rr + 1); else NORM_STORE(vb, row0 + rr + 1, rr + 1); } \
                if (MODE_ == 1 && (rr & 2)) NORM_FLUSH(rr & ~3); } } \
        if (gw < 512) { const int row = NPROMPT + gw; const int slot = 4 + (gw >> 6); const int np_ = (NPART); \
            f32x4 v[8]; float ss = 0.f; \
            if (S32) { _Pragma("unroll") for (int jj = 0; jj < 8; ++jj) v[jj] = *(const f32x4*)(args.in[I_XS] + (size_t)gw * DM + NCOL(jj)); } \
            else { const bf16_t* xh = XBs + (size_t)row * DM + 8 * lane; _Pragma("unroll") for (int j = 0; j < 4; ++j) LD8_BF16(v[2 * j], v[2 * j + 1], xh + 512 * j); } \
            if (np_ > 0) { const int pm_ = (PMODE); \
                _Pragma("unroll") for (int jj = 0; jj < 8; ++jj) { f32x4 sp = (f32x4){0.f, 0.f, 0.f, 0.f}; const int col = NCOL(jj); \
                    if (pm_ == 0) { for (int ks = 0; ks < np_; ++ks) sp += *(const f32x4*)(PART + ((size_t)ks * 512 + gw) * DM + col); } \
                    else { f32x4 sg = (f32x4){0.f, 0.f, 0.f, 0.f}; \
                        for (int ks = 0; ks < np_; ++ks) { const float* pp = PART + ((size_t)ks * 512 + gw) * 4096 + (col >> 7) * 256 + (col & 127); sp += *(const f32x4*)pp; sg += *(const f32x4*)(pp + 128); } \
                        _Pragma("unroll") for (int e = 0; e < 4; ++e) sp[e] *= fast_sigmoid(sg[e]); } \
                    v[jj] += *(const f32x4*)((PGATE) + (size_t)slot * 12288 + col) * sp; } \
                _Pragma("unroll") for (int j = 0; j < 4; ++j) { *(u32x4*)(XBs + (size_t)row * DM + 8 * lane + 512 * j) = pg8::pack8(v[2 * j], v[2 * j + 1]); \
                    LD8_BF16(v[2 * j], v[2 * j + 1], XBs + (size_t)row * DM + 8 * lane + 512 * j); } }     \
            _Pragma("unroll") for (int jj = 0; jj < 8; ++jj) ss += (v[jj].x * v[jj].x + v[jj].y * v[jj].y) + (v[jj].z * v[jj].z + v[jj].w * v[jj].w); \
            const float rstd = 1.0f / sqrtf(wave_sum(ss, lane) * (1.0f / DM) + EPS); \
            NORM_LOADP(slot, GAIN, SHOFF, SCOFF) \
            NORM_STORE(v, row, row & 15); } } while (0)
#define PREV_GATE_F (MOD + (size_t)(l - 1) * NSLOT * 12288 + 10240)

        if ((l & 1) == 0) {
#define wb (ws + WS_MLA + li * WSZ_MLA)
            PH_BEGIN
#ifndef NO_A0
            NORM_ROWS(l == 0, l == 0, args.in[I_GMIX] + l * DM, 0, 2048, 0, (l > 0 ? 11 : 0), PREV_GATE_F, 0);
#endif
            PH_END
            PH_BEGIN
#ifndef NO_A1
            { pg8::Gemm g = pg8::gemm_rm(Hb, (const bf16_t*)wb, DM, DM, DM); pg8::StaticOrder S; S.init(128, 3, G, bx); S.pnskip = 2; pg8::EpiA1 E{QKVA, QA, STATQ};
              pg8::gemm_phase<pg8::EpiA1, pg8::StaticOrder, true>(lds, g, S, E, tid); }
            { pg8::Gemm g = pg8::gemm_rm(Hb, (const bf16_t*)wb, DM, DM, DM); pg8::StaticOrder S; S.init(128, 1, G, (G > 128) ? (bx + 128) % G : bx); S.pnoff = 2;
              pg8::EpiCkv E{CKV, out + O_CKVP + (size_t)li * NPROMPT * KVLORA, args.in[I_GKVA] + li * KVLORA, (LAS float*)(lds + MISC_OFF + 1024)};
              pg8::gemm_phase<pg8::EpiCkv, pg8::StaticOrder, true>(lds, g, S, E, tid); }
            { pg8::Gemm g = pg8::gemm_rm(Hb, (const bf16_t*)wb, DM, DM, 512); pg8::SplitOrder S{bx, 4, 4, (size_t)1024}; pg8::EpiPartial E{PART, 1024};
              pg8::gemm_phase<pg8::EpiPartial, pg8::SplitOrder, true>(lds, g, S, E, tid); }
#endif
            PH_END
            PH_BEGIN
#ifndef NO_A2
            {
                const float* gqa = args.in[I_GQA] + li * QLORA; const float* gkva = args.in[I_GKVA] + li * KVLORA; const float* gkn = args.in[I_GKN] + li * DQK;
                for (int it = gw; it < NTOK + 8 * PAST; it += NGW) {
                    int kvrow, pos; f32x4 kr = (f32x4){0.f, 0.f, 0.f, 0.f};
                    if (it < NTOK) {
                        const int row = it;
                        f32x4 v[4];
                        const bool pr = row < NPROMPT;
                        if (pr) { const float* src = QKVA + (size_t)row * 1024;
                            v[0] = v[1] = (f32x4){0.f, 0.f, 0.f, 0.f};
                            v[2] = v[0]; v[3] = *(const f32x4*)(src + 4 * lane + 768); }
                        else { const float* src = PART + (size_t)(row - NPROMPT) * 1024;
#pragma unroll
                            for (int j = 0; j < 4; ++j) v[j] = (*(const f32x4*)(src + 4 * lane + 256 * j) + *(const f32x4*)(src + 512 * 1024 + 4 * lane + 256 * j)) + (*(const f32x4*)(src + 2 * 512 * 1024 + 4 * lane + 256 * j) + *(const f32x4*)(src + 3 * 512 * 1024 + 4 * lane + 256 * j)); }
                        float sq = 0.f, sk = 0.f;
#pragma unroll
                        for (int j = 0; j < 2; ++j) sq += (v[j].x * v[j].x + v[j].y * v[j].y) + (v[j].z * v[j].z + v[j].w * v[j].w);
                        if (pr) sq = lane < 8 ? STATQ[(size_t)row * 8 + lane] : 0.f;
                        sk = (v[2].x * v[2].x + v[2].y * v[2].y) + (v[2].z * v[2].z + v[2].w * v[2].w);
                        const float rq = 1.0f / sqrtf(wave_sum(sq, lane) * (1.0f / QLORA) + EPS), rk = 1.0f / sqrtf(wave_sum(sk, lane) * (1.0f / KVLORA) + EPS);
                        if (!pr) {
#pragma unroll
                            for (int j = 0; j < 2; ++j) { const f32x4 h = v[j] * rq; u32x2 w; w.x = cvt_pk_bf16(h.x, h.y); w.y = cvt_pk_bf16(h.z, h.w);
                                *(u32x2*)(QA + (size_t)row * QLORA + 4 * lane + 256 * j) = w; } }
                        if (lane == 0) RSTDQ[row] = pr ? rq : 1.0f;
                        const f32x4 gk = *(const f32x4*)(gkva + 4 * lane); const f32x4 ck = v[2] * rk * gk;
                        int t;
                        if (row < NPROMPT) { kvrow = row; t = row & (SEQ - 1); pos = t; const int b = row >> 13;
                            if (lane < 16) *(f32x4*)(out + O_KRP + ((size_t)(li * 4 + b) * SEQ + t) * 64 + 4 * lane) = v[3]; }
                        else { const int r2 = row - NPROMPT, b = r2 >> 6; t = r2 & 63; kvrow = NPROMPT + b * SKV + PAST + t; pos = PAST + t;
                            *(f32x4*)(out + O_CKVS + ((size_t)(li * 8 + b) * DSEQ + t) * KVLORA + 4 * lane) = ck;
                            if (lane < 16) *(f32x4*)(out + O_KRS + ((size_t)(li * 8 + b) * DSEQ + t) * 64 + 4 * lane) = v[3]; }
                        if (!pr) { u32x2 w; w.x = cvt_pk_bf16(ck.x, ck.y); w.y = cvt_pk_bf16(ck.z, ck.w); *(u32x2*)(CKV + (size_t)kvrow * KVLORA + 4 * lane) = w; }
                        kr = v[3];
                    } else {
                        const int c2 = it - NTOK, b = c2 >> 12, p = c2 & (PAST - 1); kvrow = NPROMPT + b * SKV + p; pos = p;
                        const f32x4 ck = *(const f32x4*)(args.in[I_CCKV] + ((size_t)(li * 8 + b) * PAST + p) * KVLORA + 4 * lane);
                        u32x2 w; w.x = cvt_pk_bf16(ck.x, ck.y); w.y = cvt_pk_bf16(ck.z, ck.w); *(u32x2*)(CKV + (size_t)kvrow * KVLORA + 4 * lane) = w;
                        if (lane < 16) kr = *(const f32x4*)(args.in[I_CKR] + ((size_t)(li * 8 + b) * PAST + p) * 64 + 4 * lane);
                    }
                    float ssk = (lane < 16) ? (kr.x * kr.x + kr.y * kr.y) + (kr.z * kr.z + kr.w * kr.w) : 0.f;
                    ssk = sum16(ssk, lane);
                    const f32x4 gr = (lane < 16) ? *(const f32x4*)(gkn + 128 + 4 * lane) : (f32x4){0.f, 0.f, 0.f, 0.f};
                    const f32x4 kg = kr * gr;
                    f32x4 other; other.x = shx(kg.x, 8, lane); other.y = shx(kg.y, 8, lane); other.z = shx(kg.z, 8, lane); other.w = shx(kg.w, 8, lane);
                    if (lane < 16) {
                        const int jb = 4 * (lane & 7); f32x4 o;
#pragma unroll
                        for (int e = 0; e < 4; ++e) { const f32x2 cs = *(const f32x2*)(ROPE + ((size_t)pos * 32 + jb + e) * 2); const float c = cs.x, s = cs.y;
                            o[e] = (lane < 8) ? kg[e] * c - other[e] * s : other[e] * s + kg[e] * c; }
                        *(f32x4*)(Rr + (size_t)kvrow * 64 + 4 * lane) = o;
                        if (lane == 0) KRSS[kvrow] = ssk;
                    }
                }
            }
#endif
            PH_END
            PH_BEGIN
#ifndef NO_A3
            { pg8::Gemm g = pg8::gemm_rm(QA, (const bf16_t*)(wb + WSZ_DQKV), QLORA, QLORA, QLORA); pg8::StaticOrder S; S.init(NTOK / 256, 12, G, bx); pg8::EpiBf16 E{Qb, 3072, RSTDQ};
              pg8::gemm_phase<pg8::EpiBf16, pg8::StaticOrder, true>(lds, g, S, E, tid); }
            { pg8::Gemm g = pg8::gemm_rm(CKV, (const bf16_t*)(wb + WSZ_DQKV + WSZ_UQ), KVLORA, KVLORA, KVLORA); pg8::StaticOrder S; S.init(NKV / 256, 16, G, (G % 8 == 0 && G > 64) ? (bx + 32) % G : bx);     pg8::EpiKV E{KB, KRSS, Rr, args.in[I_GKN] + li * DQK, (LAS float*)(lds + MISC_OFF + 1024)};
              pg8::gemm_phase<pg8::EpiKV, pg8::StaticOrder, true>(lds, g, S, E, tid); }
#endif
            PH_END
            PH_BEGIN
#ifndef NO_A5
            {
                bool fx_ok;
                { float gq = 0.f, gk = 0.f;
                  for (int e = lane; e < DQK; e += 64) { gq = fmaxf(gq, fabsf(args.in[I_GQN][li * DQK + e])); gk = fmaxf(gk, fabsf(args.in[I_GKN][li * DQK + e])); }
#pragma unroll
                  for (int o_ = 1; o_ < 64; o_ <<= 1) { gq = fmaxf(gq, shx(gq, o_, lane)); gk = fmaxf(gk, shx(gk, o_, lane)); }
                  fx_ok = __builtin_amdgcn_readfirstlane(__float_as_int(gq * gk * (1.4427f * 13.8564f * 1.03f))) < __float_as_int(60.0f); }
                const int nun = ((vcu & 1) == 0) ? 9 : 8;
                for (int un = 0; un < nun; ++un) {
                    const bf16_t* q_; const bf16_t* k_; const bf16_t* v_; bf16_t* o_; int NT_, NTr_, nv_, wq_, pos0_, rev_;
                    if (un < 8) { const int x = vcu >> 5, i = vcu & 31; const int bh = x * 8 + (un >> 1) * 2 + (un & 1), b = bh >> 4, h = bh & 15; const int qb = (un & 1) == 0 ? i : ((un >> 1) < 2 ? 31 - (i ^ 1) : 31 - i);     const size_t qrow = (size_t)b * SEQ + 256 * qb;
                        q_ = Qb + qrow * 3072 + h * DQK; k_ = KB + (size_t)b * SEQ * 5120 + h * 320; v_ = k_ + 192; o_ = Hb + qrow * DM + h * 128;
                        NT_ = 4 * (qb + 1); NTr_ = NT_; nv_ = 4 * qb + (wave >> 1) + 1; wq_ = wave; pos0_ = 256 * qb; rev_ = un & 1; }
                    else { const int su = vcu >> 1, b = su >> 4, h = su & 15; const size_t qrow = NPROMPT + (size_t)b * DSEQ, kvr = NPROMPT + (size_t)b * SKV;
                        q_ = Qb + qrow * 3072 + h * DQK; k_ = KB + kvr * 5120 + h * 320; v_ = k_ + 192; o_ = Hb + qrow * DM + h * 128;
                        NT_ = 66; NTr_ = 65; nv_ = wave < 2 ? 65 : 0; wq_ = wave & 1; pos0_ = PAST; rev_ = 0; }
                    if (fx_ok) att::attn_unit<true>(q_, k_, v_, o_, NT_, NTr_, nv_, wq_, rev_, (LAS char*)lds, tid, args.in[I_GQN] + li * DQK, ROPE, pos0_);
                    else att::attn_unit<false>(q_, k_, v_, o_, NT_, NTr_, nv_, wq_, rev_, (LAS char*)lds, tid, args.in[I_GQN] + li * DQK, ROPE, pos0_);
                }
            }
#endif
            PH_END
            PH_BEGIN
#ifndef NO_A6
            { pg8::Gemm g = pg8::gemm_rm(Hb, (const bf16_t*)(wb + WSZ_DQKV + WSZ_UQ + WSZ_UKV), DM, DM, DM); pg8::StaticOrder S; S.init(128, 8, G, bx); pg8::EpiResid E{args.in[I_XP], out, XBs, modl + 4096, (l == 0) ? 1 : 0, 0};
              pg8::gemm_phase<pg8::EpiResid, pg8::StaticOrder, true>(lds, g, S, E, tid); }
            { pg8::Gemm g = pg8::gemm_rm(Hb, (const bf16_t*)(wb + WSZ_DQKV + WSZ_UQ + WSZ_UKV), DM, DM, 512); pg8::SplitOrder S{bx, 8, 4, (size_t)1024}; pg8::EpiPartial E{PART, DM};
              pg8::gemm_phase<pg8::EpiPartial, pg8::SplitOrder, true>(lds, g, S, E, tid); }
#endif
            PH_END
        } else {
#undef wb
#define wb (ws + WS_S5 + li * WSZ_S5)
            PH_BEGIN
#ifndef NO_S0
            NORM_ROWS(false, false, args.in[I_GMIX] + l * DM, 0, 2048, 1, 11, PREV_GATE_F, 0);
#endif
            PH_END
            PH_BEGIN
#ifndef NO_S1
            { pg8::Gemm g = pg8::gemm_rm(UP, (const bf16_t*)(wb + WSZ_GG + WSZ_BTY), 384, 256, 256); pg8::GroupOrder S{G, bx}; pg8::EpiXloc E{XLOC};
              pg8::gemm_phase<pg8::EpiXloc, pg8::GroupOrder, true>(lds, g, S, E, tid); }
#endif
            PH_END
            PH_BEGIN
#ifndef NO_S2
            {
                for (int it = gw; it < NSLOT * NGRP; it += NGW) {
                    const int slot = it >> 7, g = it & 127, n = lane;
                    const float ar = A16[((li * NGRP + g) * 64 + n) * 2], ai = A16[((li * NGRP + g) * 64 + n) * 2 + 1];
                    float xr = 0.f, xi = 0.f; int c0, nc;
                    if (slot < 4) { c0 = slot * 512; nc = 512; }
                    else { const int b = slot - 4; c0 = 2048 + 4 * b; nc = 4; xr = args.in[I_SRE][((size_t)(li * 8 + b) * NGRP + g) * 64 + n]; xi = args.in[I_SIM][((size_t)(li * 8 + b) * NGRP + g) * 64 + n]; }
                    const bf16_t* xl = XLOC + ((size_t)g * NSUB + c0) * 128; bf16_t* up = UP + ((size_t)g * NSUB + c0) * 384 + 256;
#define S2_STEP(LR, LI, Q) do { const unsigned pk = cvt_pk_bf16(xr, xi); up[(size_t)(c + (Q)) * 384 + n] = (bf16_t)(pk & 0xffffu); up[(size_t)(c + (Q)) * 384 + 64 + n] = (bf16_t)(pk >> 16); \
                            const float nr = ar * xr - ai * xi + (LR), ni = ar * xi + ai * xr + (LI); xr = nr; xi = ni; } while (0)
                    if (nc == 4) { const int c = 0; float lr[4], lim[4];
#pragma unroll
                        for (int q = 0; q < 4; ++q) { lr[q] = bf_lo((unsigned)xl[(size_t)q * 128 + n]); lim[q] = bf_lo((unsigned)xl[(size_t)q * 128 + 64 + n]); }
#pragma unroll
                        for (int q = 0; q < 4; ++q) S2_STEP(lr[q], lim[q], q);
                    } else {
                        float lr[16], lim[16];
#pragma unroll
                        for (int q = 0; q < 16; ++q) { lr[q] = bf_lo((unsigned)xl[(size_t)q * 128 + n]); lim[q] = bf_lo((unsigned)xl[(size_t)q * 128 + 64 + n]); }
                        for (int c = 0; c < nc; c += 16) {
                            float nr_[16], ni_[16]; const int cn = c + 16 < nc ? c + 16 : c;
#pragma unroll
                            for (int q = 0; q < 16; ++q) { nr_[q] = bf_lo((unsigned)xl[(size_t)(cn + q) * 128 + n]); ni_[q] = bf_lo((unsigned)xl[(size_t)(cn + q) * 128 + 64 + n]); }
#pragma unroll
                            for (int q = 0; q < 16; ++q) S2_STEP(lr[q], lim[q], q);
#pragma unroll
                            for (int q = 0; q < 16; ++q) { lr[q] = nr_[q]; lim[q] = ni_[q]; }
                        }
                    }
#undef S2_STEP
                    if (slot < 4) { out[O_REP + ((size_t)(li * 4 + slot) * NGRP + g) * 64 + n] = xr; out[O_IMP + ((size_t)(li * 4 + slot) * NGRP + g) * 64 + n] = xi; }
                    else { out[O_RES + ((size_t)(li * 8 + slot - 4) * NGRP + g) * 64 + n] = xr; out[O_IMS + ((size_t)(li * 8 + slot - 4) * NGRP + g) * 64 + n] = xi; }
                }
            }
#endif
            PH_END
            PH_BEGIN
#ifndef NO_S3
            { pg8::Gemm g = pg8::gemm_rm(UP, (const bf16_t*)(wb + WSZ_GG), 384, 384, 384); pg8::GroupOrder S{G, bx}; pg8::EpiY E{UP, Hb, args.in[I_SD] + li * DM};
              pg8::gemm_phase<pg8::EpiY, pg8::GroupOrder, true>(lds, g, S, E, tid); }
#endif
            PH_END
            PH_BEGIN
#ifndef NO_S4
            { pg8::Gemm g = pg8::gemm_rm(Hb, (const bf16_t*)wb, DM, DM, DM); pg8::StaticOrder S; S.init(128, 16, G, bx); pg8::EpiGlu E{XBs, modl + 4096};
              pg8::gemm_phase<pg8::EpiGlu, pg8::StaticOrder, true>(lds, g, S, E, tid); }
            { pg8::Gemm g = pg8::gemm_rm(Hb, (const bf16_t*)wb, DM, DM, 512); pg8::SplitOrder S{bx, 16, 4, (size_t)1024}; pg8::EpiPartial E{PART, 4096};
              pg8::gemm_phase<pg8::EpiPartial, pg8::SplitOrder, true>(lds, g, S, E, tid); }
#endif
            PH_END
        }
        {
#undef wb
#define wb (ws + WS_FFN + l * WSZ_FFN)
            PH_BEGIN
#ifndef NO_F0
            NORM_ROWS(false, l == 0, args.in[I_GFFN] + l * DM, 6144, 8192, 0, 4, modl + 4096, (l & 1));
#endif
            PH_END
            PH_BEGIN
#ifndef NO_F1
            { pg8::Gemm g = pg8::gemm_rm(Hb, (const bf16_t*)wb, DM, DM, DM); pg8::StaticOrder S; S.init(128, 44, G, bx);
              pg8::EpiFfn E{HID, args.in[I_FCW] + (size_t)l * 3 * DFF, args.in[I_FCB] + (size_t)l * DFF, out + O_CONVP + (size_t)l * 4 * 2 * DFF, GBND, DEFC, DEFU, (LAS float*)(lds + MISC_OFF + 1024)};
              pg8::gemm_phase<pg8::EpiFfn, pg8::StaticOrder, true>(lds, g, S, E, tid); }
            { pg8::Gemm g = pg8::gemm_rm(Hb, (const bf16_t*)wb, DM, DM, 1024); pg8::SplitOrder S{bx, 44, 2, (size_t)2048}; pg8::EpiPartial E{PGU, 2 * DFF};
              pg8::gemm_phase<pg8::EpiPartial, pg8::SplitOrder, true>(lds, g, S, E, tid); }
#endif
            PH_END
            PH_BEGIN
#ifndef NO_F2
            for (int it = gw; it < 512 * 22; it += NGW) { const int r = it / 22, c = (it - r * 22) * 256 + 4 * lane; const int b = r >> 6, t = r & 63;
                const float* cwp = args.in[I_FCW] + (size_t)l * 3 * DFF + c; const f32x4 w0 = *(const f32x4*)cwp, w1 = *(const f32x4*)(cwp + DFF), w2 = *(const f32x4*)(cwp + 2 * DFF), cbv = *(const f32x4*)(args.in[I_FCB] + (size_t)l * DFF + c);
                const float* pg = PGU + (size_t)r * (2 * DFF) + (c >> 7) * 256 + (c & 127); const size_t ps = (size_t)512 * 2 * DFF;
                const float* cc = args.in[I_CCONV] + ((size_t)(l * 8 + b) * 2) * DFF + c;
                const f32x4 g2 = *(const f32x4*)pg + *(const f32x4*)(pg + ps);
                const f32x4 g1 = t >= 1 ? *(const f32x4*)(pg - 2 * DFF) + *(const f32x4*)(pg - 2 * DFF + ps) : *(const f32x4*)(cc + DFF);
                const f32x4 g0 = t >= 2 ? *(const f32x4*)(pg - 4 * DFF) + *(const f32x4*)(pg - 4 * DFF + ps) : *(const f32x4*)(cc + (t == 1 ? DFF : 0));
                const f32x4 uu = *(const f32x4*)(pg + 128) + *(const f32x4*)(pg + 128 + ps);
                f32x4 h;
#pragma unroll
                for (int e = 0; e < 4; ++e) { const float gc = cbv[e] + w0[e] * g0[e] + w1[e] * g1[e] + w2[e] * g2[e]; h[e] = -1.4426950408889634f * (gc * fast_sigmoid(gc) * uu[e]); }
                u32x2 w; w.x = cvt_pk_bf16(h[0], h[1]); w.y = cvt_pk_bf16(h[2], h[3]);
                *(u32x2*)(HID + pg8::tiled_off(NPROMPT + r, c, DFF / 64)) = w;
                if (t >= DSEQ - 2) *(f32x4*)(out + O_CONVS + ((size_t)(l * 8 + b) * 2 + (t - (DSEQ - 2))) * DFF + c) = g2; }
            for (int it = gw * 64 + lane; it < 128 * 2 * (DFF / 4); it += NGW * 64) { const int pm = it / (2 * (DFF / 4)), rem = it - pm * (2 * (DFF / 4)), rr = rem / (DFF / 4), c = (rem - rr * (DFF / 4)) * 4;
                if ((pm & 31) == 0) continue;
                const float* cwp = args.in[I_FCW] + (size_t)l * 3 * DFF + c; const f32x4 w0 = *(const f32x4*)cwp, w1 = *(const f32x4*)(cwp + DFF);
                const f32x4 p254 = *(const f32x4*)(GBND + (size_t)((pm - 1) * 2) * DFF + c), p255 = *(const f32x4*)(GBND + (size_t)((pm - 1) * 2 + 1) * DFF + c);
                const f32x4 cp = *(const f32x4*)(DEFC + (size_t)(pm * 2 + rr) * DFF + c), uu = *(const f32x4*)(DEFU + (size_t)(pm * 2 + rr) * DFF + c);
                f32x4 h;
#pragma unroll
                for (int e = 0; e < 4; ++e) { const float gc = rr == 0 ? cp[e] + -1.4426950408889634f * (w0[e] * p254[e] + w1[e] * p255[e]) : cp[e] + -1.4426950408889634f * (w0[e] * p255[e]); h[e] = gc * __builtin_amdgcn_rcpf(1.0f + __builtin_amdgcn_exp2f(gc)) * uu[e]; }
                u32x2 w; w.x = cvt_pk_bf16(h[0], h[1]); w.y = cvt_pk_bf16(h[2], h[3]);
                *(u32x2*)(HID + pg8::tiled_off(pm * 256 + rr, c, DFF / 64)) = w; }
#endif
            PH_END
            PH_BEGIN
#ifndef NO_F3
            { pg8::Gemm g{HID, (const bf16_t*)(wb + 2 * WSZ_FF1), 64, 64, DFF, 32768, 32768, (size_t)88 * 32768, (size_t)88 * 32768};
              pg8::StaticOrder S; S.init(128, 8, G, bx); pg8::EpiResid E{args.in[I_XP], out, XBs, modl + 10240, 0, (l == 3) ? 1 : 0};
              pg8::gemm_phase<pg8::EpiResid, pg8::StaticOrder, true>(lds, g, S, E, tid); }
            { pg8::Gemm g{HID, (const bf16_t*)(wb + 2 * WSZ_FF1), 64, 64, 512, 32768, 32768, (size_t)88 * 32768, (size_t)88 * 32768};
              pg8::SplitOrder S{bx, 8, 11, (size_t)8 * 32768}; pg8::EpiPartial E{PART, DM};
              pg8::gemm_phase<pg8::EpiPartial, pg8::SplitOrder, true>(lds, g, S, E, tid); }
#endif
            PH_END
        }
    }
    PH_BEGIN
    if (gw < 512) { const int row = NPROMPT + gw; const int slot = 4 + (gw >> 6); const float* pg = MOD + (size_t)(3 * NSLOT + slot) * 12288 + 10240;
        f32x4 sp[8];
#pragma unroll
        for (int j = 0; j < 8; ++j) sp[j] = (f32x4){0.f, 0.f, 0.f, 0.f};
        for (int ks = 0; ks < 11; ++ks) {
#pragma unroll
            for (int j = 0; j < 8; ++j) sp[j] += *(const f32x4*)(PART + ((size_t)ks * 512 + gw) * DM + 4 * lane + 256 * j); }
#pragma unroll
        for (int j = 0; j < 8; ++j) { const u32x2 xw = *(const u32x2*)(XBs + (size_t)row * DM + 4 * lane + 256 * j); const f32x4 xv = (f32x4){bf_lo(xw.x), bf_hi(xw.x), bf_lo(xw.y), bf_hi(xw.y)};
            *(f32x4*)(out + (size_t)row * DM + 4 * lane + 256 * j) = xv + *(const f32x4*)(pg + 4 * lane + 256 * j) * sp[j]; } }
    PH_END
#undef wb
#undef PH_BEGIN
#undef PH_END
}

constexpr int NPHASES = 1 + 2 * (6 + 4) + 2 * (5 + 4) + 1;

extern "C" void kernel_launch(void* const* d_in, const int* in_sizes, int n_in, void* d_out, int out_size, void* d_ws, size_t ws_size, hipStream_t stream) {
    static int grid = 0;
    if (grid == 0) {
        if (n_in != 37 || (size_t)out_size != O_END || ws_size < WS_END) { fprintf(stderr, "kernel_launch: unexpected shapes (n_in %d out %d ws %zu)\n", n_in, out_size, ws_size); grid = -1; return; }
        int dev = 0, cus = 0, per_cu = 0;
        if (hipGetDevice(&dev) != hipSuccess || hipDeviceGetAttribute(&cus, hipDeviceAttributeMultiprocessorCount, dev) != hipSuccess) { grid = -1; return; }
        if (hipFuncSetAttribute((const void*)fwd_kernel, hipFuncAttributeMaxDynamicSharedMemorySize, LDS_BYTES) != hipSuccess) { fprintf(stderr, "kernel_launch: hipFuncSetAttribute failed\n"); grid = -1; return; }
        if (hipOccupancyMaxActiveBlocksPerMultiprocessor(&per_cu, (const void*)fwd_kernel, NWAVES * 64, LDS_BYTES) != hipSuccess || per_cu < 1) { fprintf(stderr, "kernel_launch: occupancy query says %d\n", per_cu); }
        (void)hipGetLastError();
        grid = cus;
    }
    if (grid < 0) return;
    (void)hipMemsetAsync((char*)d_ws + WS_CTL, 0, CTL_ZERO_BYTES, stream);
    Args a{};
    for (int i = 0; i < 37; ++i) a.in[i] = (const float*)d_in[i];
    a.out = (float*)d_out; a.ws = (unsigned char*)d_ws;
#if MK_PER_PHASE
    for (int p = 0; p < NPHASES; ++p) { a.ph_lo = p; a.ph_hi = p + 1; hipLaunchKernelGGL(fwd_kernel, dim3(grid), dim3(NWAVES * 64), LDS_BYTES, stream, a); }
#else
    a.ph_lo = 0; a.ph_hi = NPHASES;
    hipLaunchKernelGGL(fwd_kernel, dim3(grid), dim3(NWAVES * 64), LDS_BYTES, stream, a);
#endif
    const hipError_t le = hipPeekAtLastError();
    if (le != hipSuccess) fprintf(stderr, "kernel_launch: launch failed: %s\n", hipGetErrorName(le));
}
```

```cpp
#include <hip/hip_runtime.h>
#include <cstdio>
#include <cstdint>

#ifndef MK_PER_PHASE
#define MK_PER_PHASE 0
#endif

#define LAS __attribute__((address_space(3)))
#define GAS __attribute__((address_space(1)))
typedef unsigned short bf16_t;
typedef short bf16x8 __attribute__((ext_vector_type(8)));
typedef short s16x4 __attribute__((ext_vector_type(4)));
typedef float f32x4 __attribute__((ext_vector_type(4)));
typedef float f32x2 __attribute__((ext_vector_type(2)));
typedef float f32x16 __attribute__((ext_vector_type(16)));
typedef unsigned u32x4 __attribute__((ext_vector_type(4)));
typedef unsigned u32x2 __attribute__((ext_vector_type(2)));

constexpr int DM = 2048, NPROMPT = 32768, NTOK = 33280, SEQ = 8192, DSEQ = 64, PAST = 4096, SKV = 4160, NKV = 66048, DFF = 5632;
constexpr int NH = 16, DQK = 192, QLORA = 512, KVLORA = 256;
constexpr int NSLOT = 12;
constexpr int NWAVES = 8;
constexpr float EPS = 1e-6f;
constexpr int NGRP = 128, NSUB = 2304;

constexpr size_t O_Y = 0, O_CKVP = 68157440, O_KRP = 84934656, O_CKVS = 89128960, O_KRS = 89391104, O_REP = 89456640, O_IMP = 89522176,
                 O_RES = 89587712, O_IMS = 89718784, O_CONVP = 89849856, O_CONVS = 90030080, O_END = 90390528;

constexpr size_t MiB = 1u << 20;
constexpr size_t WS_CTL = 0, CTL_ZERO_BYTES = 1 * MiB, WS_ZGATE = 128 * 1024;
constexpr size_t WS_MOD = 1 * MiB;
constexpr size_t WS_A16 = 4 * MiB;
constexpr size_t WS_KRSS = 5 * MiB;
constexpr size_t WS_ROPE = 6 * MiB;
constexpr size_t WS_W = 8 * MiB;
constexpr size_t WSZ_DQKV = 4 * MiB, WSZ_UQ = 3 * MiB, WSZ_UKV = 2 * MiB, WSZ_WO = 8 * MiB, WSZ_MLA = 17 * MiB;
constexpr size_t WS_MLA = WS_W;
constexpr size_t WSZ_GG = 16 * MiB, WSZ_BTY = 24 * MiB, WSZ_BTX = 16 * MiB, WSZ_S5 = 56 * MiB;
constexpr size_t WS_S5 = WS_MLA + 2 * WSZ_MLA;
constexpr size_t WSZ_FF1 = 22 * MiB, WSZ_FFN = 66 * MiB;
constexpr size_t WS_FFN = WS_S5 + 2 * WSZ_S5;
constexpr size_t WS_H = WS_FFN + 4 * WSZ_FFN;
constexpr size_t WS_XB = WS_H + 130 * MiB;
constexpr size_t WS_BIG = WS_XB + 130 * MiB;
constexpr size_t OY_QA = 0;
constexpr size_t OY_CKV = 33 * MiB;
constexpr size_t OY_STATQ = 100 * MiB;
constexpr size_t OY_RSTDQ = 102 * MiB;
constexpr size_t OY_R = 66 * MiB;
constexpr size_t WS_Q = WS_BIG;
constexpr size_t WS_KB = WS_Q + 195 * MiB;
constexpr size_t WS_QKVA = WS_KB;
constexpr size_t WS_G = WS_BIG;
constexpr size_t WS_HID = WS_BIG + 358 * MiB;
constexpr size_t WS_PART = WS_BIG + 716 * MiB;
constexpr size_t WS_PGU = WS_BIG + 764 * MiB;
constexpr size_t WS_UP = WS_BIG;
constexpr size_t WS_XLOC = WS_BIG + 216 * MiB;
constexpr size_t WS_END = WS_KB + 645 * MiB;
static_assert(WS_END <= 1536 * MiB, "workspace map");
static_assert(WS_HID + 358 * MiB <= WS_PART && WS_PART + 48 * MiB <= WS_PGU && WS_PGU + 48 * MiB <= WS_END && WS_XLOC + 144 * MiB <= WS_PART, "aliases");

constexpr int RING_BYTES = 131072;
constexpr int MISC_OFF = RING_BYTES;
constexpr int PAR_OFF = RING_BYTES + 1024 + 4096;
constexpr int LDS_BYTES = RING_BYTES + 1024 + 4096 + 2048;

#define RLX_AGENT __ATOMIC_RELAXED, __HIP_MEMORY_SCOPE_AGENT
#define LDS_WAIT() asm volatile("s_waitcnt lgkmcnt(0)" ::: "memory")
#define VM_WAIT() asm volatile("s_waitcnt vmcnt(0)" ::: "memory")

__device__ __forceinline__ unsigned cvt_pk_bf16(float lo, float hi) { unsigned r; asm volatile("v_cvt_pk_bf16_f32 %0, %1, %2" : "=v"(r) : "v"(lo), "v"(hi)); return r; }
__device__ __forceinline__ float bf_lo(unsigned w) { return __uint_as_float(w << 16); }
__device__ __forceinline__ float bf_hi(unsigned w) { return __uint_as_float(w & 0xffff0000u); }
__device__ __forceinline__ float bf1(bf16_t b) { return __uint_as_float(((unsigned)b) << 16); }
__device__ __forceinline__ float shx(float v, int m, int lane) { return __int_as_float(__builtin_amdgcn_ds_bpermute((lane ^ m) << 2, __float_as_int(v))); }
__device__ __forceinline__ float wave_sum(float v, int lane) {
#pragma unroll
    for (int o = 1; o < 64; o <<= 1) v += shx(v, o, lane);
    return v;
}
__device__ __forceinline__ float sum16(float v, int lane) {
#pragma unroll
    for (int o = 1; o < 16; o <<= 1) v += shx(v, o, lane);
    return v;
}
__device__ __forceinline__ int slot_of_row(int r) { return r < NPROMPT ? (r >> 13) : 4 + ((r - NPROMPT) >> 6); }
__device__ __forceinline__ float fast_sigmoid(float x) { return __builtin_amdgcn_rcpf(1.0f + __builtin_amdgcn_exp2f(-1.4426950408889634f * x)); }

#ifndef GEMM_SP2
#define GEMM_SP2 true
#endif
namespace pg8 {
constexpr int BM = 256, BK = 64, HALF = 128, HTB = HALF * BK * 2, STAGE_BYTES = 8 * HTB, NXCD = 8, WGM = 8;
__host__ __device__ __forceinline__ int lds_byte(int r, int c) { const int st = (r >> 4) * 2 + (c >> 5), rr = r & 15, cc = c & 31, ob = rr * 64 + cc * 2; return st * 1024 + (ob ^ (((ob >> 9) & 1) << 5)); }
__host__ __device__ __forceinline__ void stage_rc(int b, int& R, int& C) { const int st = b / 1024, sb = b % 1024, swz = sb ^ (((sb >> 9) & 1) << 5); R = (st >> 1) * 16 + swz / 64; C = (st & 1) * 32 + (swz % 64) / 2; }
__host__ __device__ __forceinline__ int perm32(int rho) { const int n = rho >> 4, i = rho & 15; return 8 * (i >> 2) + 4 * n + (i & 3); }

struct Unit { int pm, pn, ks; size_t koff; };
struct Gemm { const bf16_t* A; const bf16_t* Bt; int lda, ldb, K; size_t ksA, ksB, tsA, tsB; };
__device__ __forceinline__ Gemm gemm_rm(const bf16_t* A, const bf16_t* Bt, int lda, int ldb, int K) { return Gemm{A, Bt, lda, ldb, K, 128, 128, (size_t)512 * lda, (size_t)512 * ldb}; }
__device__ __forceinline__ size_t tiled_off(int row, int col, int nkt) { return (((size_t)(row >> 8) * nkt + (col >> 6)) * 256 + (row & 255)) * 64 + (col & 63); }

struct StaticOrder {
    int nM, nN, nwg, G, c, pnskip = 1 << 30, pnoff = 0, pmx = 0;
    __device__ void init(int nM_, int nN_, int G_, int c_) { nM = nM_; nN = nN_; nwg = nM * nN; G = G_; c = c_; }
    __device__ bool next(int i, Unit& u) const {
        const long L = (long)i * G + c; if (L >= nwg) return false;
        int wgid = (int)L; { const int q = nwg / NXCD, r = nwg % NXCD, xcd = wgid % NXCD, off = wgid / NXCD; wgid = (xcd < r ? xcd * (q + 1) : r * (q + 1) + (xcd - r) * q) + off; }
        const int nig = WGM * nN, gid = wgid / nig, fm = gid * WGM, gsz = (nM - fm) < WGM ? (nM - fm) : WGM;
        u.pm = (fm + ((wgid % nig) % gsz)) ^ pmx; { const int p_ = (wgid % nig) / gsz; u.pn = p_ + pnoff + (p_ >= pnskip ? 1 : 0); } u.ks = 0; u.koff = 0; return true;
    }
};
struct SplitOrder {
    int c, nN, nsplit; size_t kbytes;
    __device__ bool next(int i, Unit& u) const { if (i > 0 || c >= 2 * nN * nsplit) return false; const int ks = c % nsplit, t = c / nsplit; u.pm = 128 + t / nN; u.pn = t % nN; u.ks = ks; u.koff = ks * kbytes; return true; }
};
struct GroupOrder {
    int G, c;
    __device__ bool next(int i, Unit& u) const { const int L = i * G + c; if (L >= NGRP * 9) return false; const int g = L < NGRP * 8 ? L >> 3 : L - NGRP * 8, p = L < NGRP * 8 ? (L & 7) : 8;
        u.pm = 9 * g + p; u.pn = g; u.ks = 0; u.koff = 0; return true; }
};

template <class Epi, class Sched, bool ALIGN_EPI, bool SP2 = GEMM_SP2>
__device__ __forceinline__ void gemm_phase(LAS unsigned char* lds, const Gemm g, const Sched& S, const Epi& E, const int tid) {
    const int wid = __builtin_amdgcn_readfirstlane(tid >> 6), lane = tid & 63, wr = wid >> 2, wc = wid & 3, fr = lane & 15, fq = lane >> 4;
    const int K = g.K, nt = K / BK;
    unsigned voffA[2], voffB[2];
#pragma unroll
    for (int i = 0; i < 2; ++i) { int R, C; stage_rc(tid * 16 + i * 8192, R, C); const int Rb = Epi::PERM ? ((R & ~31) + perm32(R & 31)) : R;
        const int Ra = Epi::PERMA ? ((R & ~63) + ((R & 15) << 2) + ((R >> 4) & 3)) : R;
        voffA[i] = (unsigned)(Ra * g.lda + C) * 2u; voffB[i] = (unsigned)(Rb * g.ldb + C) * 2u; }
    const size_t kstepA = g.ksA, kstepB = g.ksB;
    const size_t hstepA = (size_t)HALF * g.lda * 2, hstepB = (size_t)HALF * g.ldb * 2;
    const size_t tstepA = g.tsA, tstepB = g.tsB;
    const unsigned ldsw = (unsigned)wid * 1024u;
    const int aoff = lds_byte(wr * 64 + fr, fq * 8), boff = lds_byte(wc * 32 + fr, fq * 8);
#define PG8_SA(b, h) (((b) * 2 + (h)) * HTB)
#define PG8_SB(b, h) ((4 + (b) * 2 + (h)) * HTB)
#define PG8_STAGE(bufoff, gbase, voff) do { _Pragma("unroll") for (int _i = 0; _i < 2; ++_i) \
        __builtin_amdgcn_global_load_lds((const unsigned*)((const char*)(gbase) + (voff)[_i]), (LAS unsigned*)(lds + (bufoff) + ldsw + _i * 8192), 16, 0, 0); } while (0)
#define PG8_LDA(dst, b, h) do { _Pragma("unroll") for (int m = 0; m < 4; ++m) _Pragma("unroll") for (int k = 0; k < 2; ++k) dst[m][k] = *(const LAS bf16x8*)(lds + PG8_SA(b, h) + aoff + m * 2048 + k * 1024); } while (0)
#define PG8_LDB(dst, b, h) do { _Pragma("unroll") for (int n = 0; n < 2; ++n) _Pragma("unroll") for (int k = 0; k < 2; ++k) dst[n][k] = *(const LAS bf16x8*)(lds + PG8_SB(b, h) + boff + n * 2048 + k * 1024); } while (0)
#define PG8_MMA(ai, bj, At, Bt) do { __builtin_amdgcn_s_setprio(1); _Pragma("unroll") for (int m = 0; m < 4; ++m) _Pragma("unroll") for (int n = 0; n < 2; ++n) _Pragma("unroll") for (int k = 0; k < 2; ++k) \
        acc[ai][bj][m][n] = __builtin_amdgcn_mfma_f32_16x16x32_bf16(Bt[n][k], At[m][k], acc[ai][bj][m][n], 0, 0, 0); __builtin_amdgcn_s_setprio(0); } while (0)
#define PG8_WAIT_V(n) asm volatile("s_waitcnt vmcnt(" #n ")" ::: "memory")
#define PG8_WAIT_L(n) asm volatile("s_waitcnt lgkmcnt(" #n ")" ::: "memory")
#define PG8_WAIT_VP(n) do { if constexpr (Epi::NPRE == 0) { PG8_WAIT_V(n); } else { static_assert(Epi::NPRE == 1 && n == 8, "counts"); if (pf) PG8_WAIT_V(9); else PG8_WAIT_V(8); } } while (0)
#define PG8_BAR __builtin_amdgcn_s_barrier()
#define PG8_SCHED __builtin_amdgcn_sched_barrier(0)
    Unit cur, nxt; int ui = 0;
    if (!S.next(0, cur)) return;
    f32x4 acc[2][2][4][2];
#pragma unroll
    for (int a = 0; a < 2; ++a)
#pragma unroll
        for (int b = 0; b < 2; ++b)
#pragma unroll
            for (int m = 0; m < 4; ++m)
#pragma unroll
                for (int n = 0; n < 2; ++n) acc[a][b][m][n] = (f32x4){0.f, 0.f, 0.f, 0.f};
    bf16x8 At[4][2], B0[2][2], B1[2][2];
    const char* cA = (const char*)g.A + (size_t)cur.pm * tstepA + cur.koff; const char* cB = (const char*)g.Bt + (size_t)cur.pn * tstepB + cur.koff;
    if constexpr (SP2) {
    PG8_STAGE(PG8_SB(0, 0), cB, voffB); PG8_STAGE(PG8_SB(0, 1), cB + hstepB, voffB); PG8_STAGE(PG8_SA(0, 0), cA, voffA); PG8_STAGE(PG8_SA(0, 1), cA + hstepA, voffA);
    if (wr == 1) PG8_BAR;
    PG8_WAIT_V(2); PG8_BAR;
    PG8_STAGE(PG8_SB(1, 0), cB + kstepB, voffB); PG8_STAGE(PG8_SA(1, 0), cA + kstepA, voffA); PG8_STAGE(PG8_SB(1, 1), cB + hstepB + kstepB, voffB);
    PG8_WAIT_V(6); PG8_BAR;
    } else {
    PG8_STAGE(PG8_SB(0, 0), cB, voffB); PG8_STAGE(PG8_SA(0, 0), cA, voffA); PG8_STAGE(PG8_SB(0, 1), cB + hstepB, voffB); PG8_STAGE(PG8_SA(0, 1), cA + hstepA, voffA);
    if (wr == 1) PG8_BAR;
    PG8_WAIT_V(4); PG8_BAR;
    PG8_STAGE(PG8_SB(1, 0), cB + kstepB, voffB); PG8_STAGE(PG8_SA(1, 0), cA + kstepA, voffA); PG8_STAGE(PG8_SB(1, 1), cB + hstepB + kstepB, voffB);
    PG8_WAIT_V(6); PG8_BAR;
    }
    for (;;) {
        const bool has_next = S.next(ui + 1, nxt);
        const char* nA = has_next ? (const char*)g.A + (size_t)nxt.pm * tstepA + nxt.koff : cA; const char* nB = has_next ? (const char*)g.Bt + (size_t)nxt.pn * tstepB + nxt.koff : cB;
#pragma unroll 1
        for (int t = 0; t < nt; t += 2) {
            const bool last = (t == nt - 2);
            const char* a1 = cA + (size_t)(t + 1) * kstepA;
            const char* a2 = last ? nA : cA + (size_t)(t + 2) * kstepA; const char* b2 = last ? nB : cB + (size_t)(t + 2) * kstepB;
            const char* a3 = a2 + kstepA; const char* b3 = b2 + kstepB;
            const bool pf = Epi::NPRE > 0 && (t == nt - 4);
            if constexpr (Epi::NPRE > 0) { if (pf) E.prefetch(lds, cur, wid, lane); }
            if constexpr (SP2) {
            PG8_LDB(B0, 0, 0); PG8_LDB(B1, 0, 1); PG8_SCHED; PG8_LDA(At, 0, 0); PG8_STAGE(PG8_SA(1, 1), a1 + hstepA, voffA);
            PG8_WAIT_VP(8); PG8_WAIT_L(0); PG8_BAR; PG8_MMA(0, 0, At, B0); PG8_MMA(0, 1, At, B1); PG8_BAR; PG8_SCHED;
            PG8_LDA(At, 0, 1); PG8_STAGE(PG8_SB(0, 0), b2, voffB); PG8_STAGE(PG8_SB(0, 1), b2 + hstepB, voffB); PG8_STAGE(PG8_SA(0, 0), a2, voffA);
            PG8_WAIT_VP(8); PG8_WAIT_L(0); PG8_BAR; PG8_MMA(1, 0, At, B0); PG8_MMA(1, 1, At, B1); PG8_BAR; PG8_SCHED;
            PG8_LDB(B0, 1, 0); PG8_LDB(B1, 1, 1); PG8_SCHED; PG8_LDA(At, 1, 0); PG8_STAGE(PG8_SA(0, 1), a2 + hstepA, voffA);
            PG8_WAIT_VP(8); PG8_WAIT_L(0); PG8_BAR; PG8_MMA(0, 0, At, B0); PG8_MMA(0, 1, At, B1); PG8_BAR; PG8_SCHED;
            PG8_LDA(At, 1, 1); PG8_STAGE(PG8_SB(1, 0), b3, voffB); PG8_STAGE(PG8_SB(1, 1), b3 + hstepB, voffB); PG8_STAGE(PG8_SA(1, 0), a3, voffA);
            PG8_WAIT_VP(8); PG8_WAIT_L(0); PG8_BAR; PG8_MMA(1, 0, At, B0); PG8_MMA(1, 1, At, B1); PG8_BAR; PG8_SCHED;
            } else {
            PG8_LDB(B0, 0, 0); PG8_SCHED; PG8_LDA(At, 0, 0); PG8_STAGE(PG8_SA(1, 1), a1 + hstepA, voffA);
            PG8_WAIT_L(8); PG8_BAR; PG8_WAIT_L(0); PG8_MMA(0, 0, At, B0); PG8_BAR; PG8_SCHED;
            PG8_LDB(B1, 0, 1); PG8_STAGE(PG8_SB(0, 0), b2, voffB);
            PG8_BAR; PG8_WAIT_L(0); PG8_MMA(0, 1, At, B1); PG8_BAR;
            PG8_LDA(At, 0, 1); PG8_STAGE(PG8_SA(0, 0), a2, voffA);
            PG8_BAR; PG8_WAIT_L(0); PG8_MMA(1, 0, At, B0); PG8_BAR; PG8_SCHED;
            PG8_STAGE(PG8_SB(0, 1), b2 + hstepB, voffB);
            PG8_WAIT_V(6); PG8_BAR; PG8_MMA(1, 1, At, B1); PG8_BAR;
            PG8_LDB(B0, 1, 0); PG8_SCHED; PG8_LDA(At, 1, 0); PG8_STAGE(PG8_SA(0, 1), a2 + hstepA, voffA);
            PG8_WAIT_L(8); PG8_BAR; PG8_WAIT_L(0); PG8_MMA(0, 0, At, B0); PG8_BAR; PG8_SCHED;
            PG8_LDB(B1, 1, 1); PG8_STAGE(PG8_SB(1, 0), b3, voffB);
            PG8_BAR; PG8_WAIT_L(0); PG8_MMA(0, 1, At, B1); PG8_BAR;
            PG8_LDA(At, 1, 1); PG8_STAGE(PG8_SA(1, 0), a3, voffA);
            PG8_BAR; PG8_WAIT_L(0); PG8_MMA(1, 0, At, B0); PG8_BAR; PG8_SCHED;
            PG8_STAGE(PG8_SB(1, 1), b3 + hstepB, voffB);
            PG8_WAIT_V(6); PG8_BAR; PG8_MMA(1, 1, At, B1); PG8_BAR;
            }
        }
        if constexpr (ALIGN_EPI) { if (wr == 0) PG8_BAR; }
        E(acc, cur, wr, wc, fr, fq);
        if (!has_next) break;
#pragma unroll
        for (int a = 0; a < 2; ++a)
#pragma unroll
            for (int b = 0; b < 2; ++b)
#pragma unroll
                for (int m = 0; m < 4; ++m)
#pragma unroll
                    for (int n = 0; n < 2; ++n) acc[a][b][m][n] = (f32x4){0.f, 0.f, 0.f, 0.f};
        cur = nxt; cA = nA; cB = nB; ++ui;
        if constexpr (ALIGN_EPI) { if (wr == 1) PG8_BAR; }
    }
    PG8_WAIT_V(0);
    if constexpr (!ALIGN_EPI) { if (wr == 0) PG8_BAR; }
    PG8_BAR;
#undef PG8_SA
#undef PG8_SB
#undef PG8_STAGE
#undef PG8_LDA
#undef PG8_LDB
#undef PG8_MMA
#undef PG8_WAIT_V
#undef PG8_WAIT_VP
#undef PG8_WAIT_L
#undef PG8_BAR
#undef PG8_SCHED
}

typedef f32x4 Acc[2][2][4][2];

struct EpiF32 {
    static constexpr int NPRE = 0; static constexpr bool PERMA = false;
    static constexpr bool PERM = false;
    float* C; int ldc;
    __device__ __forceinline__ void operator()(const Acc& acc, const Unit& u, int wr, int wc, int fr, int fq) const {
        const int row0 = u.pm * BM + wr * 64 + fr, col0 = u.pn * BM + wc * 32 + 4 * fq;
#pragma unroll
        for (int ai = 0; ai < 2; ++ai)
#pragma unroll
            for (int m = 0; m < 4; ++m) { float* rowp = C + (size_t)(row0 + ai * HALF + m * 16) * ldc + col0;
#pragma unroll
                for (int bj = 0; bj < 2; ++bj)
#pragma unroll
                    for (int n = 0; n < 2; ++n) *(f32x4*)(rowp + bj * HALF + n * 16) = acc[ai][bj][m][n]; }
    }
};
__device__ __forceinline__ u32x4 pack8(const f32x4& v0, const f32x4& v1) { u32x4 w; w.x = cvt_pk_bf16(v0[0], v0[1]); w.y = cvt_pk_bf16(v0[2], v0[3]); w.z = cvt_pk_bf16(v1[0], v1[1]); w.w = cvt_pk_bf16(v1[2], v1[3]); return w; }
struct EpiBf16 {
    static constexpr int NPRE = 0; static constexpr bool PERMA = false;
    static constexpr bool PERM = true;
    bf16_t* O; int ldc; const float* rs;
    __device__ __forceinline__ void operator()(const Acc& acc, const Unit& u, int wr, int wc, int fr, int fq) const {
        const int row0 = u.pm * BM + wr * 64 + fr, col0 = u.pn * BM + wc * 32 + 8 * fq;
        float sc[2][4];
#pragma unroll
        for (int ai = 0; ai < 2; ++ai)
#pragma unroll
            for (int m = 0; m < 4; ++m) sc[ai][m] = rs[row0 + ai * HALF + m * 16];
#pragma unroll
        for (int ai = 0; ai < 2; ++ai)
#pragma unroll
            for (int m = 0; m < 4; ++m) { bf16_t* rowp = O + (size_t)(row0 + ai * HALF + m * 16) * ldc + col0;
#pragma unroll
                for (int bj = 0; bj < 2; ++bj) *(u32x4*)(rowp + bj * HALF) = pack8(acc[ai][bj][m][0] * sc[ai][m], acc[ai][bj][m][1] * sc[ai][m]); }
    }
};
struct EpiA1 {
    static constexpr int NPRE = 0; static constexpr bool PERMA = false;
    static constexpr bool PERM = true;
    float* C; bf16_t* Q; float* stat;
    __device__ __forceinline__ void operator()(const Acc& acc, const Unit& u, int wr, int wc, int fr, int fq) const {
        const int lane = fr + 16 * fq;
        const int row0 = u.pm * BM + wr * 64 + fr, col0 = u.pn * BM + wc * 32 + 8 * fq;
        if (u.pn < 2) {
#pragma unroll
            for (int ai = 0; ai < 2; ++ai)
#pragma unroll
                for (int m = 0; m < 4; ++m) { const int row = row0 + ai * HALF + m * 16; float ss = 0.f;
#pragma unroll
                    for (int bj = 0; bj < 2; ++bj) { const f32x4 a = acc[ai][bj][m][0], b = acc[ai][bj][m][1];
                        *(u32x4*)(Q + (size_t)row * QLORA + col0 + bj * HALF) = pack8(a, b);
                        ss += ((a[0] * a[0] + a[1] * a[1]) + (a[2] * a[2] + a[3] * a[3])) + ((b[0] * b[0] + b[1] * b[1]) + (b[2] * b[2] + b[3] * b[3])); }
                    ss += shx(ss, 16, lane); ss += shx(ss, 32, lane);
                    if (fq == 0) stat[(size_t)row * 8 + u.pn * 4 + wc] = ss; }
        } else {
#pragma unroll
            for (int ai = 0; ai < 2; ++ai)
#pragma unroll
                for (int m = 0; m < 4; ++m) { float* rowp = C + (size_t)(row0 + ai * HALF + m * 16) * 1024 + col0;
#pragma unroll
                    for (int bj = 0; bj < 2; ++bj) { *(f32x4*)(rowp + bj * HALF) = acc[ai][bj][m][0]; *(f32x4*)(rowp + bj * HALF + 4) = acc[ai][bj][m][1]; } }
        }
    }
};
struct EpiCkv {
    static constexpr int NPRE = 0; static constexpr bool PERMA = false;
    static constexpr bool PERM = true;
    bf16_t* ckvb; float* ckvo; const float* gkva; LAS float* scr;
    __device__ __forceinline__ void operator()(const Acc& acc, const Unit& u, int wr, int wc, int fr, int fq) const {
        const int lane = fr + 16 * fq, c0 = wc * 32 + 8 * fq;
#pragma unroll
        for (int ai = 0; ai < 2; ++ai)
#pragma unroll
            for (int m = 0; m < 4; ++m) { float ss = 0.f;
#pragma unroll
                for (int bj = 0; bj < 2; ++bj) { const f32x4 a = acc[ai][bj][m][0], b = acc[ai][bj][m][1]; ss += ((a[0] * a[0] + a[1] * a[1]) + (a[2] * a[2] + a[3] * a[3])) + ((b[0] * b[0] + b[1] * b[1]) + (b[2] * b[2] + b[3] * b[3])); }
                ss += shx(ss, 16, lane); ss += shx(ss, 32, lane);
                if (fq == 0) scr[(ai * HALF + wr * 64 + m * 16 + fr) * 4 + wc] = ss; }
        asm volatile("s_waitcnt lgkmcnt(0)\n\ts_barrier" ::: "memory");
        float rk[2][4];
#pragma unroll
        for (int ai = 0; ai < 2; ++ai)
#pragma unroll
            for (int m = 0; m < 4; ++m) { const f32x4 sp = *(const LAS f32x4*)(scr + (ai * HALF + wr * 64 + m * 16 + fr) * 4); rk[ai][m] = 1.0f / sqrtf(((sp[0] + sp[1]) + (sp[2] + sp[3])) * (1.0f / KVLORA) + EPS); }
#pragma unroll
        for (int bj = 0; bj < 2; ++bj) { const f32x4 g0 = *(const f32x4*)(gkva + bj * HALF + c0), g1 = *(const f32x4*)(gkva + bj * HALF + c0 + 4);
#pragma unroll
            for (int ai = 0; ai < 2; ++ai)
#pragma unroll
                for (int m = 0; m < 4; ++m) { const unsigned off = (unsigned)((u.pm * BM + ai * HALF + wr * 64 + m * 16 + fr) * KVLORA + c0 + bj * HALF);
                    const f32x4 a = acc[ai][bj][m][0] * rk[ai][m] * g0, b = acc[ai][bj][m][1] * rk[ai][m] * g1;
                    *(f32x4*)(ckvo + off) = a; *(f32x4*)(ckvo + off + 4) = b; *(u32x4*)(ckvb + off) = pack8(a, b); }
            asm volatile("" ::: "memory"); }
    }
};
struct EpiKV {
    static constexpr int NPRE = 0; static constexpr bool PERMA = false;
    static constexpr bool PERM = true;
    bf16_t* KV; const float* krss; const float* R; const float* gkn; LAS float* scr;
    __device__ __forceinline__ void operator()(const Acc& acc, const Unit& u, int wr, int wc, int fr, int fq) const {
        const int lane = fr + 16 * fq;
#pragma unroll
        for (int ai = 0; ai < 2; ++ai)
#pragma unroll
            for (int m = 0; m < 4; ++m) { const f32x4 a = acc[ai][0][m][0], b = acc[ai][0][m][1];
                float s = (a[0] * a[0] + a[1] * a[1]) + (a[2] * a[2] + a[3] * a[3]) + (b[0] * b[0] + b[1] * b[1]) + (b[2] * b[2] + b[3] * b[3]);
                s += shx(s, 16, lane); s += shx(s, 32, lane);
                if (fq == 0) scr[(ai * HALF + wr * 64 + m * 16 + fr) * 4 + wc] = s; }
        const int row0 = u.pm * BM + wr * 64 + fr;
        bf16_t* base = KV + (size_t)row0 * 5120 + u.pn * 320;
        const f32x4 g0 = *(const f32x4*)(gkn + wc * 32 + 8 * fq), g1 = *(const f32x4*)(gkn + wc * 32 + 8 * fq + 4);
        float kr[2][4]; f32x4 rv[2][4];
#pragma unroll
        for (int ai = 0; ai < 2; ++ai)
#pragma unroll
            for (int m = 0; m < 4; ++m) { const size_t row = (size_t)(row0 + ai * HALF + m * 16); kr[ai][m] = krss[row]; rv[ai][m] = *(const f32x4*)(R + row * 64 + wc * 16 + 4 * fq); }
        asm volatile("s_waitcnt lgkmcnt(0)\n\ts_barrier" ::: "memory");
#pragma unroll
        for (int ai = 0; ai < 2; ++ai)
#pragma unroll
            for (int m = 0; m < 4; ++m) { const int rl = ai * HALF + m * 16;
                const f32x4 sp = *(const LAS f32x4*)(scr + (rl + wr * 64 + fr) * 4);
                const float r = 1.0f / sqrtf(((sp[0] + sp[1]) + (sp[2] + sp[3]) + kr[ai][m]) * (1.0f / 192.0f) + EPS);
                bf16_t* rowp = base + (size_t)rl * 5120;
                *(u32x4*)(rowp + wc * 32 + 8 * fq) = pack8(acc[ai][0][m][0] * g0 * r, acc[ai][0][m][1] * g1 * r);
                *(u32x4*)(rowp + 192 + wc * 32 + 8 * fq) = pack8(acc[ai][1][m][0], acc[ai][1][m][1]);
                const f32x4 rr = rv[ai][m] * r;
                u32x2 w; w.x = cvt_pk_bf16(rr[0], rr[1]); w.y = cvt_pk_bf16(rr[2], rr[3]);
                *(u32x2*)(rowp + 128 + wc * 16 + 4 * fq) = w; }
    }
};
struct EpiResid {
    static constexpr int NPRE = 0; static constexpr bool PERMA = false;
    static constexpr bool PERM = true;
    const float* xin32; float* xout32; bf16_t* xb; const float* gate; int inf32, outf32;
    __device__ __forceinline__ void operator()(const Acc& acc, const Unit& u, int wr, int wc, int fr, int fq) const {
        const int col0 = u.pn * BM + wc * 32 + 8 * fq;
#pragma unroll
        for (int ai = 0; ai < 2; ++ai) {
            const int rbase = u.pm * BM + ai * HALF + wr * 64; const float* gp = gate + (size_t)slot_of_row(rbase) * 12288 + col0;
            const size_t off0 = (size_t)(rbase + fr) * DM + col0;
            f32x4 xi[4][2][2];
            if (inf32) {
#pragma unroll
                for (int m = 0; m < 4; ++m)
#pragma unroll
                    for (int bj = 0; bj < 2; ++bj)
#pragma unroll
                        for (int n = 0; n < 2; ++n) xi[m][bj][n] = *(const f32x4*)(xin32 + off0 + (size_t)m * 16 * DM + bj * HALF + n * 4);
            } else { u32x4 xr[4][2];
#pragma unroll
                for (int m = 0; m < 4; ++m)
#pragma unroll
                    for (int bj = 0; bj < 2; ++bj) xr[m][bj] = *(const u32x4*)(xb + off0 + (size_t)m * 16 * DM + bj * HALF);
#pragma unroll
                for (int m = 0; m < 4; ++m)
#pragma unroll
                    for (int bj = 0; bj < 2; ++bj) { xi[m][bj][0] = (f32x4){bf_lo(xr[m][bj].x), bf_hi(xr[m][bj].x), bf_lo(xr[m][bj].y), bf_hi(xr[m][bj].y)}; xi[m][bj][1] = (f32x4){bf_lo(xr[m][bj].z), bf_hi(xr[m][bj].z), bf_lo(xr[m][bj].w), bf_hi(xr[m][bj].w)}; } }
            f32x4 gv[2][2];
#pragma unroll
            for (int bj = 0; bj < 2; ++bj)
#pragma unroll
                for (int n = 0; n < 2; ++n) gv[bj][n] = *(const f32x4*)(gp + bj * HALF + n * 4);
#pragma unroll
            for (int m = 0; m < 4; ++m)
#pragma unroll
                for (int bj = 0; bj < 2; ++bj) { const f32x4 x0 = xi[m][bj][0] + gv[bj][0] * acc[ai][bj][m][0], x1 = xi[m][bj][1] + gv[bj][1] * acc[ai][bj][m][1]; const size_t o = off0 + (size_t)m * 16 * DM + bj * HALF;
                    if (outf32) { *(f32x4*)(xout32 + o) = x0; *(f32x4*)(xout32 + o + 4) = x1; } else *(u32x4*)(xb + o) = pack8(x0, x1); }
            asm volatile("" ::: "memory");
        }
    }
};
struct EpiGlu {
    static constexpr int NPRE = 0; static constexpr bool PERMA = false;
    static constexpr bool PERM = true;
    bf16_t* xb; const float* gate;
    __device__ __forceinline__ void operator()(const Acc& acc, const Unit& u, int wr, int wc, int fr, int fq) const {
        const int col0 = u.pn * HALF + wc * 32 + 8 * fq;
        u32x4 xr[2][4];
#pragma unroll
        for (int ai = 0; ai < 2; ++ai)
#pragma unroll
            for (int m = 0; m < 4; ++m) xr[ai][m] = *(const u32x4*)(xb + (size_t)(u.pm * BM + ai * HALF + wr * 64 + m * 16 + fr) * DM + col0);
#pragma unroll
        for (int ai = 0; ai < 2; ++ai) {
            const int rbase = u.pm * BM + ai * HALF + wr * 64; const float* gp = gate + (size_t)slot_of_row(rbase) * 12288 + col0;
            f32x4 gv[2];
#pragma unroll
            for (int n = 0; n < 2; ++n) gv[n] = *(const f32x4*)(gp + n * 4);
#pragma unroll
            for (int m = 0; m < 4; ++m) { const size_t off = (size_t)(rbase + m * 16 + fr) * DM + col0; f32x4 o[2];
#pragma unroll
                for (int n = 0; n < 2; ++n) { const f32x4 a = acc[ai][0][m][n], b = acc[ai][1][m][n]; const unsigned lo = n == 0 ? xr[ai][m].x : xr[ai][m].z, hi = n == 0 ? xr[ai][m].y : xr[ai][m].w;
                    const f32x4 xi = (f32x4){bf_lo(lo), bf_hi(lo), bf_lo(hi), bf_hi(hi)};
#pragma unroll
                    for (int j = 0; j < 4; ++j) o[n][j] = xi[j] + gv[n][j] * a[j] * fast_sigmoid(b[j]); }
                *(u32x4*)(xb + off) = pack8(o[0], o[1]); }
        }
    }
};
struct EpiGate {
    static constexpr int NPRE = 0; static constexpr bool PERMA = false;
    static constexpr bool PERM = true;
    bf16_t* G; float* convp; float* convs;
    __device__ __forceinline__ void operator()(const Acc& acc, const Unit& u, int wr, int wc, int fr, int fq) const {
        const int col0 = u.pn * BM + wc * 32 + 8 * fq;
#pragma unroll
        for (int ai = 0; ai < 2; ++ai) {
            const int rbase = u.pm * BM + ai * HALF + wr * 64; const int slot = slot_of_row(rbase);
#pragma unroll
            for (int m = 0; m < 4; ++m) { const int row = rbase + m * 16 + fr; bf16_t* rowp = G + (size_t)(row + 2 * (slot + 1)) * DFF + col0;
#pragma unroll
                for (int bj = 0; bj < 2; ++bj) *(u32x4*)(rowp + bj * HALF) = pack8(acc[ai][bj][m][0], acc[ai][bj][m][1]);
                if (m == 3 && fr >= 14) {
                    const bool lastp = (slot < 4) && ((row & (SEQ - 1)) >= SEQ - 2); const bool lasts = (slot >= 4);
                    if (lastp || lasts) { float* cp = (slot < 4 ? convp + (size_t)(slot * 2 + (row & 1)) * DFF : convs + (size_t)((slot - 4) * 2 + (row & 1)) * DFF) + col0;
#pragma unroll
                        for (int bj = 0; bj < 2; ++bj) { *(f32x4*)(cp + bj * HALF) = acc[ai][bj][m][0]; *(f32x4*)(cp + bj * HALF + 4) = acc[ai][bj][m][1]; } }
                }
            }
        }
    }
};
struct EpiUp {
    static constexpr int NPRE = 0; static constexpr bool PERMA = false;
    static constexpr bool PERM = true;
    const bf16_t* G; bf16_t* HID; const float* cw; const float* cb;
    __device__ __forceinline__ void operator()(const Acc& acc, const Unit& u, int wr, int wc, int fr, int fq) const {
        u32x4 ga[3], gb[3];
        const bf16_t* gbase = G + (size_t)(u.pm * BM + wr * 64 + fr) * DFF + u.pn * BM + wc * 32 + 8 * fq;
        const int sl0 = 2 * (slot_of_row(u.pm * BM + wr * 64) + 1), sl1 = 2 * (slot_of_row(u.pm * BM + HALF + wr * 64) + 1);
#define EU_LOAD(DST, B) do { const bf16_t* gp_ = gbase + (size_t)((((B) >> 2) & 1) * HALF + ((B) & 3) * 16 + ((((B) >> 2) & 1) ? sl1 : sl0)) * DFF + ((B) >> 3) * HALF; \
            DST[2] = *(const u32x4*)gp_; DST[1] = *(const u32x4*)(gp_ - DFF); DST[0] = *(const u32x4*)(gp_ - 2 * DFF); } while (0)
#define EU_COMP(SRC, B) do { constexpr int bj_ = (B) >> 3, ai_ = ((B) >> 2) & 1, m_ = (B) & 3; const int col_ = u.pn * BM + bj_ * HALF + wc * 32 + 8 * fq; \
            const int row_ = u.pm * BM + ai_ * HALF + wr * 64 + m_ * 16 + fr; float o_[8]; \
            _Pragma("unroll") for (int q = 0; q < 4; ++q) { \
                const float c0 = bb[2 * q] + w0[2 * q] * bf_lo(SRC[0][q]) + w1[2 * q] * bf_lo(SRC[1][q]) + w2[2 * q] * bf_lo(SRC[2][q]); \
                const float c1 = bb[2 * q + 1] + w0[2 * q + 1] * bf_hi(SRC[0][q]) + w1[2 * q + 1] * bf_hi(SRC[1][q]) + w2[2 * q + 1] * bf_hi(SRC[2][q]); \
                o_[2 * q] = c0 * fast_sigmoid(c0); o_[2 * q + 1] = c1 * fast_sigmoid(c1); } \
            const f32x4 a0 = acc[ai_][bj_][m_][0], a1 = acc[ai_][bj_][m_][1]; \
            u32x4 w_; w_.x = cvt_pk_bf16(o_[0] * a0[0], o_[1] * a0[1]); w_.y = cvt_pk_bf16(o_[2] * a0[2], o_[3] * a0[3]); w_.z = cvt_pk_bf16(o_[4] * a1[0], o_[5] * a1[1]); w_.w = cvt_pk_bf16(o_[6] * a1[2], o_[7] * a1[3]); \
            *(u32x4*)(HID + tiled_off(row_, col_, DFF / 64)) = w_; } while (0)
#define EU_PARAMS(BJ) do { const int col_ = u.pn * BM + (BJ) * HALF + wc * 32 + 8 * fq; _Pragma("unroll") for (int h = 0; h < 2; ++h) { const f32x4 a = *(const f32x4*)(cw + col_ + 4 * h), b = *(const f32x4*)(cw + DFF + col_ + 4 * h), c = *(const f32x4*)(cw + 2 * DFF + col_ + 4 * h), d = *(const f32x4*)(cb + col_ + 4 * h); \
            _Pragma("unroll") for (int j = 0; j < 4; ++j) { w0[4 * h + j] = a[j]; w1[4 * h + j] = b[j]; w2[4 * h + j] = c[j]; bb[4 * h + j] = d[j]; } } } while (0)
#define EU_STEP2(B) do { EU_LOAD(gb, (B) + 1); asm volatile("" ::: "memory"); EU_COMP(ga, B); EU_LOAD(ga, (B) + 2); asm volatile("" ::: "memory"); EU_COMP(gb, (B) + 1); } while (0)
        float w0[8], w1[8], w2[8], bb[8];
        EU_LOAD(ga, 0); EU_PARAMS(0);
        EU_STEP2(0); EU_STEP2(2); EU_STEP2(4);
        EU_LOAD(gb, 7); asm volatile("" ::: "memory"); EU_COMP(ga, 6); EU_LOAD(ga, 8); asm volatile("" ::: "memory"); EU_COMP(gb, 7);
        EU_PARAMS(1);
        EU_STEP2(8); EU_STEP2(10); EU_STEP2(12);
        EU_LOAD(gb, 15); asm volatile("" ::: "memory"); EU_COMP(ga, 14); EU_COMP(gb, 15);
#undef EU_LOAD
#undef EU_COMP
#undef EU_PARAMS
#undef EU_STEP2
    }
};
template <int CTRL> __device__ __forceinline__ float dpp_upd(float old, float src) { return __int_as_float(__builtin_amdgcn_update_dpp(__float_as_int(old), __float_as_int(src), CTRL, 0xF, 0xF, false)); }
template <int CTRL> __device__ __forceinline__ float dpp_rot(float src) { return __int_as_float(__builtin_amdgcn_mov_dpp(__float_as_int(src), CTRL, 0xF, 0xF, true)); }
struct EpiFfn {
    static constexpr bool PERM = true; static constexpr bool PERMA = true;
    static constexpr int NPRE = 1;
    __device__ __forceinline__ void prefetch(LAS unsigned char* lds, const Unit& u, int wid, int lane) const { const int a = wid >> 1; const float* src = (a < 3 ? cw + (size_t)a * DFF : cb) + u.pn * HALF + (wid & 1) * 64 + lane;
        __builtin_amdgcn_global_load_lds((const unsigned*)src, (LAS unsigned*)(lds + PAR_OFF + wid * 256), 4, 0, 0); }
    bf16_t* HID; const float* cw; const float* cb; float* convp; float* gbnd; float* defc; float* defu; LAS float* scr;
    __device__ __forceinline__ void operator()(const Acc& acc, const Unit& u, int wr, int wc, int fr, int fq) const {
        const int ch0 = u.pn * HALF + wc * 32 + 8 * fq;
#pragma unroll
        for (int ai = 0; ai < 2; ++ai) { const int k = ai * 2 + wr;
            if (fr == 15) {
#pragma unroll
                for (int rr = 0; rr < 2; ++rr) {
                    if (k < 3) { LAS float* p = scr + ((((k * 4 + wc) * 4 + fq) * 2 + rr) * 8); *(LAS f32x4*)p = acc[ai][0][2 + rr][0]; *(LAS f32x4*)(p + 4) = acc[ai][0][2 + rr][1]; }
                    else { float* p = gbnd + (size_t)(u.pm * 2 + rr) * DFF + ch0; *(f32x4*)p = acc[ai][0][2 + rr][0]; *(f32x4*)(p + 4) = acc[ai][0][2 + rr][1];
                        if ((u.pm & 31) == 31) { float* cp = convp + (size_t)((u.pm >> 5) * 2 + rr) * DFF + ch0; *(f32x4*)cp = acc[ai][0][2 + rr][0]; *(f32x4*)(cp + 4) = acc[ai][0][2 + rr][1]; } } } } }
        float w0[8], w1[8], w2[8], bb[8];
        { const LAS float* par = (const LAS float*)((LAS unsigned char*)scr + 4096) + wc * 32 + 8 * fq;
#pragma unroll
        for (int h = 0; h < 2; ++h) { const f32x4 a = *(const LAS f32x4*)(par + 4 * h), b = *(const LAS f32x4*)(par + 128 + 4 * h), c = *(const LAS f32x4*)(par + 256 + 4 * h), d = *(const LAS f32x4*)(par + 384 + 4 * h);
#pragma unroll
            for (int j = 0; j < 4; ++j) { w0[4 * h + j] = -1.4426950408889634f * a[j]; w1[4 * h + j] = -1.4426950408889634f * b[j]; w2[4 * h + j] = -1.4426950408889634f * c[j]; bb[4 * h + j] = -1.4426950408889634f * d[j]; } } }
        asm volatile("s_waitcnt lgkmcnt(0)\n\ts_barrier" ::: "memory");
#pragma unroll
        for (int ai = 0; ai < 2; ++ai) { const int k = ai * 2 + wr;
            float bm1[8], bm2[8];
            if (k >= 1) { const LAS float* p = scr + ((((k - 1) * 4 + wc) * 4 + fq) * 2) * 8; const f32x4 a = *(const LAS f32x4*)p, b = *(const LAS f32x4*)(p + 4), c = *(const LAS f32x4*)(p + 8), d = *(const LAS f32x4*)(p + 12);
#pragma unroll
                for (int j = 0; j < 4; ++j) { bm2[j] = a[j]; bm2[4 + j] = b[j]; bm1[j] = c[j]; bm1[4 + j] = d[j]; } }
            else {
#pragma unroll
                for (int e = 0; e < 8; ++e) { bm1[e] = 0.f; bm2[e] = 0.f; } }
            float s3[8], s2[8];
#pragma unroll
            for (int n = 0; n < 2; ++n)
#pragma unroll
                for (int j = 0; j < 4; ++j) { const int e = 4 * n + j; s3[e] = dpp_upd<0x111>(bm1[e], acc[ai][0][3][n][j]); s2[e] = dpp_upd<0x111>(bm2[e], acc[ai][0][2][n][j]); }
#pragma unroll
            for (int m = 0; m < 4; ++m) { const int row = u.pm * BM + ai * HALF + wr * 64 + 4 * fr + m;
                float cc[8], o[8];
#pragma unroll
                for (int n = 0; n < 2; ++n)
#pragma unroll
                    for (int j = 0; j < 4; ++j) { const int e = 4 * n + j; const float g = acc[ai][0][m][n][j];
                        const float g1 = m == 0 ? s3[e] : acc[ai][0][m > 0 ? m - 1 : 0][n][j], g2 = m == 0 ? s2[e] : (m == 1 ? s3[e] : acc[ai][0][m > 1 ? m - 2 : 0][n][j]);
                        const float c = bb[e] + w0[e] * g2 + w1[e] * g1 + w2[e] * g; cc[e] = c; o[e] = c * __builtin_amdgcn_rcpf(1.0f + __builtin_amdgcn_exp2f(c)) * acc[ai][1][m][n][j]; }
                u32x4 w_; w_.x = cvt_pk_bf16(o[0], o[1]); w_.y = cvt_pk_bf16(o[2], o[3]); w_.z = cvt_pk_bf16(o[4], o[5]); w_.w = cvt_pk_bf16(o[6], o[7]);
                *(u32x4*)(HID + tiled_off(row, ch0, DFF / 64)) = w_;
                if (m < 2 && k == 0 && fr == 0) { float* pc = defc + (size_t)(u.pm * 2 + m) * DFF + ch0; float* pu = defu + (size_t)(u.pm * 2 + m) * DFF + ch0;
                    *(f32x4*)pc = (f32x4){cc[0], cc[1], cc[2], cc[3]}; *(f32x4*)(pc + 4) = (f32x4){cc[4], cc[5], cc[6], cc[7]}; *(f32x4*)pu = acc[ai][1][m][0]; *(f32x4*)(pu + 4) = acc[ai][1][m][1]; } }
        }
    }
};
struct EpiPartial {
    static constexpr int NPRE = 0; static constexpr bool PERMA = false;
    static constexpr bool PERM = false;
    float* P; int ldc;
    __device__ __forceinline__ void operator()(const Acc& acc, const Unit& u, int wr, int wc, int fr, int fq) const {
        const int row0 = (u.pm - 128) * BM + wr * 64 + fr, col0 = u.pn * BM + wc * 32 + 4 * fq;
        float* base = P + ((size_t)u.ks * 512 + row0) * ldc + col0;
#pragma unroll
        for (int ai = 0; ai < 2; ++ai)
#pragma unroll
            for (int m = 0; m < 4; ++m) { float* rowp = base + (size_t)(ai * HALF + m * 16) * ldc;
#pragma unroll
                for (int bj = 0; bj < 2; ++bj)
#pragma unroll
                    for (int n = 0; n < 2; ++n) *(f32x4*)(rowp + bj * HALF + n * 16) = acc[ai][bj][m][n]; }
    }
};
struct EpiXloc {
    static constexpr int NPRE = 0; static constexpr bool PERMA = false;
    static constexpr bool PERM = true;
    bf16_t* X;
    __device__ __forceinline__ void operator()(const Acc& acc, const Unit& u, int wr, int wc, int fr, int fq) const {
        const int row0 = u.pm * BM + wr * 64 + fr, col0 = wc * 32 + 8 * fq;
#pragma unroll
        for (int ai = 0; ai < 2; ++ai)
#pragma unroll
            for (int m = 0; m < 4; ++m) *(u32x4*)(X + (size_t)(row0 + ai * HALF + m * 16) * 128 + col0) = pack8(acc[ai][0][m][0], acc[ai][0][m][1]);
    }
};
struct EpiY {
    static constexpr int NPRE = 0; static constexpr bool PERMA = false;
    static constexpr bool PERM = true;
    const bf16_t* UP; bf16_t* Z; const float* Dv;
    __device__ __forceinline__ void operator()(const Acc& acc, const Unit& u, int wr, int wc, int fr, int fq) const {
        const int g = u.pn, cbase = (u.pm - 9 * g) * BM;
        const int q0 = (8 * fq) & 15;
        const f32x4 d0 = *(const f32x4*)(Dv + 16 * g + q0), d1 = *(const f32x4*)(Dv + 16 * g + q0 + 4);
#pragma unroll
        for (int ai = 0; ai < 2; ++ai) {
            const int c0 = cbase + ai * HALF + wr * 64 + fr;
            u32x4 uq[4][2];
#pragma unroll
            for (int m = 0; m < 4; ++m) { const int c = c0 + m * 16 < 2080 ? c0 + m * 16 : 2079;
#pragma unroll
                for (int bj = 0; bj < 2; ++bj) uq[m][bj] = *(const u32x4*)(UP + ((size_t)g * NSUB + c) * 384 + bj * HALF + wc * 32 + 8 * fq); }
#pragma unroll
            for (int m = 0; m < 4; ++m) { const int c = c0 + m * 16;
                if (c < 2080) {
#pragma unroll
                    for (int bj = 0; bj < 2; ++bj) { const int cc = bj * HALF + wc * 32 + 8 * fq; const int t = cc >> 4;
                        const u32x4 uu = uq[m][bj];
                        const f32x4 a0 = acc[ai][bj][m][0], a1 = acc[ai][bj][m][1];
                        float y[8];
                        y[0] = a0[0] + d0[0] * bf_lo(uu[0]); y[1] = a0[1] + d0[1] * bf_hi(uu[0]); y[2] = a0[2] + d0[2] * bf_lo(uu[1]); y[3] = a0[3] + d0[3] * bf_hi(uu[1]);
                        y[4] = a1[0] + d1[0] * bf_lo(uu[2]); y[5] = a1[1] + d1[1] * bf_hi(uu[2]); y[6] = a1[2] + d1[2] * bf_lo(uu[3]); y[7] = a1[3] + d1[3] * bf_hi(uu[3]);
#pragma unroll
                        for (int j = 0; j < 8; ++j) { const float v = y[j]; const float w2 = v * (-2.3022081983f + -0.1029432395f * (v * v)); y[j] = v * __builtin_amdgcn_rcpf(1.0f + __builtin_amdgcn_exp2f(w2)); }
                        u32x4 w; w.x = cvt_pk_bf16(y[0], y[1]); w.y = cvt_pk_bf16(y[2], y[3]); w.z = cvt_pk_bf16(y[4], y[5]); w.w = cvt_pk_bf16(y[6], y[7]);
                        *(u32x4*)(Z + (size_t)(16 * c + t) * DM + 16 * g + q0) = w; }
                } }
            asm volatile("" ::: "memory");
        }
    }
};
}

namespace att {
constexpr int SHM_V = 64 * 128 * 2, SHM_K = 64 * 384, OFF_V = 0, OFF_K = 3 * SHM_V, OFF_SCR = OFF_K + 3 * SHM_K, ATT_LDS = OFF_SCR + 8 * 256;
static_assert(ATT_LDS <= 131072, "attention LDS");
constexpr float THR2 = 11.54f;
#define SBAR() __builtin_amdgcn_sched_barrier(0)
__device__ __forceinline__ int crow(int r, int hi) { return (r & 3) + 8 * (r >> 2) + 4 * hi; }
__device__ __forceinline__ int kswz(int row, int c16) { return row * 384 + ((c16 ^ ((row >> 1) & 7)) << 4); }
template <bool FX> __device__ __forceinline__ void partialSM(f32x16& p0, f32x16& p1, float& m_reg, float& mn, float& alpha, bool vis) {
  if (!vis) {
#pragma unroll
    for (int r = 0; r < 16; ++r) { p0[r] = -__builtin_inff(); p1[r] = -__builtin_inff(); } }
  if constexpr (FX) { mn = 0.f; alpha = 1.f;
#pragma unroll
    for (int r = 0; r < 16; ++r) p0[r] = __builtin_amdgcn_exp2f(p0[r]);
    return; }
  float pmax = p0[0];
#pragma unroll
  for (int r = 1; r < 16; ++r) pmax = fmaxf(pmax, p0[r]);
#pragma unroll
  for (int r = 0; r < 16; ++r) pmax = fmaxf(pmax, p1[r]);
  { auto rr = __builtin_amdgcn_permlane32_swap(__float_as_uint(pmax), __float_as_uint(pmax), false, false);
    pmax = fmaxf(__uint_as_float(rr[0]), __uint_as_float(rr[1])); }
  if (__builtin_expect(__all(pmax - m_reg <= THR2), 1)) { mn = m_reg; alpha = 1.f; }
  else { mn = fmaxf(m_reg, pmax); alpha = __builtin_amdgcn_exp2f(m_reg - mn); m_reg = mn; }
#pragma unroll
  for (int r = 0; r < 16; ++r) p0[r] = __builtin_amdgcn_exp2f(p0[r] - mn);
#pragma unroll
  for (int r = 0; r < 16; ++r) p1[r] = p1[r] - mn;
}
__device__ __forceinline__ void finishSM(f32x16& p0, f32x16& p1, float alpha, float& l_reg, bf16x8& pa0, bf16x8& pa1, bf16x8& pa2, bf16x8& pa3) {
#pragma unroll
  for (int r = 0; r < 16; ++r) p1[r] = __builtin_amdgcn_exp2f(p1[r]);
  float ps = 0;
#pragma unroll
  for (int r = 0; r < 16; ++r) ps += p0[r];
#pragma unroll
  for (int r = 0; r < 16; ++r) ps += p1[r];
  { auto rr = __builtin_amdgcn_permlane32_swap(__float_as_uint(ps), __float_as_uint(ps), false, false);
    ps = __uint_as_float(rr[0]) + __uint_as_float(rr[1]); }
  l_reg = l_reg * alpha + ps;
#define PK4(P, BASE, OUT) do { unsigned a0 = cvt_pk_bf16(P[BASE + 0], P[BASE + 1]), a1 = cvt_pk_bf16(P[BASE + 2], P[BASE + 3]);   \
    unsigned b0 = cvt_pk_bf16(P[BASE + 4], P[BASE + 5]), b1 = cvt_pk_bf16(P[BASE + 6], P[BASE + 7]);                              \
    auto r0 = __builtin_amdgcn_permlane32_swap(a0, b0, false, false); auto r1 = __builtin_amdgcn_permlane32_swap(a1, b1, false, false); \
    u32x4 w = {r0[0], r1[0], r0[1], r1[1]}; OUT = *reinterpret_cast<bf16x8*>(&w); } while (0)
  PK4(p0, 0, pa0); PK4(p0, 8, pa1); PK4(p1, 0, pa2); PK4(p1, 8, pa3);
#undef PK4
}
__device__ __forceinline__ void qkt(f32x16& p0, f32x16& p1, const bf16x8* qr, const int* kb, int so) {
  p0 = f32x16{}; p1 = f32x16{};
  const int k0 = kb[0] + so, k1 = kb[1] + so, k2 = kb[2] + so, k3 = kb[3] + so;
  bf16x8 fa[4], fb[4];
#define KADDR(d0) (((d0) & 3) == 0 ? k0 : ((d0) & 3) == 1 ? k1 : ((d0) & 3) == 2 ? k2 : k3)
#define LOADK(F, d0) do { F[0] = *(const LAS bf16x8*)(uintptr_t)(unsigned)(KADDR(d0) + ((d0) >> 2) * 128); F[1] = *(const LAS bf16x8*)(uintptr_t)(unsigned)(KADDR(d0) + ((d0) >> 2) * 128 + 32 * 384); \
    F[2] = *(const LAS bf16x8*)(uintptr_t)(unsigned)(KADDR((d0) + 1) + (((d0) + 1) >> 2) * 128); F[3] = *(const LAS bf16x8*)(uintptr_t)(unsigned)(KADDR((d0) + 1) + (((d0) + 1) >> 2) * 128 + 32 * 384); } while (0)
#define MMAK(F, d0) do { p0 = __builtin_amdgcn_mfma_f32_32x32x16_bf16(F[0], qr[d0], p0, 0, 0, 0); p1 = __builtin_amdgcn_mfma_f32_32x32x16_bf16(F[1], qr[d0], p1, 0, 0, 0); \
    p0 = __builtin_amdgcn_mfma_f32_32x32x16_bf16(F[2], qr[(d0) + 1], p0, 0, 0, 0); p1 = __builtin_amdgcn_mfma_f32_32x32x16_bf16(F[3], qr[(d0) + 1], p1, 0, 0, 0); } while (0)
  LOADK(fa, 0); SBAR(); LOADK(fb, 2); SBAR();
  MMAK(fa, 0); SBAR(); LOADK(fa, 4); SBAR();
  MMAK(fb, 2); SBAR(); LOADK(fb, 6); SBAR();
  MMAK(fa, 4); SBAR(); LOADK(fa, 8); SBAR();
  MMAK(fb, 6); SBAR(); LOADK(fb, 10); SBAR();
  MMAK(fa, 8); SBAR();
  MMAK(fb, 10); SBAR();
#undef KADDR
#undef LOADK
#undef MMAK
}
__device__ __forceinline__ int v_st(int k, int c) { const int kk = (k & ~0xC) | ((k & 4) << 1) | ((k & 8) >> 1); return ((kk >> 3) * 4 + (c >> 5)) * 512 + ((kk & 7) * 32 + (c & 31)) * 2; }
__device__ __forceinline__ int v_rd_base(int lane) { return ((lane & 3) << 3) | (((lane >> 2) & 3) << 6) | (((lane >> 4) & 1) << 5) | (((lane >> 5) & 1) << 8); }
constexpr int v_rd_off(int d0, int ks, int half) { return d0 * 512 + ks * 4096 + half * 2048; }
typedef short v4i16_t __attribute__((ext_vector_type(4)));
template <int OFF> __device__ __forceinline__ s16x4 tr_read(int vb) {
  return __builtin_bit_cast(s16x4, __builtin_amdgcn_ds_read_tr16_b64_v4i16((LAS v4i16_t*)(uintptr_t)(unsigned)(vb + OFF)));
}
template <int D0> __device__ __forceinline__ void pv_load(s16x4* f, int vb) {
  f[0] = tr_read<v_rd_off(D0, 0, 0)>(vb); f[1] = tr_read<v_rd_off(D0, 0, 1)>(vb); f[2] = tr_read<v_rd_off(D0, 1, 0)>(vb); f[3] = tr_read<v_rd_off(D0, 1, 1)>(vb);
  f[4] = tr_read<v_rd_off(D0, 2, 0)>(vb); f[5] = tr_read<v_rd_off(D0, 2, 1)>(vb); f[6] = tr_read<v_rd_off(D0, 3, 0)>(vb); f[7] = tr_read<v_rd_off(D0, 3, 1)>(vb);
}
__device__ __forceinline__ void pv_mma(f32x16& od, const s16x4* f, bf16x8 pa0, bf16x8 pa1, bf16x8 pa2, bf16x8 pa3) {
#define PK(L, H) (bf16x8){L[0], L[1], L[2], L[3], H[0], H[1], H[2], H[3]}
  od = __builtin_amdgcn_mfma_f32_32x32x16_bf16(pa0, PK(f[0], f[1]), od, 0, 0, 0);
  od = __builtin_amdgcn_mfma_f32_32x32x16_bf16(pa1, PK(f[2], f[3]), od, 0, 0, 0);
  od = __builtin_amdgcn_mfma_f32_32x32x16_bf16(pa2, PK(f[4], f[5]), od, 0, 0, 0);
  od = __builtin_amdgcn_mfma_f32_32x32x16_bf16(pa3, PK(f[6], f[7]), od, 0, 0, 0);
#undef PK
}
__device__ __forceinline__ void pv_d0(f32x16* o, int vb, bf16x8 pa0, bf16x8 pa1, bf16x8 pa2, bf16x8 pa3) {
  s16x4 va[8], vbf[8];
  pv_load<0>(va, vb); SBAR(); pv_load<1>(vbf, vb); SBAR();
  pv_mma(o[0], va, pa0, pa1, pa2, pa3); SBAR(); pv_load<2>(va, vb); SBAR();
  pv_mma(o[1], vbf, pa0, pa1, pa2, pa3); SBAR(); pv_load<3>(vbf, vb); SBAR();
  pv_mma(o[2], va, pa0, pa1, pa2, pa3); SBAR();
  pv_mma(o[3], vbf, pa0, pa1, pa2, pa3); SBAR();
}
__device__ __forceinline__ int k_src(int s) { const int row = s / 24, cp = s - row * 24, c = cp ^ ((row >> 1) & 7); return row * 5120 + c * 8; }
__device__ __forceinline__ int v_src(int s) { const int sub = s >> 5, w = s & 31, kk = (sub >> 2) * 8 + (w >> 2), c = (sub & 3) * 32 + (w & 3) * 8; const int k = (kk & ~0xC) | ((kk & 4) << 1) | ((kk & 8) >> 1); return k * 5120 + c; }
template <bool FX> __device__ __forceinline__ void attn_unit(const bf16_t* __restrict__ Qb, const bf16_t* __restrict__ Kh, const bf16_t* __restrict__ Vh, bf16_t* __restrict__ Ob,
                                          int NT, int NTreal, int nvis, int wq, int rev, LAS char* lds, const int tid, const float* __restrict__ gqn, const float* __restrict__ rope, int pos0) {
  int lane_ = tid & 63; asm volatile("" : "+v"(lane_));
  const int wid = __builtin_amdgcn_readfirstlane(tid >> 6), lane = lane_, r32 = lane & 31, hi = lane >> 5, grp = wid >> 2;
  LAS char* V_lds = lds + OFF_V; LAS char* K_lds = lds + OFF_K;
  LAS float* ws = (LAS float*)(lds + OFF_SCR) + wid * 64; LAS float* li_l = ws; LAS float* al_l = ws + 32;
  float m_reg = -1e30f, l_reg = 0; f32x16 o[4] = {}; bf16x8 qr[12];
  const bf16_t* Qw = Qb + (size_t)(wq * 32 + r32) * 3072 + hi * 8;
  {
    u32x4 raw[12];
#pragma unroll
    for (int d0 = 0; d0 < 12; ++d0) raw[d0] = *(const u32x4*)(Qw + d0 * 16);
    float ss = 0.f;
#pragma unroll
    for (int d0 = 0; d0 < 12; ++d0)
#pragma unroll
      for (int e = 0; e < 4; ++e) { const float a = bf_lo(raw[d0][e]), b = bf_hi(raw[d0][e]); ss += a * a + b * b; }
    { auto rr = __builtin_amdgcn_permlane32_swap(__float_as_uint(ss), __float_as_uint(ss), false, false); ss = __uint_as_float(rr[0]) + __uint_as_float(rr[1]); }
    const float rq = (1.0f / sqrtf(ss * (1.0f / 192.0f) + EPS)) * (0.07216878364870323f * 1.4426950408889634f);
#pragma unroll
    for (int d0 = 0; d0 < 8; ++d0) { const f32x4 g0 = *(const f32x4*)(gqn + d0 * 16 + hi * 8), g1 = *(const f32x4*)(gqn + d0 * 16 + hi * 8 + 4); u32x4 w;
      w.x = cvt_pk_bf16(bf_lo(raw[d0][0]) * rq * g0[0], bf_hi(raw[d0][0]) * rq * g0[1]); w.y = cvt_pk_bf16(bf_lo(raw[d0][1]) * rq * g0[2], bf_hi(raw[d0][1]) * rq * g0[3]);
      w.z = cvt_pk_bf16(bf_lo(raw[d0][2]) * rq * g1[0], bf_hi(raw[d0][2]) * rq * g1[1]); w.w = cvt_pk_bf16(bf_lo(raw[d0][3]) * rq * g1[2], bf_hi(raw[d0][3]) * rq * g1[3]);
      qr[d0] = *reinterpret_cast<bf16x8*>(&w); }
    const float* rt = rope + (size_t)(pos0 + wq * 32 + r32) * 64;
#pragma unroll
    for (int dd = 0; dd < 2; ++dd) {
      u32x4 w1, w2;
#pragma unroll
      for (int e2 = 0; e2 < 4; ++e2) { const int j = 16 * dd + 8 * hi + 2 * e2;
        const f32x4 cs = *(const f32x4*)(rt + 2 * j);
        const f32x2 ga = *(const f32x2*)(gqn + 128 + j), gb = *(const f32x2*)(gqn + 160 + j);
        const float x10 = bf_lo(raw[8 + dd][e2]) * rq * ga.x, x11 = bf_hi(raw[8 + dd][e2]) * rq * ga.y, x20 = bf_lo(raw[10 + dd][e2]) * rq * gb.x, x21 = bf_hi(raw[10 + dd][e2]) * rq * gb.y;
        w1[e2] = cvt_pk_bf16(x10 * cs[0] - x20 * cs[1], x11 * cs[2] - x21 * cs[3]);
        w2[e2] = cvt_pk_bf16(x10 * cs[1] + x20 * cs[0], x11 * cs[3] + x21 * cs[2]); }
      qr[8 + dd] = *reinterpret_cast<bf16x8*>(&w1); qr[10 + dd] = *reinterpret_cast<bf16x8*>(&w2); }
  }
  int kb[4];
#pragma unroll
  for (int v = 0; v < 4; ++v) kb[v] = (int)(uintptr_t)K_lds + r32 * 384 + ((((2 * v) | hi) ^ ((r32 >> 1) & 7)) << 4);
  unsigned kg[3], vg[2];
#pragma unroll
  for (int i = 0; i < 3; ++i) kg[i] = (unsigned)k_src((wid * 3 + i) * 64 + lane) * 2u;
#pragma unroll
  for (int i = 0; i < 2; ++i) vg[i] = (unsigned)v_src((wid * 2 + i) * 64 + lane) * 2u;
  const int vb0 = (int)(uintptr_t)V_lds + v_rd_base(lane);
#define DMA(jt, st) do { const int _p = rev ? NT - 1 - (jt) : (jt); const int _t = _p < NTreal ? _p : NTreal - 1; const char* _k = (const char*)(Kh + (size_t)_t * 64 * 5120); const char* _v = (const char*)(Vh + (size_t)_t * 64 * 5120); \
    _Pragma("unroll") for (int _i = 0; _i < 3; ++_i) __builtin_amdgcn_global_load_lds((const unsigned*)(_k + kg[_i]), (LAS unsigned*)(K_lds + (st) * SHM_K + (wid * 3 + _i) * 1024), 16, 0, 0); \
    _Pragma("unroll") for (int _i = 0; _i < 2; ++_i) __builtin_amdgcn_global_load_lds((const unsigned*)(_v + vg[_i]), (LAS unsigned*)(V_lds + (st) * SHM_V + (wid * 2 + _i) * 1024), 16, 0, 0); } while (0)
#define WAITBAR(N) asm volatile("s_waitcnt vmcnt(" #N ")\n\ts_barrier" ::: "memory")
#define RESC(a) do { if constexpr (!FX) if (__any((a) < 1.f)) { if (hi == 0) al_l[r32] = (a); asm volatile("s_waitcnt lgkmcnt(0)" ::: "memory"); \
    _Pragma("unroll") for (int d = 0; d < 4; ++d) _Pragma("unroll") for (int r = 0; r < 16; ++r) o[d][r] *= al_l[crow(r, hi)]; } } while (0)
#define VIS(j) ((rev ? NT - 1 - (j) : (j)) < nvis)
  if (grp) __builtin_amdgcn_s_setprio(1);
  f32x16 pA0, pA1, pB0, pB1; float mnA, mnB, alA, alB; bf16x8 pa0, pa1, pa2, pa3;
  int sp = 0, sc = 1, sn = 2;
  DMA(0, 0); DMA(1, 1);
  WAITBAR(5);
  if (VIS(0)) qkt(pA0, pA1, qr, kb, 0);
  partialSM<FX>(pA0, pA1, m_reg, mnA, alA, VIS(0));
  for (int j = 1; j + 1 < NT; j += 2) {
    WAITBAR(0);
    DMA(j + 1, sn);
    SBAR(); if (VIS(j)) qkt(pB0, pB1, qr, kb, sc * SHM_K);
    finishSM(pA0, pA1, alA, l_reg, pa0, pa1, pa2, pa3); SBAR();
    if (VIS(j - 1)) pv_d0(o, vb0 + sp * SHM_V, pa0, pa1, pa2, pa3);
    partialSM<FX>(pB0, pB1, m_reg, mnB, alB, VIS(j));
    RESC(alB);
    { const int t = sp; sp = sc; sc = sn; sn = t; }
    WAITBAR(0);
    DMA(j + 2, sn);
    SBAR(); if (VIS(j + 1)) qkt(pA0, pA1, qr, kb, sc * SHM_K);
    finishSM(pB0, pB1, alB, l_reg, pa0, pa1, pa2, pa3); SBAR();
    if (VIS(j)) pv_d0(o, vb0 + sp * SHM_V, pa0, pa1, pa2, pa3);
    partialSM<FX>(pA0, pA1, m_reg, mnA, alA, VIS(j + 1));
    RESC(alA);
    { const int t = sp; sp = sc; sc = sn; sn = t; }
  }
  WAITBAR(0);
  SBAR(); if (VIS(NT - 1)) qkt(pB0, pB1, qr, kb, sc * SHM_K);
  finishSM(pA0, pA1, alA, l_reg, pa0, pa1, pa2, pa3); SBAR();
  if (VIS(NT - 2)) pv_d0(o, vb0 + sp * SHM_V, pa0, pa1, pa2, pa3);
  partialSM<FX>(pB0, pB1, m_reg, mnB, alB, VIS(NT - 1));
  RESC(alB);
  finishSM(pB0, pB1, alB, l_reg, pa0, pa1, pa2, pa3); SBAR();
  if (VIS(NT - 1)) pv_d0(o, vb0 + sc * SHM_V, pa0, pa1, pa2, pa3);
  if (nvis > 0) {
    if (hi == 0) li_l[r32] = l_reg; asm volatile("s_waitcnt lgkmcnt(0)" ::: "memory");
    bf16_t* Ow = Ob + (size_t)(wq * 32) * 2048;
    const bool odd = (lane & 1) != 0;
#pragma unroll
    for (int r = 0; r < 16; r += 2) {
      const float ra = __builtin_amdgcn_rcpf(li_l[crow(r, hi)]), rb = __builtin_amdgcn_rcpf(li_l[crow(r + 1, hi)]);
      const int orow = odd ? crow(r + 1, hi) : crow(r, hi);
#pragma unroll
      for (int d0 = 0; d0 < 4; ++d0) {
        const float e = o[d0][r] * ra, f = o[d0][r + 1] * rb;
        const float keep = odd ? f : e, send = odd ? e : f;
        const float got = __int_as_float(__builtin_amdgcn_mov_dpp(__float_as_int(send), 0xB1, 0xF, 0xF, true));
        const unsigned w = odd ? cvt_pk_bf16(got, keep) : cvt_pk_bf16(keep, got);
        *(unsigned*)(Ow + (size_t)orow * 2048 + d0 * 32 + (r32 & ~1)) = w; } }
  }
  __builtin_amdgcn_s_setprio(0);
  asm volatile("s_waitcnt lgkmcnt(0)\n\ts_barrier" ::: "memory");
#undef DMA
#undef VIS
#undef WAITBAR
#undef RESC
}
}

#define XB_TMO      128
#define XB_XCNT(j)  (256  + 64 * (j))
#define XB_XSUB(j)  (1280 + 64 * (j))
#define XB_XGEN(j)  (2304 + 64 * (j))
#define XB_TOP      3328
#define XB_TOPGEN   3392
#define XCD_BAR_WORDS 3456
#define XB_SPIN_CAP (1u << 18)
__device__ __forceinline__ unsigned xb_ld(unsigned* p)              { return __hip_atomic_load(p, __ATOMIC_RELAXED, __HIP_MEMORY_SCOPE_AGENT); }
__device__ __forceinline__ unsigned xb_add(unsigned* p, unsigned v) { return __hip_atomic_fetch_add(p, v, __ATOMIC_RELAXED, __HIP_MEMORY_SCOPE_AGENT); }
__device__ __forceinline__ unsigned xb_xcc_id() { return (unsigned)__builtin_amdgcn_s_getreg((3 << 11) | 20) & 0xFu; }
#define XB_SPIN(cond, bar) do { unsigned _sp = 0; while (cond) { __builtin_amdgcn_s_sleep(1); \
    if ((++_sp & 255u) == 0u) { if (xb_ld(&(bar)[XB_TMO])) break; if (_sp > XB_SPIN_CAP) { atomicAdd(&(bar)[XB_TMO], 1u); break; } } } } while (0)
struct XcdBarrier { unsigned* bar; unsigned x; volatile LAS unsigned* st; };
__device__ __forceinline__ XcdBarrier xcd_barrier_post(unsigned* bar, volatile LAS unsigned* st) {
    XcdBarrier b; b.bar = bar; b.x = xb_xcc_id(); b.st = st;
    if (threadIdx.x == 0) (void)xb_add(&bar[XB_XCNT(b.x)], 1u);
    return b;
}
__device__ __forceinline__ void xcd_barrier_complete(unsigned* bar, unsigned x, unsigned& nloc, unsigned& nx) {
    const unsigned G = gridDim.x * gridDim.y * gridDim.z;
    unsigned sum, cnt, mine, sp = 0u;
    for (;;) {
        sum = 0u; cnt = 0u; mine = 0u;
#pragma unroll
        for (unsigned j = 0; j < 16; ++j) { const unsigned c = xb_ld(&bar[XB_XCNT(j)]); sum += c; cnt += (c > 0u) ? 1u : 0u; mine = (j == x) ? c : mine; }
        if (sum == G) break;
        __builtin_amdgcn_s_sleep(1);
        if ((++sp & 255u) == 0u) { if (xb_ld(&bar[XB_TMO])) break; if (sp > XB_SPIN_CAP) { atomicAdd(&bar[XB_TMO], 1u); break; } }
    }
    nloc = mine > 0u ? mine : 1u; nx = cnt > 0u ? cnt : 1u;
}
__device__ __forceinline__ void xcd_barrier(const XcdBarrier& b, const int tid) {
    asm volatile("s_waitcnt vmcnt(0)" ::: "memory");
    __syncthreads();
    if (tid == 0) {
        unsigned* bar = b.bar; asm volatile("" : "+s"(bar));
        __builtin_amdgcn_s_waitcnt(0);
        unsigned nloc = b.st[0], nx = b.st[1];
        if (nloc == 0u) { xcd_barrier_complete(bar, b.x, nloc, nx); b.st[0] = nloc; b.st[1] = nx; }
        const unsigned old = xb_add(&bar[XB_XSUB(b.x)], 1u);
        const unsigned gen = old / nloc;
        if (old + 1u == (gen + 1u) * nloc) {
            __builtin_amdgcn_fence(__ATOMIC_RELEASE, "agent");
            asm volatile("s_waitcnt vmcnt(0)" ::: "memory");
            const unsigned og = xb_add(&bar[XB_TOP], 1u);
            const unsigned tg = og / nx;
            if (og + 1u == (tg + 1u) * nx) xb_add(&bar[XB_TOPGEN], 1u);
            else XB_SPIN(xb_ld(&bar[XB_TOPGEN]) == tg, bar);
            __builtin_amdgcn_fence(__ATOMIC_ACQUIRE, "agent");
            xb_add(&bar[XB_XGEN(b.x)], 1u);
            asm volatile("s_waitcnt vmcnt(0)" ::: "memory");
        } else {
            XB_SPIN(xb_ld(&bar[XB_XGEN(b.x)]) == gen, bar);
            __builtin_amdgcn_fence(__ATOMIC_ACQUIRE, "agent");
            asm volatile("s_waitcnt vmcnt(0)" ::: "memory");
        }
    }
    __syncthreads();
}

struct Args { const float* in[37]; float* out; unsigned char* ws; int ph_lo, ph_hi; };
enum { I_XP = 0, I_XS, I_CCKV, I_CKR, I_SRE, I_SIM, I_CCONV, I_CP, I_CS, I_WMOD, I_BMOD, I_GMIX, I_GFFN, I_WDQ, I_GQA, I_WUQ, I_GQN, I_WDKV, I_GKVA, I_WUKV, I_GKN, I_WO,
       I_ARE, I_AIM, I_LDT, I_BRE, I_BIM, I_CRE, I_CIM, I_SD, I_WGLU, I_WSG, I_FG, I_FU, I_FCW, I_FCB, I_FD };

__device__ const double ROPE_INV[32] = {
 1.0, 0.7498942093324559, 0.5623413251903491, 0.4216965034285822, 0.31622776601683794, 0.23713737056616552, 0.1778279410038923, 0.1333521432163324,
 0.1, 0.07498942093324558, 0.05623413251903491, 0.04216965034285822, 0.03162277660168379, 0.023713737056616554, 0.01778279410038923, 0.01333521432163324,
 0.01, 0.007498942093324558, 0.005623413251903491, 0.004216965034285823, 0.0031622776601683794, 0.0023713737056616554, 0.0017782794100389228, 0.001333521432163324,
 0.001, 0.0007498942093324559, 0.0005623413251903491, 0.0004216965034285823, 0.00031622776601683794, 0.00023713737056616554, 0.00017782794100389227, 0.0001333521432163324 };
__device__ __forceinline__ void sincos_red(double a, float& s, float& c) {
    const double k = __builtin_rint(a * 0.15915494309189535);
    const float r = (float)__builtin_fma(-k, 6.283185307179586, a);
    s = __sinf(r); c = __cosf(r);
}

__device__ __forceinline__ void transpose_item(const float* W, int K, int N, bf16_t* WT, int row_off, int mode, LAS float* scr, int item, int lane, const float sc = 1.0f, const float* ksc = nullptr) {
    const int nblk = N / 32, kb = item / nblk, nb = item - kb * nblk, k0 = 64 * kb, n0 = 32 * nb;
#pragma unroll 8
    for (int i = 0; i < 32; ++i) { const int kk = 2 * i + (lane >> 5); scr[kk * 33 + (lane & 31)] = W[(size_t)(k0 + kk) * N + n0 + (lane & 31)] * (ksc ? ksc[k0 + kk] : 1.0f); }
    LDS_WAIT(); asm volatile("" ::: "memory");
    const int c = lane & 7;
#pragma unroll
    for (int j = 0; j < 4; ++j) { const int n = (lane >> 3) + 8 * j; const LAS float* s = scr + (8 * c) * 33 + n;
        u32x4 o; o.x = cvt_pk_bf16(sc * s[0 * 33], sc * s[1 * 33]); o.y = cvt_pk_bf16(sc * s[2 * 33], sc * s[3 * 33]); o.z = cvt_pk_bf16(sc * s[4 * 33], sc * s[5 * 33]); o.w = cvt_pk_bf16(sc * s[6 * 33], sc * s[7 * 33]);
        const int nn = n0 + n; const int drow = mode == 0 ? row_off + nn : ((nn >> 7) * 256 + (nn & 127) + (mode == 2 ? 128 : 0));
        if (mode == 3) *(u32x4*)(WT + pg8::tiled_off(nn, k0 + 8 * c, K / 64)) = o;
        else *(u32x4*)(WT + (size_t)drow * K + k0 + 8 * c) = o; }
    LDS_WAIT(); asm volatile("" ::: "memory");
}

__global__ void __launch_bounds__(NWAVES * 64, 2) fwd_kernel(Args args) {
    extern __shared__ __attribute__((aligned(16))) unsigned char lds_raw[];
    LAS unsigned char* lds = (LAS unsigned char*)lds_raw;
    volatile LAS unsigned* MISC = (volatile LAS unsigned*)(lds + MISC_OFF);
    const int tid0 = threadIdx.x; const int wave0 = __builtin_amdgcn_readfirstlane(tid0 >> 6);
    const int G = gridDim.x; const int bx = blockIdx.x; const int vcu = (G % 8 == 0) ? (bx % 8) * (G / 8) + bx / 8 : bx;
    const int NGW = G * NWAVES;
    unsigned char* ws0 = args.ws; float* out0 = args.out;
    unsigned* ctl = (unsigned*)(ws0 + WS_CTL);
    for (int u = tid0; u < 64; u += NWAVES * 64) ((LAS unsigned*)(lds + MISC_OFF))[u] = 0u;
    __syncthreads();
    XcdBarrier bar; bar.bar = ctl + 1024; bar.x = 0; bar.st = nullptr;
    if (!MK_PER_PHASE) bar = xcd_barrier_post(ctl + 1024, MISC + 8);
    const int lo = args.ph_lo, hi = args.ph_hi;
    int ph = 0;
#define PH_BEGIN if (lo <= ph && ph < hi) { int tid; asm volatile("v_mbcnt_lo_u32_b32 %0, -1, 0\n\tv_mbcnt_hi_u32_b32 %0, -1, %0" : "=v"(tid)); tid |= wave0 << 6; \
    const int lane = tid & 63, wave = __builtin_amdgcn_readfirstlane(tid >> 6), gw = vcu * NWAVES + wave; (void)lane; (void)gw; \
    __attribute__((address_space(1))) unsigned char* wsg_; __attribute__((address_space(1))) float* outg_; asm volatile("s_mov_b64 %0, %1" : "=s"(wsg_) : "s"(ws0)); asm volatile("s_mov_b64 %0, %1" : "=s"(outg_) : "s"(out0)); unsigned char* ws = (unsigned char*)wsg_; float* out = (float*)outg_; (void)ws; (void)out;
#define PH_END if (ph + 1 < hi) xcd_barrier(bar, tid); } ++ph;

#define MOD ((float*)(ws + WS_MOD))
#define A16 ((float*)(ws + WS_A16))
#define KRSS ((float*)(ws + WS_KRSS))
#define ROPE ((float*)(ws + WS_ROPE))
#define Hb ((bf16_t*)(ws + WS_H))
#define QA ((bf16_t*)((unsigned char*)out + OY_QA))
#define CKV ((bf16_t*)((unsigned char*)out + OY_CKV))
#define Rr ((float*)((unsigned char*)out + OY_R))
#define STATQ ((float*)((unsigned char*)out + OY_STATQ))
#define RSTDQ ((float*)((unsigned char*)out + OY_RSTDQ))
#define XBs ((bf16_t*)(ws + WS_XB))
#define Qb ((bf16_t*)(ws + WS_Q))
#define KB ((bf16_t*)(ws + WS_KB))
#define QKVA ((float*)(ws + WS_QKVA))
#define Gb ((bf16_t*)(ws + WS_G))
#define HID ((bf16_t*)(ws + WS_HID))
#define GBND ((float*)(ws + WS_G))
#define DEFC ((float*)(ws + WS_G + 8 * MiB))
#define DEFU ((float*)(ws + WS_G + 16 * MiB))
#define UP ((bf16_t*)(ws + WS_UP))
#define XLOC ((bf16_t*)(ws + WS_XLOC))
#define PART ((float*)(ws + WS_PART))
#define PGU ((float*)(ws + WS_PGU))

    PH_BEGIN
#ifndef NO_P0
    {
        for (int it = vcu; it < 4 * 64; it += G) {
            const int l = it >> 6, cb = it & 63;
            LAS float* sc = (LAS float*)lds;
            for (int e = tid; e < NSLOT * DM; e += NWAVES * 64) { const int s = e >> 11, k = e & 2047; const float c = s < 4 ? args.in[I_CP][s * DM + k] : args.in[I_CS][(s - 4) * DM + k]; sc[e] = c * fast_sigmoid(c); }
            __syncthreads();
            f32x4 acc[NSLOT];
#pragma unroll
            for (int s = 0; s < NSLOT; ++s) acc[s] = (f32x4){0.f, 0.f, 0.f, 0.f};
            const int lc = lane < 48 ? lane : 47;
            const float* Wp = args.in[I_WMOD] + (size_t)l * DM * 12288 + (size_t)(wave * 256) * 12288 + cb * 192 + 4 * lc;
            for (int k0 = 0; k0 < 256; k0 += 8) {
                f32x4 w[8];
#pragma unroll
                for (int kk = 0; kk < 8; ++kk) w[kk] = *(const f32x4*)(Wp + (size_t)(k0 + kk) * 12288);
#pragma unroll
                for (int s = 0; s < NSLOT; ++s) { const f32x4 c0 = *(const LAS f32x4*)(sc + s * DM + wave * 256 + k0), c1 = *(const LAS f32x4*)(sc + s * DM + wave * 256 + k0 + 4);
#pragma unroll
                    for (int kk = 0; kk < 4; ++kk) { acc[s] += c0[kk] * w[kk]; acc[s] += c1[kk] * w[4 + kk]; } }
            }
            __syncthreads();
            LAS float* red = (LAS float*)lds;
            if (lane < 48) {
#pragma unroll
                for (int s = 0; s < NSLOT; ++s) *(LAS f32x4*)(red + (wave * NSLOT + s) * 192 + 4 * lane) = acc[s]; }
            __syncthreads();
            for (int e = tid; e < NSLOT * 192; e += NWAVES * 64) { const int s = e / 192, c = e - s * 192; float v = args.in[I_BMOD][l * 12288 + cb * 192 + c];
#pragma unroll
                for (int w8 = 0; w8 < 8; ++w8) v += red[(w8 * NSLOT + s) * 192 + c];
                MOD[(size_t)(l * NSLOT + s) * 12288 + cb * 192 + c] = v; }
            __syncthreads();
        }
        for (int e = gw * 64 + lane; e < SEQ * 32; e += NGW * 64) { float s, c; sincos_red((double)(e >> 5) * ROPE_INV[e & 31], s, c); *(f32x2*)(ROPE + 2 * (size_t)e) = (f32x2){c, s}; }
        for (int it = vcu; it < 2 * NGRP; it += G) {
            const int i = it >> 7, g = it & 127;
            LAS float* pwr = (LAS float*)lds;
            LAS float* pwi = pwr + 17 * 64;
            LAS float* bbr = pwi + 17 * 64;
            LAS float* bbi = bbr + 1024;
            LAS float* ccr = bbi + 1024;
            LAS float* cci = ccr + 1024;
            LAS float* kd = cci + 1024;
            const float dt = expf(args.in[I_LDT][i * NGRP + g]);
            if (tid < 64) {
                const int n = tid; const float are = args.in[I_ARE][(i * NGRP + g) * 64 + n], aim = args.in[I_AIM][(i * NGRP + g) * 64 + n];
                const double xr = (double)are * (double)dt, xi = (double)aim * (double)dt;
                for (int d = 0; d <= 16; ++d) { float s, c; sincos_red(xi * d, s, c); const float e = expf((float)(xr * d)); pwr[d * 64 + n] = e * c; pwi[d * 64 + n] = e * s; }
                A16[((i * NGRP + g) * 64 + n) * 2] = pwr[16 * 64 + n]; A16[((i * NGRP + g) * 64 + n) * 2 + 1] = pwi[16 * 64 + n];
                const float nr = pwr[64 + n] - 1.0f, ni = pwi[64 + n]; const float den = 1.0f / (are * are + aim * aim);
                const float fr_ = (nr * are + ni * aim) * den, fi_ = (ni * are - nr * aim) * den;
                for (int p = 0; p < 16; ++p) { const float br = args.in[I_BRE][((size_t)(i * NGRP + g) * 64 + n) * 16 + p], bi = args.in[I_BIM][((size_t)(i * NGRP + g) * 64 + n) * 16 + p];
                    bbr[n * 16 + p] = fr_ * br - fi_ * bi; bbi[n * 16 + p] = fr_ * bi + fi_ * br; }
            } else {
                for (int e = tid - 64; e < 1024; e += NWAVES * 64 - 64) { ccr[e] = args.in[I_CRE][(size_t)(i * NGRP + g) * 1024 + e]; cci[e] = args.in[I_CIM][(size_t)(i * NGRP + g) * 1024 + e]; }
            }
            __syncthreads();
            for (int e = tid; e < 4096; e += NWAVES * 64) { const int d = e >> 8, q = (e >> 4) & 15, p = e & 15; float s = 0.f;
                for (int n = 0; n < 64; ++n) { const float mr = pwr[d * 64 + n] * bbr[n * 16 + p] - pwi[d * 64 + n] * bbi[n * 16 + p], mi = pwr[d * 64 + n] * bbi[n * 16 + p] + pwi[d * 64 + n] * bbr[n * 16 + p];
                    s += ccr[q * 64 + n] * mr - cci[q * 64 + n] * mi; }
                kd[e] = s; }
            __syncthreads();
            bf16_t* BtY = (bf16_t*)(ws + WS_S5 + i * WSZ_S5 + WSZ_GG) + (size_t)g * 256 * 384;
            bf16_t* BtX = (bf16_t*)(ws + WS_S5 + i * WSZ_S5 + WSZ_GG + WSZ_BTY) + (size_t)g * 256 * 256;
            for (int e = tid; e < 256 * 192; e += NWAVES * 64) { const int rr = e / 192, k2 = (e - rr * 192) * 2; const int t = rr >> 4, q = rr & 15; float v[2];
#pragma unroll
                for (int z = 0; z < 2; ++z) { const int k = k2 + z;
                    if (k < 256) { const int s = k >> 4, p = k & 15; v[z] = (s <= t) ? kd[((t - s) * 16 + q) * 16 + p] : 0.f; }
                    else if (k < 320) { const int n = k - 256; v[z] = ccr[q * 64 + n] * pwr[(t + 1) * 64 + n] - cci[q * 64 + n] * pwi[(t + 1) * 64 + n]; }
                    else { const int n = k - 320; v[z] = -(ccr[q * 64 + n] * pwi[(t + 1) * 64 + n] + cci[q * 64 + n] * pwr[(t + 1) * 64 + n]); } }
                *(unsigned*)(BtY + (size_t)rr * 384 + k2) = cvt_pk_bf16(v[0], v[1]); }
            for (int e = tid; e < 256 * 128; e += NWAVES * 64) { const int rr = e >> 7, k2 = (e & 127) * 2; float v[2];
#pragma unroll
                for (int z = 0; z < 2; ++z) { const int k = k2 + z, s = k >> 4, p = k & 15;
                    if (rr < 64) { const int n = rr; v[z] = pwr[(15 - s) * 64 + n] * bbr[n * 16 + p] - pwi[(15 - s) * 64 + n] * bbi[n * 16 + p]; }
                    else if (rr < 128) { const int n = rr - 64; v[z] = pwr[(15 - s) * 64 + n] * bbi[n * 16 + p] + pwi[(15 - s) * 64 + n] * bbr[n * 16 + p]; }
                    else v[z] = 0.f; }
                *(unsigned*)(BtX + (size_t)rr * 256 + k2) = cvt_pk_bf16(v[0], v[1]); }
            __syncthreads();
        }
        {
            LAS float* scr = (LAS float*)(lds + wave * 16384);
            constexpr int I_DQ_ = 32 * 16, I_DKV_ = 32 * 10, I_UQ_ = 8 * 96, I_UKV_ = 4 * 128, I_O_ = 32 * 64, I_MLA_ = I_DQ_ + I_DKV_ + I_UQ_ + I_UKV_ + I_O_;
            constexpr int I_GL_ = 32 * 64, I_S5_ = 2 * I_GL_;
            constexpr int I_FG_ = 32 * 176, I_FD_ = 88 * 64, I_FFN_ = 2 * I_FG_ + I_FD_;
            constexpr int NIT = 2 * I_MLA_ + 2 * I_S5_ + 4 * I_FFN_;
            for (int it = gw; it < NIT; it += NGW) {
                int r = it;
                if (r < 2 * I_MLA_) { const int i = r / I_MLA_; r -= i * I_MLA_; unsigned char* wb = ws + WS_MLA + i * WSZ_MLA;
                    if (r < I_DQ_) { transpose_item(args.in[I_WDQ] + (size_t)i * DM * QLORA, DM, QLORA, (bf16_t*)wb, 0, 0, scr, r, lane); continue; } r -= I_DQ_;
                    if (r < I_DKV_) { transpose_item(args.in[I_WDKV] + (size_t)i * DM * 320, DM, 320, (bf16_t*)wb, 512, 0, scr, r, lane); continue; } r -= I_DKV_;
                    if (r < I_UQ_) { transpose_item(args.in[I_WUQ] + (size_t)i * QLORA * 3072, QLORA, 3072, (bf16_t*)(wb + WSZ_DQKV), 0, 0, scr, r, lane, 1.0f, args.in[I_GQA] + i * QLORA); continue; }     r -= I_UQ_;
                    if (r < I_UKV_) { transpose_item(args.in[I_WUKV] + (size_t)i * KVLORA * 4096, KVLORA, 4096, (bf16_t*)(wb + WSZ_DQKV + WSZ_UQ), 0, 0, scr, r, lane); continue; } r -= I_UKV_;
                    transpose_item(args.in[I_WO] + (size_t)i * DM * DM, DM, DM, (bf16_t*)(wb + WSZ_DQKV + WSZ_UQ + WSZ_UKV), 0, 0, scr, r, lane); continue; }
                r -= 2 * I_MLA_;
                if (r < 2 * I_S5_) { const int i = r / I_S5_; r -= i * I_S5_; bf16_t* wb = (bf16_t*)(ws + WS_S5 + i * WSZ_S5);
                    if (r < I_GL_) { transpose_item(args.in[I_WGLU] + (size_t)i * DM * DM, DM, DM, wb, 0, 1, scr, r, lane); continue; } r -= I_GL_;
                    transpose_item(args.in[I_WSG] + (size_t)i * DM * DM, DM, DM, wb, 0, 2, scr, r, lane); continue; }
                r -= 2 * I_S5_;
                { const int l = r / I_FFN_; r -= l * I_FFN_; unsigned char* wb = ws + WS_FFN + l * WSZ_FFN;
                    if (r < I_FG_) { transpose_item(args.in[I_FG] + (size_t)l * DM * DFF, DM, DFF, (bf16_t*)wb, 0, 1, scr, r, lane); continue; } r -= I_FG_;
                    if (r < I_FG_) { transpose_item(args.in[I_FU] + (size_t)l * DM * DFF, DM, DFF, (bf16_t*)wb, 0, 2, scr, r, lane); continue; } r -= I_FG_;
                    transpose_item(args.in[I_FD] + (size_t)l * DFF * DM, DFF, DM, (bf16_t*)(wb + 2 * WSZ_FF1), 0, 3, scr, r, lane, -0.6931471805599453f); }
            }
            for (int i = 0; i < 2; ++i) { u32x4* z = (u32x4*)(ws + WS_MLA + i * WSZ_MLA + (size_t)832 * DM * 2);
                for (int e = gw * 64 + lane; e < 192 * DM * 2 / 16; e += NGW * 64) z[e] = (u32x4){0u, 0u, 0u, 0u}; }
        }
    }
#endif
    PH_END

    for (int l = 0; l < 4; ++l) {
        const int li = l >> 1;
#define modl (MOD + (size_t)l * NSLOT * 12288)

#define NCOL(jj) (8 * lane + 512 * ((jj) >> 1) + 4 * ((jj) & 1))
#define NORM_STORE(V, ROW, RR16) do { \
                _Pragma("unroll") for (int j = 0; j < 4; ++j) { const f32x4 h0 = V[2 * j] * rstd * mul[2 * j] + add[2 * j], h1 = V[2 * j + 1] * rstd * mul[2 * j + 1] + add[2 * j + 1]; const u32x4 w = pg8::pack8(h0, h1); \
                    if (MODE_ == 0) *(u32x4*)(Hb + (size_t)(ROW) * DM + 8 * lane + 512 * j) = w; \
                    else { const int c = ((ROW) >> 4); *(u32x4*)(UP + ((size_t)((lane >> 1) + 32 * j) * NSUB + c) * 384 + (RR16) * 16 + 8 * (lane & 1)) = w; } } } while (0)
#define NORM_STAGE(V, RR16) do { \
                _Pragma("unroll") for (int j = 0; j < 4; ++j) { const f32x4 h0 = V[2 * j] * rstd * mul[2 * j] + add[2 * j], h1 = V[2 * j + 1] * rstd * mul[2 * j + 1] + add[2 * j + 1]; \
                    *(LAS u32x4*)(lds + wave * 16384 + ((RR16) & 3) * 4096 + 16 * lane + 1024 * j) = pg8::pack8(h0, h1); } } while (0)
#define NORM_FLUSH(RR4) do { asm volatile("s_waitcnt lgkmcnt(0)" ::: "memory"); const int t_ = lane >> 4, gl_ = (lane >> 1) & 7, h_ = lane & 1; \
                _Pragma("unroll") for (int i_ = 0; i_ < 16; ++i_) { const int g_ = 8 * i_ + gl_; const u32x4 w_ = *(const LAS u32x4*)(lds + wave * 16384 + t_ * 4096 + g_ * 32 + h_ * 16); \
                    *(u32x4*)(UP + ((size_t)g_ * NSUB + gw) * 384 + ((RR4) + t_) * 16 + 8 * h_) = w_; } \
                asm volatile("s_waitcnt lgkmcnt(0)" ::: "memory"); } while (0)
#define NORM_LOADP(MULADD_SLOT, GAIN, SHOFF, SCOFF) \
            f32x4 mul[8], add[8]; \
            _Pragma("unroll") for (int jj = 0; jj < 8; ++jj) { const int col = NCOL(jj); const f32x4 gg = *(const f32x4*)((GAIN) + col); const f32x4 scv = *(const f32x4*)(modl + (MULADD_SLOT) * 12288 + (SCOFF) + col); \
                add[jj] = *(const f32x4*)(modl + (MULADD_SLOT) * 12288 + (SHOFF) + col); mul[jj] = gg * (scv + 1.0f); }
#define LD8_BF16(V0, V1, P) do { const u32x4 w_ = *(const u32x4*)(P); V0 = (f32x4){bf_lo(w_[0]), bf_hi(w_[0]), bf_lo(w_[1]), bf_hi(w_[1])}; V1 = (f32x4){bf_lo(w_[2]), bf_hi(w_[2]), bf_lo(w_[3]), bf_hi(w_[3])}; } while (0)
#define NORM_ROWS(P32, S32, GAIN, SHOFF, SCOFF, MODE, NPART, PGATE, PMODE) do { constexpr int MODE_ = MODE; \
        { const int row0 = gw * 16; const int slot = slot_of_row(row0); \
            NORM_LOADP(slot, GAIN, SHOFF, SCOFF) \
            for (int rr = 0; rr < 16; rr += 2) { \
                f32x4 va[8], vb[8]; float sa = 0.f, sb = 0.f; \
                if (P32) { const float* xs = args.in[I_XP] + (size_t)(row0 + rr) * DM; \
                    _Pragma("unroll") for (int jj = 0; jj < 8; ++jj) { va[jj] = *(const f32x4*)(xs + NCOL(jj)); vb[jj] = *(const f32x4*)(xs + DM + NCOL(jj)); } } \
                else { const bf16_t* xh = XBs + (size_t)(row0 + rr) * DM + 8 * lane; \
                    _Pragma("unroll") for (int j = 0; j < 4; ++j) { LD8_BF16(va[2 * j], va[2 * j + 1], xh + 512 * j); LD8_BF16(vb[2 * j], vb[2 * j + 1], xh + DM + 512 * j); } } \
                _Pragma("unroll") for (int jj = 0; jj < 8; ++jj) { sa += (va[jj].x * va[jj].x + va[jj].y * va[jj].y) + (va[jj].z * va[jj].z + va[jj].w * va[jj].w); sb += (vb[jj].x * vb[jj].x + vb[jj].y * vb[jj].y) + (vb[jj].z * vb[jj].z + vb[jj].w * vb[jj].w); } \
                _Pragma("unroll") for (int o_ = 1; o_ < 64; o_ <<= 1) { sa += shx(sa, o_, lane); sb += shx(sb, o_, lane); } \
                { const float rstd = 1.0f / sqrtf(sa * (1.0f / DM) + EPS); if (MODE_ == 1) NORM_STAGE(va, rr); else NORM_STORE(va, row0 + rr, rr); } \
                { const float rstd = 1.0f / sqrtf(sb * (1.0f / DM) + EPS); if (MODE_ == 1) NORM_STAGE(vb, rr + 1); else NORM_STORE(vb, row0 + rr + 1, rr + 1); } \
                if (MODE_ == 1 && (rr & 2)) NORM_FLUSH(rr & ~3); } } \
        if (gw < 512) { const int row = NPROMPT + gw; const int slot = 4 + (gw >> 6); const int np_ = (NPART); \
            f32x4 v[8]; float ss = 0.f; \
            if (S32) { _Pragma("unroll") for (int jj = 0; jj < 8; ++jj) v[jj] = *(const f32x4*)(args.in[I_XS] + (size_t)gw * DM + NCOL(jj)); } \
            else { const bf16_t* xh = XBs + (size_t)row * DM + 8 * lane; _Pragma("unroll") for (int j = 0; j < 4; ++j) LD8_BF16(v[2 * j], v[2 * j + 1], xh + 512 * j); } \
            if (np_ > 0) { const int pm_ = (PMODE); \
                _Pragma("unroll") for (int jj = 0; jj < 8; ++jj) { f32x4 sp = (f32x4){0.f, 0.f, 0.f, 0.f}; const int col = NCOL(jj); \
                    if (pm_ == 0) { for (int ks = 0; ks < np_; ++ks) sp += *(const f32x4*)(PART + ((size_t)ks * 512 + gw) * DM + col); } \
                    else { f32x4 sg = (f32x4){0.f, 0.f, 0.f, 0.f}; \
                        for (int ks = 0; ks < np_; ++ks) { const float* pp = PART + ((size_t)ks * 512 + gw) * 4096 + (col >> 7) * 256 + (col & 127); sp += *(const f32x4*)pp; sg += *(const f32x4*)(pp + 128); } \
                        _Pragma("unroll") for (int e = 0; e < 4; ++e) sp[e] *= fast_sigmoid(sg[e]); } \
                    v[jj] += *(const f32x4*)((PGATE) + (size_t)slot * 12288 + col) * sp; } \
                _Pragma("unroll") for (int j = 0; j < 4; ++j) { *(u32x4*)(XBs + (size_t)row * DM + 8 * lane + 512 * j) = pg8::pack8(v[2 * j], v[2 * j + 1]); \
                    LD8_BF16(v[2 * j], v[2 * j + 1], XBs + (size_t)row * DM + 8 * lane + 512 * j); } }     \
            _Pragma("unroll") for (int jj = 0; jj < 8; ++jj) ss += (v[jj].x * v[jj].x + v[jj].y * v[jj].y) + (v[jj].z * v[jj].z + v[jj].w * v[jj].w); \
            const float rstd = 1.0f / sqrtf(wave_sum(ss, lane) * (1.0f / DM) + EPS); \
            NORM_LOADP(slot, GAIN, SHOFF, SCOFF) \
            NORM_STORE(v, row, row & 15); } } while (0)
#define PREV_GATE_F (MOD + (size_t)(l - 1) * NSLOT * 12288 + 10240)

        if ((l & 1) == 0) {
#define wb (ws + WS_MLA + li * WSZ_MLA)
            PH_BEGIN
#ifndef NO_A0
            NORM_ROWS(l == 0, l == 0, args.in[I_GMIX] + l * DM, 0, 2048, 0, (l > 0 ? 11 : 0), PREV_GATE_F, 0);
#endif
            PH_END
            PH_BEGIN
#ifndef NO_A1
            { pg8::Gemm g = pg8::gemm_rm(Hb, (const bf16_t*)wb, DM, DM, DM); pg8::StaticOrder S; S.init(128, 3, G, bx); S.pnskip = 2; pg8::EpiA1 E{QKVA, QA, STATQ};
              pg8::gemm_phase<pg8::EpiA1, pg8::StaticOrder, true>(lds, g, S, E, tid); }
            { pg8::Gemm g = pg8::gemm_rm(Hb, (const bf16_t*)wb, DM, DM, DM); pg8::StaticOrder S; S.init(128, 1, G, (G > 128) ? (bx + 128) % G : bx); S.pnoff = 2;
              pg8::EpiCkv E{CKV, out + O_CKVP + (size_t)li * NPROMPT * KVLORA, args.in[I_GKVA] + li * KVLORA, (LAS float*)(lds + MISC_OFF + 1024)};
              pg8::gemm_phase<pg8::EpiCkv, pg8::StaticOrder, true>(lds, g, S, E, tid); }
            { pg8::Gemm g = pg8::gemm_rm(Hb, (const bf16_t*)wb, DM, DM, 512); pg8::SplitOrder S{bx, 4, 4, (size_t)1024}; pg8::EpiPartial E{PART, 1024};
              pg8::gemm_phase<pg8::EpiPartial, pg8::SplitOrder, true>(lds, g, S, E, tid); }
#endif
            PH_END
            PH_BEGIN
#ifndef NO_A2
            {
                const float* gqa = args.in[I_GQA] + li * QLORA; const float* gkva = args.in[I_GKVA] + li * KVLORA; const float* gkn = args.in[I_GKN] + li * DQK;
                for (int it = gw; it < NTOK + 8 * PAST; it += NGW) {
                    int kvrow, pos; f32x4 kr = (f32x4){0.f, 0.f, 0.f, 0.f};
                    if (it < NTOK) {
                        const int row = it;
                        f32x4 v[4];
                        const bool pr = row < NPROMPT;
                        if (pr) { const float* src = QKVA + (size_t)row * 1024;
                            v[0] = v[1] = (f32x4){0.f, 0.f, 0.f, 0.f};
                            v[2] = v[0]; v[3] = *(const f32x4*)(src + 4 * lane + 768); }
                        else { const float* src = PART + (size_t)(row - NPROMPT) * 1024;
#pragma unroll
                            for (int j = 0; j < 4; ++j) v[j] = (*(const f32x4*)(src + 4 * lane + 256 * j) + *(const f32x4*)(src + 512 * 1024 + 4 * lane + 256 * j)) + (*(const f32x4*)(src + 2 * 512 * 1024 + 4 * lane + 256 * j) + *(const f32x4*)(src + 3 * 512 * 1024 + 4 * lane + 256 * j)); }
                        float sq = 0.f, sk = 0.f;
#pragma unroll
                        for (int j = 0; j < 2; ++j) sq += (v[j].x * v[j].x + v[j].y * v[j].y) + (v[j].z * v[j].z + v[j].w * v[j].w);
                        if (pr) sq = lane < 8 ? STATQ[(size_t)row * 8 + lane] : 0.f;
                        sk = (v[2].x * v[2].x + v[2].y * v[2].y) + (v[2].z * v[2].z + v[2].w * v[2].w);
                        const float rq = 1.0f / sqrtf(wave_sum(sq, lane) * (1.0f / QLORA) + EPS), rk = 1.0f / sqrtf(wave_sum(sk, lane) * (1.0f / KVLORA) + EPS);
                        if (!pr) {
#pragma unroll
                            for (int j = 0; j < 2; ++j) { const f32x4 h = v[j] * rq; u32x2 w; w.x = cvt_pk_bf16(h.x, h.y); w.y = cvt_pk_bf16(h.z, h.w);
                                *(u32x2*)(QA + (size_t)row * QLORA + 4 * lane + 256 * j) = w; } }
                        if (lane == 0) RSTDQ[row] = pr ? rq : 1.0f;
                        const f32x4 gk = *(const f32x4*)(gkva + 4 * lane); const f32x4 ck = v[2] * rk * gk;
                        int t;
                        if (row < NPROMPT) { kvrow = row; t = row & (SEQ - 1); pos = t; const int b = row >> 13;
                            if (lane < 16) *(f32x4*)(out + O_KRP + ((size_t)(li * 4 + b) * SEQ + t) * 64 + 4 * lane) = v[3]; }
                        else { const int r2 = row - NPROMPT, b = r2 >> 6; t = r2 & 63; kvrow = NPROMPT + b * SKV + PAST + t; pos = PAST + t;
                            *(f32x4*)(out + O_CKVS + ((size_t)(li * 8 + b) * DSEQ + t) * KVLORA + 4 * lane) = ck;
                            if (lane < 16) *(f32x4*)(out + O_KRS + ((size_t)(li * 8 + b) * DSEQ + t) * 64 + 4 * lane) = v[3]; }
                        if (!pr) { u32x2 w; w.x = cvt_pk_bf16(ck.x, ck.y); w.y = cvt_pk_bf16(ck.z, ck.w); *(u32x2*)(CKV + (size_t)kvrow * KVLORA + 4 * lane) = w; }
                        kr = v[3];
                    } else {
                        const int c2 = it - NTOK, b = c2 >> 12, p = c2 & (PAST - 1); kvrow = NPROMPT + b * SKV + p; pos = p;
                        const f32x4 ck = *(const f32x4*)(args.in[I_CCKV] + ((size_t)(li * 8 + b) * PAST + p) * KVLORA + 4 * lane);
                        u32x2 w; w.x = cvt_pk_bf16(ck.x, ck.y); w.y = cvt_pk_bf16(ck.z, ck.w); *(u32x2*)(CKV + (size_t)kvrow * KVLORA + 4 * lane) = w;
                        if (lane < 16) kr = *(const f32x4*)(args.in[I_CKR] + ((size_t)(li * 8 + b) * PAST + p) * 64 + 4 * lane);
                    }
                    float ssk = (lane < 16) ? (kr.x * kr.x + kr.y * kr.y) + (kr.z * kr.z + kr.w * kr.w) : 0.f;
                    ssk = sum16(ssk, lane);
                    const f32x4 gr = (lane < 16) ? *(const f32x4*)(gkn + 128 + 4 * lane) : (f32x4){0.f, 0.f, 0.f, 0.f};
                    const f32x4 kg = kr * gr;
                    f32x4 other; other.x = shx(kg.x, 8, lane); other.y = shx(kg.y, 8, lane); other.z = shx(kg.z, 8, lane); other.w = shx(kg.w, 8, lane);
                    if (lane < 16) {
                        const int jb = 4 * (lane & 7); f32x4 o;
#pragma unroll
                        for (int e = 0; e < 4; ++e) { const f32x2 cs = *(const f32x2*)(ROPE + ((size_t)pos * 32 + jb + e) * 2); const float c = cs.x, s = cs.y;
                            o[e] = (lane < 8) ? kg[e] * c - other[e] * s : other[e] * s + kg[e] * c; }
                        *(f32x4*)(Rr + (size_t)kvrow * 64 + 4 * lane) = o;
                        if (lane == 0) KRSS[kvrow] = ssk;
                    }
                }
            }
#endif
            PH_END
            PH_BEGIN
#ifndef NO_A3
            { pg8::Gemm g = pg8::gemm_rm(QA, (const bf16_t*)(wb + WSZ_DQKV), QLORA, QLORA, QLORA); pg8::StaticOrder S; S.init(NTOK / 256, 12, G, bx); pg8::EpiBf16 E{Qb, 3072, RSTDQ};
              pg8::gemm_phase<pg8::EpiBf16, pg8::StaticOrder, true>(lds, g, S, E, tid); }
            { pg8::Gemm g = pg8::gemm_rm(CKV, (const bf16_t*)(wb + WSZ_DQKV + WSZ_UQ), KVLORA, KVLORA, KVLORA); pg8::StaticOrder S; S.init(NKV / 256, 16, G, (G % 8 == 0 && G > 64) ? (bx + 32) % G : bx);     pg8::EpiKV E{KB, KRSS, Rr, args.in[I_GKN] + li * DQK, (LAS float*)(lds + MISC_OFF + 1024)};
              pg8::gemm_phase<pg8::EpiKV, pg8::StaticOrder, true>(lds, g, S, E, tid); }
#endif
            PH_END
            PH_BEGIN
#ifndef NO_A5
            {
                bool fx_ok;
                { float gq = 0.f, gk = 0.f;
                  for (int e = lane; e < DQK; e += 64) { gq = fmaxf(gq, fabsf(args.in[I_GQN][li * DQK + e])); gk = fmaxf(gk, fabsf(args.in[I_GKN][li * DQK + e])); }
#pragma unroll
                  for (int o_ = 1; o_ < 64; o_ <<= 1) { gq = fmaxf(gq, shx(gq, o_, lane)); gk = fmaxf(gk, shx(gk, o_, lane)); }
                  fx_ok = __builtin_amdgcn_readfirstlane(__float_as_int(gq * gk * (1.4427f * 13.8564f * 1.03f))) < __float_as_int(60.0f); }
                const int nun = ((vcu & 1) == 0) ? 9 : 8;
                for (int un = 0; un < nun; ++un) {
                    const bf16_t* q_; const bf16_t* k_; const bf16_t* v_; bf16_t* o_; int NT_, NTr_, nv_, wq_, pos0_, rev_;
                    if (un < 8) { const int x = vcu >> 5, i = vcu & 31; const int bh = x * 8 + (un >> 1) * 2 + (un & 1), b = bh >> 4, h = bh & 15; const int qb = (un & 1) == 0 ? i : ((un >> 1) < 2 ? 31 - (i ^ 1) : 31 - i);     const size_t qrow = (size_t)b * SEQ + 256 * qb;
                        q_ = Qb + qrow * 3072 + h * DQK; k_ = KB + (size_t)b * SEQ * 5120 + h * 320; v_ = k_ + 192; o_ = Hb + qrow * DM + h * 128;
                        NT_ = 4 * (qb + 1); NTr_ = NT_; nv_ = 4 * qb + (wave >> 1) + 1; wq_ = wave; pos0_ = 256 * qb; rev_ = un & 1; }
                    else { const int su = vcu >> 1, b = su >> 4, h = su & 15; const size_t qrow = NPROMPT + (size_t)b * DSEQ, kvr = NPROMPT + (size_t)b * SKV;
                        q_ = Qb + qrow * 3072 + h * DQK; k_ = KB + kvr * 5120 + h * 320; v_ = k_ + 192; o_ = Hb + qrow * DM + h * 128;
                        NT_ = 66; NTr_ = 65; nv_ = wave < 2 ? 65 : 0; wq_ = wave & 1; pos0_ = PAST; rev_ = 0; }
                    if (fx_ok) att::attn_unit<true>(q_, k_, v_, o_, NT_, NTr_, nv_, wq_, rev_, (LAS char*)lds, tid, args.in[I_GQN] + li * DQK, ROPE, pos0_);
                    else att::attn_unit<false>(q_, k_, v_, o_, NT_, NTr_, nv_, wq_, rev_, (LAS char*)lds, tid, args.in[I_GQN] + li * DQK, ROPE, pos0_);
                }
            }
#endif
            PH_END
            PH_BEGIN
#ifndef NO_A6
            { pg8::Gemm g = pg8::gemm_rm(Hb, (const bf16_t*)(wb + WSZ_DQKV + WSZ_UQ + WSZ_UKV), DM, DM, DM); pg8::StaticOrder S; S.init(128, 8, G, bx); pg8::EpiResid E{args.in[I_XP], out, XBs, modl + 4096, (l == 0) ? 1 : 0, 0};
              pg8::gemm_phase<pg8::EpiResid, pg8::StaticOrder, true>(lds, g, S, E, tid); }
            { pg8::Gemm g = pg8::gemm_rm(Hb, (const bf16_t*)(wb + WSZ_DQKV + WSZ_UQ + WSZ_UKV), DM, DM, 512); pg8::SplitOrder S{bx, 8, 4, (size_t)1024}; pg8::EpiPartial E{PART, DM};
              pg8::gemm_phase<pg8::EpiPartial, pg8::SplitOrder, true>(lds, g, S, E, tid); }
#endif
            PH_END
        } else {
#undef wb
#define wb (ws + WS_S5 + li * WSZ_S5)
            PH_BEGIN
#ifndef NO_S0
            NORM_ROWS(false, false, args.in[I_GMIX] + l * DM, 0, 2048, 1, 11, PREV_GATE_F, 0);
#endif
            PH_END
            PH_BEGIN
#ifndef NO_S1
            { pg8::Gemm g = pg8::gemm_rm(UP, (const bf16_t*)(wb + WSZ_GG + WSZ_BTY), 384, 256, 256); pg8::GroupOrder S{G, bx}; pg8::EpiXloc E{XLOC};
              pg8::gemm_phase<pg8::EpiXloc, pg8::GroupOrder, true>(lds, g, S, E, tid); }
#endif
            PH_END
            PH_BEGIN
#ifndef NO_S2
            {
                if (G == 256) {
                    { const int L = vcu * 2 + (wave >> 2), sg = wave & 3, slot = L >> 7, g = L & 127, n = lane;
                      const float ar = A16[((li * NGRP + g) * 64 + n) * 2], ai = A16[((li * NGRP + g) * 64 + n) * 2 + 1];
                      const int c0 = slot * 512 + sg * 128;
                      const bf16_t* xl = XLOC + ((size_t)g * NSUB + c0) * 128; bf16_t* up = UP + ((size_t)g * NSUB + c0) * 384 + 256;
                      float xr = 0.f, xi = 0.f;
#define S2_LD(DR, DI, C0) do { _Pragma("unroll") for (int q = 0; q < 16; ++q) { DR[q] = bf_lo((unsigned)xl[(size_t)((C0) + q) * 128 + n]); DI[q] = bf_lo((unsigned)xl[(size_t)((C0) + q) * 128 + 64 + n]); } } while (0)
#define S2_ADV(LR, LI) do { const float nr = ar * xr - ai * xi + (LR), ni = ar * xi + ai * xr + (LI); xr = nr; xi = ni; } while (0)
                      { float lr[16], lim[16]; S2_LD(lr, lim, 0);
                        for (int c = 0; c < 128; c += 16) { float nr_[16], ni_[16]; const int cn = c + 16 < 128 ? c + 16 : c; S2_LD(nr_, ni_, cn);
#pragma unroll
                            for (int q = 0; q < 16; ++q) S2_ADV(lr[q], lim[q]);
#pragma unroll
                            for (int q = 0; q < 16; ++q) { lr[q] = nr_[q]; lim[q] = ni_[q]; } } }
                      LAS float* ex = (LAS float*)lds + (wave >> 2) * 512;
                      ex[sg * 128 + n] = xr; ex[sg * 128 + 64 + n] = xi;
                      __syncthreads();
                      float pr_ = ar, pi_ = ai;
#pragma unroll
                      for (int z = 0; z < 7; ++z) { const float r2 = pr_ * pr_ - pi_ * pi_, i2 = 2.0f * pr_ * pi_; pr_ = r2; pi_ = i2; }
                      xr = 0.f; xi = 0.f;
                      for (int s2 = 0; s2 < sg; ++s2) { const float er = ex[s2 * 128 + n], ei = ex[s2 * 128 + 64 + n]; const float nr = pr_ * xr - pi_ * xi + er, ni = pr_ * xi + pi_ * xr + ei; xr = nr; xi = ni; }
                      { float lr[16], lim[16]; S2_LD(lr, lim, 0);
                        for (int c = 0; c < 128; c += 16) { float nr_[16], ni_[16]; const int cn = c + 16 < 128 ? c + 16 : c; S2_LD(nr_, ni_, cn);
#pragma unroll
                            for (int q = 0; q < 16; ++q) { const unsigned pk = cvt_pk_bf16(xr, xi); up[(size_t)(c + q) * 384 + n] = (bf16_t)(pk & 0xffffu); up[(size_t)(c + q) * 384 + 64 + n] = (bf16_t)(pk >> 16); S2_ADV(lr[q], lim[q]); }
#pragma unroll
                            for (int q = 0; q < 16; ++q) { lr[q] = nr_[q]; lim[q] = ni_[q]; } } }
                      if (sg == 3) { out[O_REP + ((size_t)(li * 4 + slot) * NGRP + g) * 64 + n] = xr; out[O_IMP + ((size_t)(li * 4 + slot) * NGRP + g) * 64 + n] = xi; }
                    }
                    if (wave < 4) { const int it = 4 * NGRP + vcu * 4 + wave; const int slot = it >> 7, g = it & 127, n = lane, b = slot - 4;
                      const float ar = A16[((li * NGRP + g) * 64 + n) * 2], ai = A16[((li * NGRP + g) * 64 + n) * 2 + 1];
                      float xr = args.in[I_SRE][((size_t)(li * 8 + b) * NGRP + g) * 64 + n], xi = args.in[I_SIM][((size_t)(li * 8 + b) * NGRP + g) * 64 + n];
                      const int c0 = 2048 + 4 * b;
                      const bf16_t* xl = XLOC + ((size_t)g * NSUB + c0) * 128; bf16_t* up = UP + ((size_t)g * NSUB + c0) * 384 + 256;
                      float lr[4], lim[4];
#pragma unroll
                      for (int q = 0; q < 4; ++q) { lr[q] = bf_lo((unsigned)xl[(size_t)q * 128 + n]); lim[q] = bf_lo((unsigned)xl[(size_t)q * 128 + 64 + n]); }
#pragma unroll
                      for (int q = 0; q < 4; ++q) { const unsigned pk = cvt_pk_bf16(xr, xi); up[(size_t)q * 384 + n] = (bf16_t)(pk & 0xffffu); up[(size_t)q * 384 + 64 + n] = (bf16_t)(pk >> 16); S2_ADV(lr[q], lim[q]); }
                      out[O_RES + ((size_t)(li * 8 + b) * NGRP + g) * 64 + n] = xr; out[O_IMS + ((size_t)(li * 8 + b) * NGRP + g) * 64 + n] = xi; }
#undef S2_LD
#undef S2_ADV
                } else
                for (int it = gw; it < NSLOT * NGRP; it += NGW) {
                    const int slot = it >> 7, g = it & 127, n = lane;
                    const float ar = A16[((li * NGRP + g) * 64 + n) * 2], ai = A16[((li * NGRP + g) * 64 + n) * 2 + 1];
                    float xr = 0.f, xi = 0.f; int c0, nc;
                    if (slot < 4) { c0 = slot * 512; nc = 512; }
                    else { const int b = slot - 4; c0 = 2048 + 4 * b; nc = 4; xr = args.in[I_SRE][((size_t)(li * 8 + b) * NGRP + g) * 64 + n]; xi = args.in[I_SIM][((size_t)(li * 8 + b) * NGRP + g) * 64 + n]; }
                    const bf16_t* xl = XLOC + ((size_t)g * NSUB + c0) * 128; bf16_t* up = UP + ((size_t)g * NSUB + c0) * 384 + 256;
#define S2_STEP(LR, LI, Q) do { const unsigned pk = cvt_pk_bf16(xr, xi); up[(size_t)(c + (Q)) * 384 + n] = (bf16_t)(pk & 0xffffu); up[(size_t)(c + (Q)) * 384 + 64 + n] = (bf16_t)(pk >> 16); \
                            const float nr = ar * xr - ai * xi + (LR), ni = ar * xi + ai * xr + (LI); xr = nr; xi = ni; } while (0)
                    if (nc == 4) { const int c = 0; float lr[4], lim[4];
#pragma unroll
                        for (int q = 0; q < 4; ++q) { lr[q] = bf_lo((unsigned)xl[(size_t)q * 128 + n]); lim[q] = bf_lo((unsigned)xl[(size_t)q * 128 + 64 + n]); }
#pragma unroll
                        for (int q = 0; q < 4; ++q) S2_STEP(lr[q], lim[q], q);
                    } else {
                        float lr[16], lim[16];
#pragma unroll
                        for (int q = 0; q < 16; ++q) { lr[q] = bf_lo((unsigned)xl[(size_t)q * 128 + n]); lim[q] = bf_lo((unsigned)xl[(size_t)q * 128 + 64 + n]); }
                        for (int c = 0; c < nc; c += 16) {
                            float nr_[16], ni_[16]; const int cn = c + 16 < nc ? c + 16 : c;
#pragma unroll
                            for (int q = 0; q < 16; ++q) { nr_[q] = bf_lo((unsigned)xl[(size_t)(cn + q) * 128 + n]); ni_[q] = bf_lo((unsigned)xl[(size_t)(cn + q) * 128 + 64 + n]); }
#pragma unroll
                            for (int q = 0; q < 16; ++q) S2_STEP(lr[q], lim[q], q);
#pragma unroll
                            for (int q = 0; q < 16; ++q) { lr[q] = nr_[q]; lim[q] = ni_[q]; }
                        }
                    }
#undef S2_STEP
                    if (slot < 4) { out[O_REP + ((size_t)(li * 4 + slot) * NGRP + g) * 64 + n] = xr; out[O_IMP + ((size_t)(li * 4 + slot) * NGRP + g) * 64 + n] = xi; }
                    else { out[O_RES + ((size_t)(li * 8 + slot - 4) * NGRP + g) * 64 + n] = xr; out[O_IMS + ((size_t)(li * 8 + slot - 4) * NGRP + g) * 64 + n] = xi; }
                }
            }
#endif
            PH_END
            PH_BEGIN
#ifndef NO_S3
            { pg8::Gemm g = pg8::gemm_rm(UP, (const bf16_t*)(wb + WSZ_GG), 384, 384, 384); pg8::GroupOrder S{G, bx}; pg8::EpiY E{UP, Hb, args.in[I_SD] + li * DM};
              pg8::gemm_phase<pg8::EpiY, pg8::GroupOrder, true>(lds, g, S, E, tid); }
#endif
            PH_END
            PH_BEGIN
#ifndef NO_S4
            { pg8::Gemm g = pg8::gemm_rm(Hb, (const bf16_t*)wb, DM, DM, DM); pg8::StaticOrder S; S.init(128, 16, G, bx); pg8::EpiGlu E{XBs, modl + 4096};
              pg8::gemm_phase<pg8::EpiGlu, pg8::StaticOrder, true>(lds, g, S, E, tid); }
            { pg8::Gemm g = pg8::gemm_rm(Hb, (const bf16_t*)wb, DM, DM, 512); pg8::SplitOrder S{bx, 16, 4, (size_t)1024}; pg8::EpiPartial E{PART, 4096};
              pg8::gemm_phase<pg8::EpiPartial, pg8::SplitOrder, true>(lds, g, S, E, tid); }
#endif
            PH_END
        }
        {
#undef wb
#define wb (ws + WS_FFN + l * WSZ_FFN)
            PH_BEGIN
#ifndef NO_F0
            NORM_ROWS(false, l == 0, args.in[I_GFFN] + l * DM, 6144, 8192, 0, 4, modl + 4096, (l & 1));
#endif
            PH_END
            PH_BEGIN
#ifndef NO_F1
            { pg8::Gemm g = pg8::gemm_rm(Hb, (const bf16_t*)wb, DM, DM, DM); pg8::StaticOrder S; S.init(128, 44, G, bx);
              pg8::EpiFfn E{HID, args.in[I_FCW] + (size_t)l * 3 * DFF, args.in[I_FCB] + (size_t)l * DFF, out + O_CONVP + (size_t)l * 4 * 2 * DFF, GBND, DEFC, DEFU, (LAS float*)(lds + MISC_OFF + 1024)};
              pg8::gemm_phase<pg8::EpiFfn, pg8::StaticOrder, true>(lds, g, S, E, tid); }
            { pg8::Gemm g = pg8::gemm_rm(Hb, (const bf16_t*)wb, DM, DM, 1024); pg8::SplitOrder S{bx, 44, 2, (size_t)2048}; pg8::EpiPartial E{PGU, 2 * DFF};
              pg8::gemm_phase<pg8::EpiPartial, pg8::SplitOrder, true>(lds, g, S, E, tid); }
#endif
            PH_END
            PH_BEGIN
#ifndef NO_F2
            for (int it = gw; it < 512 * 22; it += NGW) { const int r = it / 22, c = (it - r * 22) * 256 + 4 * lane; const int b = r >> 6, t = r & 63;
                const float* cwp = args.in[I_FCW] + (size_t)l * 3 * DFF + c; const f32x4 w0 = *(const f32x4*)cwp, w1 = *(const f32x4*)(cwp + DFF), w2 = *(const f32x4*)(cwp + 2 * DFF), cbv = *(const f32x4*)(args.in[I_FCB] + (size_t)l * DFF + c);
                const float* pg = PGU + (size_t)r * (2 * DFF) + (c >> 7) * 256 + (c & 127); const size_t ps = (size_t)512 * 2 * DFF;
                const float* cc = args.in[I_CCONV] + ((size_t)(l * 8 + b) * 2) * DFF + c;
                const f32x4 g2 = *(const f32x4*)pg + *(const f32x4*)(pg + ps);
                const f32x4 g1 = t >= 1 ? *(const f32x4*)(pg - 2 * DFF) + *(const f32x4*)(pg - 2 * DFF + ps) : *(const f32x4*)(cc + DFF);
                const f32x4 g0 = t >= 2 ? *(const f32x4*)(pg - 4 * DFF) + *(const f32x4*)(pg - 4 * DFF + ps) : *(const f32x4*)(cc + (t == 1 ? DFF : 0));
                const f32x4 uu = *(const f32x4*)(pg + 128) + *(const f32x4*)(pg + 128 + ps);
                f32x4 h;
#pragma unroll
                for (int e = 0; e < 4; ++e) { const float gc = cbv[e] + w0[e] * g0[e] + w1[e] * g1[e] + w2[e] * g2[e]; h[e] = -1.4426950408889634f * (gc * fast_sigmoid(gc) * uu[e]); }
                u32x2 w; w.x = cvt_pk_bf16(h[0], h[1]); w.y = cvt_pk_bf16(h[2], h[3]);
                *(u32x2*)(HID + pg8::tiled_off(NPROMPT + r, c, DFF / 64)) = w;
                if (t >= DSEQ - 2) *(f32x4*)(out + O_CONVS + ((size_t)(l * 8 + b) * 2 + (t - (DSEQ - 2))) * DFF + c) = g2; }
            for (int it = gw * 64 + lane; it < 128 * 2 * (DFF / 4); it += NGW * 64) { const int pm = it / (2 * (DFF / 4)), rem = it - pm * (2 * (DFF / 4)), rr = rem / (DFF / 4), c = (rem - rr * (DFF / 4)) * 4;
                if ((pm & 31) == 0) continue;
                const float* cwp = args.in[I_FCW] + (size_t)l * 3 * DFF + c; const f32x4 w0 = *(const f32x4*)cwp, w1 = *(const f32x4*)(cwp + DFF);
                const f32x4 p254 = *(const f32x4*)(GBND + (size_t)((pm - 1) * 2) * DFF + c), p255 = *(const f32x4*)(GBND + (size_t)((pm - 1) * 2 + 1) * DFF + c);
                const f32x4 cp = *(const f32x4*)(DEFC + (size_t)(pm * 2 + rr) * DFF + c), uu = *(const f32x4*)(DEFU + (size_t)(pm * 2 + rr) * DFF + c);
                f32x4 h;
#pragma unroll
                for (int e = 0; e < 4; ++e) { const float gc = rr == 0 ? cp[e] + -1.4426950408889634f * (w0[e] * p254[e] + w1[e] * p255[e]) : cp[e] + -1.4426950408889634f * (w0[e] * p255[e]); h[e] = gc * __builtin_amdgcn_rcpf(1.0f + __builtin_amdgcn_exp2f(gc)) * uu[e]; }
                u32x2 w; w.x = cvt_pk_bf16(h[0], h[1]); w.y = cvt_pk_bf16(h[2], h[3]);
                *(u32x2*)(HID + pg8::tiled_off(pm * 256 + rr, c, DFF / 64)) = w; }
#endif
            PH_END
            PH_BEGIN
#ifndef NO_F3
            { pg8::Gemm g{HID, (const bf16_t*)(wb + 2 * WSZ_FF1), 64, 64, DFF, 32768, 32768, (size_t)88 * 32768, (size_t)88 * 32768};
              pg8::StaticOrder S; S.init(128, 8, G, bx); S.pmx = 8;
              pg8::EpiResid E{args.in[I_XP], out, XBs, modl + 10240, 0, (l == 3) ? 1 : 0};
              pg8::gemm_phase<pg8::EpiResid, pg8::StaticOrder, true>(lds, g, S, E, tid); }
            { pg8::Gemm g{HID, (const bf16_t*)(wb + 2 * WSZ_FF1), 64, 64, 512, 32768, 32768, (size_t)88 * 32768, (size_t)88 * 32768};
              pg8::SplitOrder S{bx, 8, 11, (size_t)8 * 32768}; pg8::EpiPartial E{PART, DM};
              pg8::gemm_phase<pg8::EpiPartial, pg8::SplitOrder, true>(lds, g, S, E, tid); }
#endif
            PH_END
        }
    }
    PH_BEGIN
    if (gw < 512) { const int row = NPROMPT + gw; const int slot = 4 + (gw >> 6); const float* pg = MOD + (size_t)(3 * NSLOT + slot) * 12288 + 10240;
        f32x4 sp[8];
#pragma unroll
        for (int j = 0; j < 8; ++j) sp[j] = (f32x4){0.f, 0.f, 0.f, 0.f};
        for (int ks = 0; ks < 11; ++ks) {
#pragma unroll
            for (int j = 0; j < 8; ++j) sp[j] += *(const f32x4*)(PART + ((size_t)ks * 512 + gw) * DM + 4 * lane + 256 * j); }
#pragma unroll
        for (int j = 0; j < 8; ++j) { const u32x2 xw = *(const u32x2*)(XBs + (size_t)row * DM + 4 * lane + 256 * j); const f32x4 xv = (f32x4){bf_lo(xw.x), bf_hi(xw.x), bf_lo(xw.y), bf_hi(xw.y)};
            *(f32x4*)(out + (size_t)row * DM + 4 * lane + 256 * j) = xv + *(const f32x4*)(pg + 4 * lane + 256 * j) * sp[j]; } }
    PH_END
#undef wb
#undef PH_BEGIN
#undef PH_END
}

constexpr int NPHASES = 1 + 2 * (6 + 4) + 2 * (5 + 4) + 1;

extern "C" void kernel_launch(void* const* d_in, const int* in_sizes, int n_in, void* d_out, int out_size, void* d_ws, size_t ws_size, hipStream_t stream) {
    static int grid = 0;
    if (grid == 0) {
        if (n_in != 37 || (size_t)out_size != O_END || ws_size < WS_END) { fprintf(stderr, "kernel_launch: unexpected shapes (n_in %d out %d ws %zu)\n", n_in, out_size, ws_size); grid = -1; return; }
        int dev = 0, cus = 0, per_cu = 0;
        if (hipGetDevice(&dev) != hipSuccess || hipDeviceGetAttribute(&cus, hipDeviceAttributeMultiprocessorCount, dev) != hipSuccess) { grid = -1; return; }
        if (hipFuncSetAttribute((const void*)fwd_kernel, hipFuncAttributeMaxDynamicSharedMemorySize, LDS_BYTES) != hipSuccess) { fprintf(stderr, "kernel_launch: hipFuncSetAttribute failed\n"); grid = -1; return; }
        if (hipOccupancyMaxActiveBlocksPerMultiprocessor(&per_cu, (const void*)fwd_kernel, NWAVES * 64, LDS_BYTES) != hipSuccess || per_cu < 1) { fprintf(stderr, "kernel_launch: occupancy query says %d\n", per_cu); }
        (void)hipGetLastError();
        grid = cus;
    }
    if (grid < 0) return;
    (void)hipMemsetAsync((char*)d_ws + WS_CTL, 0, CTL_ZERO_BYTES, stream);
    Args a{};
    for (int i = 0; i < 37; ++i) a.in[i] = (const float*)d_in[i];
    a.out = (float*)d_out; a.ws = (unsigned char*)d_ws;
#if MK_PER_PHASE
    for (int p = 0; p < NPHASES; ++p) { a.ph_lo = p; a.ph_hi = p + 1; hipLaunchKernelGGL(fwd_kernel, dim3(grid), dim3(NWAVES * 64), LDS_BYTES, stream, a); }
#else
    a.ph_lo = 0; a.ph_hi = NPHASES;
    hipLaunchKernelGGL(fwd_kernel, dim3(grid), dim3(NWAVES * 64), LDS_BYTES, stream, a);
#endif
    const hipError_t le = hipPeekAtLastError();
    if (le != hipSuccess) fprintf(stderr, "kernel_launch: launch failed: %s\n", hipGetErrorName(le));
}
```

```cpp
#include <hip/hip_runtime.h>
#include <cstdio>
#include <cstdint>

#ifndef MK_PER_PHASE
#define MK_PER_PHASE 0
#endif

#define LAS __attribute__((address_space(3)))
#define GAS __attribute__((address_space(1)))
typedef unsigned short bf16_t;
typedef short bf16x8 __attribute__((ext_vector_type(8)));
typedef short s16x4 __attribute__((ext_vector_type(4)));
typedef float f32x4 __attribute__((ext_vector_type(4)));
typedef float f32x2 __attribute__((ext_vector_type(2)));
typedef float f32x16 __attribute__((ext_vector_type(16)));
typedef unsigned u32x4 __attribute__((ext_vector_type(4)));
typedef unsigned u32x2 __attribute__((ext_vector_type(2)));

constexpr int DM = 2048, NPROMPT = 32768, NTOK = 33280, SEQ = 8192, DSEQ = 64, PAST = 4096, SKV = 4160, NKV = 66048, DFF = 5632;
constexpr int NH = 16, DQK = 192, QLORA = 512, KVLORA = 256;
constexpr int NSLOT = 12;
constexpr int NWAVES = 8;
constexpr float EPS = 1e-6f;
constexpr int NGRP = 128, NSUB = 2304;

constexpr size_t O_Y = 0, O_CKVP = 68157440, O_KRP = 84934656, O_CKVS = 89128960, O_KRS = 89391104, O_REP = 89456640, O_IMP = 89522176,
                 O_RES = 89587712, O_IMS = 89718784, O_CONVP = 89849856, O_CONVS = 90030080, O_END = 90390528;

constexpr size_t MiB = 1u << 20;
constexpr size_t WS_CTL = 0, CTL_ZERO_BYTES = 1 * MiB, WS_ZGATE = 128 * 1024;
constexpr size_t WS_MOD = 1 * MiB;
constexpr size_t WS_A16 = 4 * MiB;
constexpr size_t WS_KRSS = 5 * MiB;
constexpr size_t WS_ROPE = 6 * MiB;
constexpr size_t WS_W = 8 * MiB;
constexpr size_t WSZ_DQKV = 4 * MiB, WSZ_UQ = 3 * MiB, WSZ_UKV = 2 * MiB, WSZ_WO = 8 * MiB, WSZ_MLA = 17 * MiB;
constexpr size_t WS_MLA = WS_W;
constexpr size_t WSZ_GG = 16 * MiB, WSZ_BTY = 24 * MiB, WSZ_BTX = 16 * MiB, WSZ_S5 = 56 * MiB;
constexpr size_t WS_S5 = WS_MLA + 2 * WSZ_MLA;
constexpr size_t WSZ_FF1 = 22 * MiB, WSZ_FFN = 66 * MiB;
constexpr size_t WS_FFN = WS_S5 + 2 * WSZ_S5;
constexpr size_t WS_H = WS_FFN + 4 * WSZ_FFN;
constexpr size_t WS_XB = WS_H + 130 * MiB;
constexpr size_t WS_BIG = WS_XB + 130 * MiB;
constexpr size_t OY_QA = 0;
constexpr size_t OY_CKV = 33 * MiB;
constexpr size_t OY_STATQ = 100 * MiB;
constexpr size_t OY_RSTDQ = 102 * MiB;
constexpr size_t OY_R = 66 * MiB;
constexpr size_t WS_Q = WS_BIG;
constexpr size_t WS_KB = WS_Q + 195 * MiB;
constexpr size_t WS_QKVA = WS_KB;
constexpr size_t WS_G = WS_BIG;
constexpr size_t WS_HID = WS_BIG + 358 * MiB;
constexpr size_t WS_PART = WS_BIG + 716 * MiB;
constexpr size_t WS_PGU = WS_BIG + 764 * MiB;
constexpr size_t WS_UP = WS_BIG;
constexpr size_t WS_XLOC = WS_BIG + 216 * MiB;
constexpr size_t WS_END = WS_KB + 645 * MiB;
static_assert(WS_END <= 1536 * MiB, "workspace map");
static_assert(WS_HID + 358 * MiB <= WS_PART && WS_PART + 48 * MiB <= WS_PGU && WS_PGU + 48 * MiB <= WS_END && WS_XLOC + 144 * MiB <= WS_PART, "aliases");

constexpr int RING_BYTES = 131072;
constexpr int MISC_OFF = RING_BYTES;
constexpr int PAR_OFF = RING_BYTES + 1024 + 4096;
constexpr int LDS_BYTES = RING_BYTES + 1024 + 4096 + 2048;

#define RLX_AGENT __ATOMIC_RELAXED, __HIP_MEMORY_SCOPE_AGENT
#define LDS_WAIT() asm volatile("s_waitcnt lgkmcnt(0)" ::: "memory")
#define VM_WAIT() asm volatile("s_waitcnt vmcnt(0)" ::: "memory")

__device__ __forceinline__ unsigned cvt_pk_bf16(float lo, float hi) { unsigned r; asm volatile("v_cvt_pk_bf16_f32 %0, %1, %2" : "=v"(r) : "v"(lo), "v"(hi)); return r; }
__device__ __forceinline__ float bf_lo(unsigned w) { return __uint_as_float(w << 16); }
__device__ __forceinline__ float bf_hi(unsigned w) { return __uint_as_float(w & 0xffff0000u); }
__device__ __forceinline__ float bf1(bf16_t b) { return __uint_as_float(((unsigned)b) << 16); }
__device__ __forceinline__ float shx(float v, int m, int lane) { return __int_as_float(__builtin_amdgcn_ds_bpermute((lane ^ m) << 2, __float_as_int(v))); }
__device__ __forceinline__ float wave_sum(float v, int lane) {
#pragma unroll
    for (int o = 1; o < 64; o <<= 1) v += shx(v, o, lane);
    return v;
}
__device__ __forceinline__ float sum16(float v, int lane) {
#pragma unroll
    for (int o = 1; o < 16; o <<= 1) v += shx(v, o, lane);
    return v;
}
__device__ __forceinline__ int slot_of_row(int r) { return r < NPROMPT ? (r >> 13) : 4 + ((r - NPROMPT) >> 6); }
__device__ __forceinline__ float fast_sigmoid(float x) { return __builtin_amdgcn_rcpf(1.0f + __builtin_amdgcn_exp2f(-1.4426950408889634f * x)); }

#ifndef GEMM_SP2
#define GEMM_SP2 true
#endif
namespace pg8 {
constexpr int BM = 256, BK = 64, HALF = 128, HTB = HALF * BK * 2, STAGE_BYTES = 8 * HTB, NXCD = 8, WGM = 8;
__host__ __device__ __forceinline__ int lds_byte(int r, int c) { const int st = (r >> 4) * 2 + (c >> 5), rr = r & 15, cc = c & 31, ob = rr * 64 + cc * 2; return st * 1024 + (ob ^ (((ob >> 9) & 1) << 5)); }
__host__ __device__ __forceinline__ void stage_rc(int b, int& R, int& C) { const int st = b / 1024, sb = b % 1024, swz = sb ^ (((sb >> 9) & 1) << 5); R = (st >> 1) * 16 + swz / 64; C = (st & 1) * 32 + (swz % 64) / 2; }
__host__ __device__ __forceinline__ int perm32(int rho) { const int n = rho >> 4, i = rho & 15; return 8 * (i >> 2) + 4 * n + (i & 3); }

struct Unit { int pm, pn, ks; size_t koff; };
struct Gemm { const bf16_t* A; const bf16_t* Bt; int lda, ldb, K; size_t ksA, ksB, tsA, tsB; };
__device__ __forceinline__ Gemm gemm_rm(const bf16_t* A, const bf16_t* Bt, int lda, int ldb, int K) { return Gemm{A, Bt, lda, ldb, K, 128, 128, (size_t)512 * lda, (size_t)512 * ldb}; }
__device__ __forceinline__ size_t tiled_off(int row, int col, int nkt) { return (((size_t)(row >> 8) * nkt + (col >> 6)) * 256 + (row & 255)) * 64 + (col & 63); }

struct StaticOrder {
    int nM, nN, nwg, G, c;
    __device__ void init(int nM_, int nN_, int G_, int c_) { nM = nM_; nN = nN_; nwg = nM * nN; G = G_; c = c_; }
    __device__ bool next(int i, Unit& u) const {
        const long L = (long)i * G + c; if (L >= nwg) return false;
        int wgid = (int)L; { const int q = nwg / NXCD, r = nwg % NXCD, xcd = wgid % NXCD, off = wgid / NXCD; wgid = (xcd < r ? xcd * (q + 1) : r * (q + 1) + (xcd - r) * q) + off; }
        const int nig = WGM * nN, gid = wgid / nig, fm = gid * WGM, gsz = (nM - fm) < WGM ? (nM - fm) : WGM;
        u.pm = fm + ((wgid % nig) % gsz); u.pn = (wgid % nig) / gsz; u.ks = 0; u.koff = 0; return true;
    }
};
struct SplitOrder {
    int c, nN, nsplit; size_t kbytes;
    __device__ bool next(int i, Unit& u) const { if (i > 0 || c >= 2 * nN * nsplit) return false; const int ks = c % nsplit, t = c / nsplit; u.pm = 128 + t / nN; u.pn = t % nN; u.ks = ks; u.koff = ks * kbytes; return true; }
};
struct GroupOrder {
    int G, c;
    __device__ bool next(int i, Unit& u) const { const int L = i * G + c; if (L >= NGRP * 9) return false; const int g = L < NGRP * 8 ? L >> 3 : L - NGRP * 8, p = L < NGRP * 8 ? (L & 7) : 8;
        u.pm = 9 * g + p; u.pn = g; u.ks = 0; u.koff = 0; return true; }
};

template <class Epi, class Sched, bool ALIGN_EPI, bool SP2 = GEMM_SP2>
__device__ __forceinline__ void gemm_phase(LAS unsigned char* lds, const Gemm g, const Sched& S, const Epi& E, const int tid) {
    const int wid = __builtin_amdgcn_readfirstlane(tid >> 6), lane = tid & 63, wr = wid >> 2, wc = wid & 3, fr = lane & 15, fq = lane >> 4;
    const int K = g.K, nt = K / BK;
    unsigned voffA[2], voffB[2];
#pragma unroll
    for (int i = 0; i < 2; ++i) { int R, C; stage_rc(tid * 16 + i * 8192, R, C); const int Rb = Epi::PERM ? ((R & ~31) + perm32(R & 31)) : R;
        const int Ra = Epi::PERMA ? ((R & ~63) + ((R & 15) << 2) + ((R >> 4) & 3)) : R;
        voffA[i] = (unsigned)(Ra * g.lda + C) * 2u; voffB[i] = (unsigned)(Rb * g.ldb + C) * 2u; }
    const size_t kstepA = g.ksA, kstepB = g.ksB;
    const size_t hstepA = (size_t)HALF * g.lda * 2, hstepB = (size_t)HALF * g.ldb * 2;
    const size_t tstepA = g.tsA, tstepB = g.tsB;
    const unsigned ldsw = (unsigned)wid * 1024u;
    const int aoff = lds_byte(wr * 64 + fr, fq * 8), boff = lds_byte(wc * 32 + fr, fq * 8);
#define PG8_SA(b, h) (((b) * 2 + (h)) * HTB)
#define PG8_SB(b, h) ((4 + (b) * 2 + (h)) * HTB)
#define PG8_STAGE(bufoff, gbase, voff) do { _Pragma("unroll") for (int _i = 0; _i < 2; ++_i) \
        __builtin_amdgcn_global_load_lds((const unsigned*)((const char*)(gbase) + (voff)[_i]), (LAS unsigned*)(lds + (bufoff) + ldsw + _i * 8192), 16, 0, 0); } while (0)
#define PG8_LDA(dst, b, h) do { _Pragma("unroll") for (int m = 0; m < 4; ++m) _Pragma("unroll") for (int k = 0; k < 2; ++k) dst[m][k] = *(const LAS bf16x8*)(lds + PG8_SA(b, h) + aoff + m * 2048 + k * 1024); } while (0)
#define PG8_LDB(dst, b, h) do { _Pragma("unroll") for (int n = 0; n < 2; ++n) _Pragma("unroll") for (int k = 0; k < 2; ++k) dst[n][k] = *(const LAS bf16x8*)(lds + PG8_SB(b, h) + boff + n * 2048 + k * 1024); } while (0)
#define PG8_MMA(ai, bj, At, Bt) do { __builtin_amdgcn_s_setprio(1); _Pragma("unroll") for (int m = 0; m < 4; ++m) _Pragma("unroll") for (int n = 0; n < 2; ++n) _Pragma("unroll") for (int k = 0; k < 2; ++k) \
        acc[ai][bj][m][n] = __builtin_amdgcn_mfma_f32_16x16x32_bf16(Bt[n][k], At[m][k], acc[ai][bj][m][n], 0, 0, 0); __builtin_amdgcn_s_setprio(0); } while (0)
#define PG8_WAIT_V(n) asm volatile("s_waitcnt vmcnt(" #n ")" ::: "memory")
#define PG8_WAIT_L(n) asm volatile("s_waitcnt lgkmcnt(" #n ")" ::: "memory")
#define PG8_WAIT_VP(n) do { if constexpr (Epi::NPRE == 0) { PG8_WAIT_V(n); } else { static_assert(Epi::NPRE == 1 && n == 8, "counts"); if (pf) PG8_WAIT_V(9); else PG8_WAIT_V(8); } } while (0)
#define PG8_BAR __builtin_amdgcn_s_barrier()
#define PG8_SCHED __builtin_amdgcn_sched_barrier(0)
    Unit cur, nxt; int ui = 0;
    if (!S.next(0, cur)) return;
    f32x4 acc[2][2][4][2];
#pragma unroll
    for (int a = 0; a < 2; ++a)
#pragma unroll
        for (int b = 0; b < 2; ++b)
#pragma unroll
            for (int m = 0; m < 4; ++m)
#pragma unroll
                for (int n = 0; n < 2; ++n) acc[a][b][m][n] = (f32x4){0.f, 0.f, 0.f, 0.f};
    bf16x8 At[4][2], B0[2][2], B1[2][2];
    const char* cA = (const char*)g.A + (size_t)cur.pm * tstepA + cur.koff; const char* cB = (const char*)g.Bt + (size_t)cur.pn * tstepB + cur.koff;
    if constexpr (SP2) {
    PG8_STAGE(PG8_SB(0, 0), cB, voffB); PG8_STAGE(PG8_SB(0, 1), cB + hstepB, voffB); PG8_STAGE(PG8_SA(0, 0), cA, voffA); PG8_STAGE(PG8_SA(0, 1), cA + hstepA, voffA);
    if (wr == 1) PG8_BAR;
    PG8_WAIT_V(2); PG8_BAR;
    PG8_STAGE(PG8_SB(1, 0), cB + kstepB, voffB); PG8_STAGE(PG8_SA(1, 0), cA + kstepA, voffA); PG8_STAGE(PG8_SB(1, 1), cB + hstepB + kstepB, voffB);
    PG8_WAIT_V(6); PG8_BAR;
    } else {
    PG8_STAGE(PG8_SB(0, 0), cB, voffB); PG8_STAGE(PG8_SA(0, 0), cA, voffA); PG8_STAGE(PG8_SB(0, 1), cB + hstepB, voffB); PG8_STAGE(PG8_SA(0, 1), cA + hstepA, voffA);
    if (wr == 1) PG8_BAR;
    PG8_WAIT_V(4); PG8_BAR;
    PG8_STAGE(PG8_SB(1, 0), cB + kstepB, voffB); PG8_STAGE(PG8_SA(1, 0), cA + kstepA, voffA); PG8_STAGE(PG8_SB(1, 1), cB + hstepB + kstepB, voffB);
    PG8_WAIT_V(6); PG8_BAR;
    }
    for (;;) {
        const bool has_next = S.next(ui + 1, nxt);
        const char* nA = has_next ? (const char*)g.A + (size_t)nxt.pm * tstepA + nxt.koff : cA; const char* nB = has_next ? (const char*)g.Bt + (size_t)nxt.pn * tstepB + nxt.koff : cB;
#pragma unroll 1
        for (int t = 0; t < nt; t += 2) {
            const bool last = (t == nt - 2);
            const char* a1 = cA + (size_t)(t + 1) * kstepA;
            const char* a2 = last ? nA : cA + (size_t)(t + 2) * kstepA; const char* b2 = last ? nB : cB + (size_t)(t + 2) * kstepB;
            const char* a3 = a2 + kstepA; const char* b3 = b2 + kstepB;
            const bool pf = Epi::NPRE > 0 && (t == nt - 4);
            if constexpr (Epi::NPRE > 0) { if (pf) E.prefetch(lds, cur, wid, lane); }
            if constexpr (SP2) {
            PG8_LDB(B0, 0, 0); PG8_LDB(B1, 0, 1); PG8_SCHED; PG8_LDA(At, 0, 0); PG8_STAGE(PG8_SA(1, 1), a1 + hstepA, voffA);
            PG8_WAIT_VP(8); PG8_WAIT_L(0); PG8_BAR; PG8_MMA(0, 0, At, B0); PG8_MMA(0, 1, At, B1); PG8_BAR; PG8_SCHED;
            PG8_LDA(At, 0, 1); PG8_STAGE(PG8_SB(0, 0), b2, voffB); PG8_STAGE(PG8_SB(0, 1), b2 + hstepB, voffB); PG8_STAGE(PG8_SA(0, 0), a2, voffA);
            PG8_WAIT_VP(8); PG8_WAIT_L(0); PG8_BAR; PG8_MMA(1, 0, At, B0); PG8_MMA(1, 1, At, B1); PG8_BAR; PG8_SCHED;
            PG8_LDB(B0, 1, 0); PG8_LDB(B1, 1, 1); PG8_SCHED; PG8_LDA(At, 1, 0); PG8_STAGE(PG8_SA(0, 1), a2 + hstepA, voffA);
            PG8_WAIT_VP(8); PG8_WAIT_L(0); PG8_BAR; PG8_MMA(0, 0, At, B0); PG8_MMA(0, 1, At, B1); PG8_BAR; PG8_SCHED;
            PG8_LDA(At, 1, 1); PG8_STAGE(PG8_SB(1, 0), b3, voffB); PG8_STAGE(PG8_SB(1, 1), b3 + hstepB, voffB); PG8_STAGE(PG8_SA(1, 0), a3, voffA);
            PG8_WAIT_VP(8); PG8_WAIT_L(0); PG8_BAR; PG8_MMA(1, 0, At, B0); PG8_MMA(1, 1, At, B1); PG8_BAR; PG8_SCHED;
            } else {
            PG8_LDB(B0, 0, 0); PG8_SCHED; PG8_LDA(At, 0, 0); PG8_STAGE(PG8_SA(1, 1), a1 + hstepA, voffA);
            PG8_WAIT_L(8); PG8_BAR; PG8_WAIT_L(0); PG8_MMA(0, 0, At, B0); PG8_BAR; PG8_SCHED;
            PG8_LDB(B1, 0, 1); PG8_STAGE(PG8_SB(0, 0), b2, voffB);
            PG8_BAR; PG8_WAIT_L(0); PG8_MMA(0, 1, At, B1); PG8_BAR;
            PG8_LDA(At, 0, 1); PG8_STAGE(PG8_SA(0, 0), a2, voffA);
            PG8_BAR; PG8_WAIT_L(0); PG8_MMA(1, 0, At, B0); PG8_BAR; PG8_SCHED;
            PG8_STAGE(PG8_SB(0, 1), b2 + hstepB, voffB);
            PG8_WAIT_V(6); PG8_BAR; PG8_MMA(1, 1, At, B1); PG8_BAR;
            PG8_LDB(B0, 1, 0); PG8_SCHED; PG8_LDA(At, 1, 0); PG8_STAGE(PG8_SA(0, 1), a2 + hstepA, voffA);
            PG8_WAIT_L(8); PG8_BAR; PG8_WAIT_L(0); PG8_MMA(0, 0, At, B0); PG8_BAR; PG8_SCHED;
            PG8_LDB(B1, 1, 1); PG8_STAGE(PG8_SB(1, 0), b3, voffB);
            PG8_BAR; PG8_WAIT_L(0); PG8_MMA(0, 1, At, B1); PG8_BAR;
            PG8_LDA(At, 1, 1); PG8_STAGE(PG8_SA(1, 0), a3, voffA);
            PG8_BAR; PG8_WAIT_L(0); PG8_MMA(1, 0, At, B0); PG8_BAR; PG8_SCHED;
            PG8_STAGE(PG8_SB(1, 1), b3 + hstepB, voffB);
            PG8_WAIT_V(6); PG8_BAR; PG8_MMA(1, 1, At, B1); PG8_BAR;
            }
        }
        if constexpr (ALIGN_EPI) { if (wr == 0) PG8_BAR; }
        E(acc, cur, wr, wc, fr, fq);
        if (!has_next) break;
#pragma unroll
        for (int a = 0; a < 2; ++a)
#pragma unroll
            for (int b = 0; b < 2; ++b)
#pragma unroll
                for (int m = 0; m < 4; ++m)
#pragma unroll
                    for (int n = 0; n < 2; ++n) acc[a][b][m][n] = (f32x4){0.f, 0.f, 0.f, 0.f};
        cur = nxt; cA = nA; cB = nB; ++ui;
        if constexpr (ALIGN_EPI) { if (wr == 1) PG8_BAR; }
    }
    PG8_WAIT_V(0);
    if constexpr (!ALIGN_EPI) { if (wr == 0) PG8_BAR; }
    PG8_BAR;
#undef PG8_SA
#undef PG8_SB
#undef PG8_STAGE
#undef PG8_LDA
#undef PG8_LDB
#undef PG8_MMA
#undef PG8_WAIT_V
#undef PG8_WAIT_VP
#undef PG8_WAIT_L
#undef PG8_BAR
#undef PG8_SCHED
}

typedef f32x4 Acc[2][2][4][2];

struct EpiF32 {
    static constexpr int NPRE = 0; static constexpr bool PERMA = false;
    static constexpr bool PERM = false;
    float* C; int ldc;
    __device__ __forceinline__ void operator()(const Acc& acc, const Unit& u, int wr, int wc, int fr, int fq) const {
        const int row0 = u.pm * BM + wr * 64 + fr, col0 = u.pn * BM + wc * 32 + 4 * fq;
#pragma unroll
        for (int ai = 0; ai < 2; ++ai)
#pragma unroll
            for (int m = 0; m < 4; ++m) { float* rowp = C + (size_t)(row0 + ai * HALF + m * 16) * ldc + col0;
#pragma unroll
                for (int bj = 0; bj < 2; ++bj)
#pragma unroll
                    for (int n = 0; n < 2; ++n) *(f32x4*)(rowp + bj * HALF + n * 16) = acc[ai][bj][m][n]; }
    }
};
__device__ __forceinline__ u32x4 pack8(const f32x4& v0, const f32x4& v1) { u32x4 w; w.x = cvt_pk_bf16(v0[0], v0[1]); w.y = cvt_pk_bf16(v0[2], v0[3]); w.z = cvt_pk_bf16(v1[0], v1[1]); w.w = cvt_pk_bf16(v1[2], v1[3]); return w; }
struct EpiBf16 {
    static constexpr int NPRE = 0; static constexpr bool PERMA = false;
    static constexpr bool PERM = true;
    bf16_t* O; int ldc; const float* rs;
    __device__ __forceinline__ void operator()(const Acc& acc, const Unit& u, int wr, int wc, int fr, int fq) const {
        const int row0 = u.pm * BM + wr * 64 + fr, col0 = u.pn * BM + wc * 32 + 8 * fq;
        float sc[2][4];
#pragma unroll
        for (int ai = 0; ai < 2; ++ai)
#pragma unroll
            for (int m = 0; m < 4; ++m) sc[ai][m] = rs[row0 + ai * HALF + m * 16];
#pragma unroll
        for (int ai = 0; ai < 2; ++ai)
#pragma unroll
            for (int m = 0; m < 4; ++m) { bf16_t* rowp = O + (size_t)(row0 + ai * HALF + m * 16) * ldc + col0;
#pragma unroll
                for (int bj = 0; bj < 2; ++bj) *(u32x4*)(rowp + bj * HALF) = pack8(acc[ai][bj][m][0] * sc[ai][m], acc[ai][bj][m][1] * sc[ai][m]); }
    }
};
struct EpiA1 {
    static constexpr int NPRE = 0; static constexpr bool PERMA = false;
    static constexpr bool PERM = true;
    float* C; bf16_t* Q; float* stat;
    __device__ __forceinline__ void operator()(const Acc& acc, const Unit& u, int wr, int wc, int fr, int fq) const {
        const int lane = fr + 16 * fq;
        const int row0 = u.pm * BM + wr * 64 + fr, col0 = u.pn * BM + wc * 32 + 8 * fq;
        if (u.pn < 2) {
#pragma unroll
            for (int ai = 0; ai < 2; ++ai)
#pragma unroll
                for (int m = 0; m < 4; ++m) { const int row = row0 + ai * HALF + m * 16; float ss = 0.f;
#pragma unroll
                    for (int bj = 0; bj < 2; ++bj) { const f32x4 a = acc[ai][bj][m][0], b = acc[ai][bj][m][1];
                        *(u32x4*)(Q + (size_t)row * QLORA + col0 + bj * HALF) = pack8(a, b);
                        ss += ((a[0] * a[0] + a[1] * a[1]) + (a[2] * a[2] + a[3] * a[3])) + ((b[0] * b[0] + b[1] * b[1]) + (b[2] * b[2] + b[3] * b[3])); }
                    ss += shx(ss, 16, lane); ss += shx(ss, 32, lane);
                    if (fq == 0) stat[(size_t)row * 8 + u.pn * 4 + wc] = ss; }
        } else {
#pragma unroll
            for (int ai = 0; ai < 2; ++ai)
#pragma unroll
                for (int m = 0; m < 4; ++m) { float* rowp = C + (size_t)(row0 + ai * HALF + m * 16) * 1024 + col0;
#pragma unroll
                    for (int bj = 0; bj < 2; ++bj) { *(f32x4*)(rowp + bj * HALF) = acc[ai][bj][m][0]; *(f32x4*)(rowp + bj * HALF + 4) = acc[ai][bj][m][1]; } }
        }
    }
};
struct EpiKV {
    static constexpr int NPRE = 0; static constexpr bool PERMA = false;
    static constexpr bool PERM = true;
    bf16_t* KV; const float* krss; const float* R; const float* gkn; LAS float* scr;
    __device__ __forceinline__ void operator()(const Acc& acc, const Unit& u, int wr, int wc, int fr, int fq) const {
        const int lane = fr + 16 * fq;
#pragma unroll
        for (int ai = 0; ai < 2; ++ai)
#pragma unroll
            for (int m = 0; m < 4; ++m) { const f32x4 a = acc[ai][0][m][0], b = acc[ai][0][m][1];
                float s = (a[0] * a[0] + a[1] * a[1]) + (a[2] * a[2] + a[3] * a[3]) + (b[0] * b[0] + b[1] * b[1]) + (b[2] * b[2] + b[3] * b[3]);
                s += shx(s, 16, lane); s += shx(s, 32, lane);
                if (fq == 0) scr[(ai * HALF + wr * 64 + m * 16 + fr) * 4 + wc] = s; }
        const int row0 = u.pm * BM + wr * 64 + fr;
        bf16_t* base = KV + (size_t)row0 * 5120 + u.pn * 320;
        const f32x4 g0 = *(const f32x4*)(gkn + wc * 32 + 8 * fq), g1 = *(const f32x4*)(gkn + wc * 32 + 8 * fq + 4);
        float kr[2][4]; f32x4 rv[2][4];
#pragma unroll
        for (int ai = 0; ai < 2; ++ai)
#pragma unroll
            for (int m = 0; m < 4; ++m) { const size_t row = (size_t)(row0 + ai * HALF + m * 16); kr[ai][m] = krss[row]; rv[ai][m] = *(const f32x4*)(R + row * 64 + wc * 16 + 4 * fq); }
        asm volatile("s_waitcnt lgkmcnt(0)\n\ts_barrier" ::: "memory");
#pragma unroll
        for (int ai = 0; ai < 2; ++ai)
#pragma unroll
            for (int m = 0; m < 4; ++m) { const int rl = ai * HALF + m * 16;
                const f32x4 sp = *(const LAS f32x4*)(scr + (rl + wr * 64 + fr) * 4);
                const float r = 1.0f / sqrtf(((sp[0] + sp[1]) + (sp[2] + sp[3]) + kr[ai][m]) * (1.0f / 192.0f) + EPS);
                bf16_t* rowp = base + (size_t)rl * 5120;
                *(u32x4*)(rowp + wc * 32 + 8 * fq) = pack8(acc[ai][0][m][0] * g0 * r, acc[ai][0][m][1] * g1 * r);
                *(u32x4*)(rowp + 192 + wc * 32 + 8 * fq) = pack8(acc[ai][1][m][0], acc[ai][1][m][1]);
                const f32x4 rr = rv[ai][m] * r;
                u32x2 w; w.x = cvt_pk_bf16(rr[0], rr[1]); w.y = cvt_pk_bf16(rr[2], rr[3]);
                *(u32x2*)(rowp + 128 + wc * 16 + 4 * fq) = w; }
    }
};
struct EpiResid {
    static constexpr int NPRE = 0; static constexpr bool PERMA = false;
    static constexpr bool PERM = true;
    const float* xin32; float* xout32; bf16_t* xb; const float* gate; int inf32, outf32;
    __device__ __forceinline__ void operator()(const Acc& acc, const Unit& u, int wr, int wc, int fr, int fq) const {
        const int col0 = u.pn * BM + wc * 32 + 8 * fq;
#pragma unroll
        for (int ai = 0; ai < 2; ++ai) {
            const int rbase = u.pm * BM + ai * HALF + wr * 64; const float* gp = gate + (size_t)slot_of_row(rbase) * 12288 + col0;
            const size_t off0 = (size_t)(rbase + fr) * DM + col0;
            f32x4 xi[4][2][2];
            if (inf32) {
#pragma unroll
                for (int m = 0; m < 4; ++m)
#pragma unroll
                    for (int bj = 0; bj < 2; ++bj)
#pragma unroll
                        for (int n = 0; n < 2; ++n) xi[m][bj][n] = *(const f32x4*)(xin32 + off0 + (size_t)m * 16 * DM + bj * HALF + n * 4);
            } else { u32x4 xr[4][2];
#pragma unroll
                for (int m = 0; m < 4; ++m)
#pragma unroll
                    for (int bj = 0; bj < 2; ++bj) xr[m][bj] = *(const u32x4*)(xb + off0 + (size_t)m * 16 * DM + bj * HALF);
#pragma unroll
                for (int m = 0; m < 4; ++m)
#pragma unroll
                    for (int bj = 0; bj < 2; ++bj) { xi[m][bj][0] = (f32x4){bf_lo(xr[m][bj].x), bf_hi(xr[m][bj].x), bf_lo(xr[m][bj].y), bf_hi(xr[m][bj].y)}; xi[m][bj][1] = (f32x4){bf_lo(xr[m][bj].z), bf_hi(xr[m][bj].z), bf_lo(xr[m][bj].w), bf_hi(xr[m][bj].w)}; } }
            f32x4 gv[2][2];
#pragma unroll
            for (int bj = 0; bj < 2; ++bj)
#pragma unroll
                for (int n = 0; n < 2; ++n) gv[bj][n] = *(const f32x4*)(gp + bj * HALF + n * 4);
#pragma unroll
            for (int m = 0; m < 4; ++m)
#pragma unroll
                for (int bj = 0; bj < 2; ++bj) { const f32x4 x0 = xi[m][bj][0] + gv[bj][0] * acc[ai][bj][m][0], x1 = xi[m][bj][1] + gv[bj][1] * acc[ai][bj][m][1]; const size_t o = off0 + (size_t)m * 16 * DM + bj * HALF;
                    if (outf32) { *(f32x4*)(xout32 + o) = x0; *(f32x4*)(xout32 + o + 4) = x1; } else *(u32x4*)(xb + o) = pack8(x0, x1); }
            asm volatile("" ::: "memory");
        }
    }
};
struct EpiGlu {
    static constexpr int NPRE = 0; static constexpr bool PERMA = false;
    static constexpr bool PERM = true;
    bf16_t* xb; const float* gate;
    __device__ __forceinline__ void operator()(const Acc& acc, const Unit& u, int wr, int wc, int fr, int fq) const {
        const int col0 = u.pn * HALF + wc * 32 + 8 * fq;
        u32x4 xr[2][4];
#pragma unroll
        for (int ai = 0; ai < 2; ++ai)
#pragma unroll
            for (int m = 0; m < 4; ++m) xr[ai][m] = *(const u32x4*)(xb + (size_t)(u.pm * BM + ai * HALF + wr * 64 + m * 16 + fr) * DM + col0);
#pragma unroll
        for (int ai = 0; ai < 2; ++ai) {
            const int rbase = u.pm * BM + ai * HALF + wr * 64; const float* gp = gate + (size_t)slot_of_row(rbase) * 12288 + col0;
            f32x4 gv[2];
#pragma unroll
            for (int n = 0; n < 2; ++n) gv[n] = *(const f32x4*)(gp + n * 4);
#pragma unroll
            for (int m = 0; m < 4; ++m) { const size_t off = (size_t)(rbase + m * 16 + fr) * DM + col0; f32x4 o[2];
#pragma unroll
                for (int n = 0; n < 2; ++n) { const f32x4 a = acc[ai][0][m][n], b = acc[ai][1][m][n]; const unsigned lo = n == 0 ? xr[ai][m].x : xr[ai][m].z, hi = n == 0 ? xr[ai][m].y : xr[ai][m].w;
                    const f32x4 xi = (f32x4){bf_lo(lo), bf_hi(lo), bf_lo(hi), bf_hi(hi)};
#pragma unroll
                    for (int j = 0; j < 4; ++j) o[n][j] = xi[j] + gv[n][j] * a[j] * fast_sigmoid(b[j]); }
                *(u32x4*)(xb + off) = pack8(o[0], o[1]); }
        }
    }
};
struct EpiGate {
    static constexpr int NPRE = 0; static constexpr bool PERMA = false;
    static constexpr bool PERM = true;
    bf16_t* G; float* convp; float* convs;
    __device__ __forceinline__ void operator()(const Acc& acc, const Unit& u, int wr, int wc, int fr, int fq) const {
        const int col0 = u.pn * BM + wc * 32 + 8 * fq;
#pragma unroll
        for (int ai = 0; ai < 2; ++ai) {
            const int rbase = u.pm * BM + ai * HALF + wr * 64; const int slot = slot_of_row(rbase);
#pragma unroll
            for (int m = 0; m < 4; ++m) { const int row = rbase + m * 16 + fr; bf16_t* rowp = G + (size_t)(row + 2 * (slot + 1)) * DFF + col0;
#pragma unroll
                for (int bj = 0; bj < 2; ++bj) *(u32x4*)(rowp + bj * HALF) = pack8(acc[ai][bj][m][0], acc[ai][bj][m][1]);
                if (m == 3 && fr >= 14) {
                    const bool lastp = (slot < 4) && ((row & (SEQ - 1)) >= SEQ - 2); const bool lasts = (slot >= 4);
                    if (lastp || lasts) { float* cp = (slot < 4 ? convp + (size_t)(slot * 2 + (row & 1)) * DFF : convs + (size_t)((slot - 4) * 2 + (row & 1)) * DFF) + col0;
#pragma unroll
                        for (int bj = 0; bj < 2; ++bj) { *(f32x4*)(cp + bj * HALF) = acc[ai][bj][m][0]; *(f32x4*)(cp + bj * HALF + 4) = acc[ai][bj][m][1]; } }
                }
            }
        }
    }
};
struct EpiUp {
    static constexpr int NPRE = 0; static constexpr bool PERMA = false;
    static constexpr bool PERM = true;
    const bf16_t* G; bf16_t* HID; const float* cw; const float* cb;
    __device__ __forceinline__ void operator()(const Acc& acc, const Unit& u, int wr, int wc, int fr, int fq) const {
        u32x4 ga[3], gb[3];
        const bf16_t* gbase = G + (size_t)(u.pm * BM + wr * 64 + fr) * DFF + u.pn * BM + wc * 32 + 8 * fq;
        const int sl0 = 2 * (slot_of_row(u.pm * BM + wr * 64) + 1), sl1 = 2 * (slot_of_row(u.pm * BM + HALF + wr * 64) + 1);
#define EU_LOAD(DST, B) do { const bf16_t* gp_ = gbase + (size_t)((((B) >> 2) & 1) * HALF + ((B) & 3) * 16 + ((((B) >> 2) & 1) ? sl1 : sl0)) * DFF + ((B) >> 3) * HALF; \
            DST[2] = *(const u32x4*)gp_; DST[1] = *(const u32x4*)(gp_ - DFF); DST[0] = *(const u32x4*)(gp_ - 2 * DFF); } while (0)
#define EU_COMP(SRC, B) do { constexpr int bj_ = (B) >> 3, ai_ = ((B) >> 2) & 1, m_ = (B) & 3; const int col_ = u.pn * BM + bj_ * HALF + wc * 32 + 8 * fq; \
            const int row_ = u.pm * BM + ai_ * HALF + wr * 64 + m_ * 16 + fr; float o_[8]; \
            _Pragma("unroll") for (int q = 0; q < 4; ++q) { \
                const float c0 = bb[2 * q] + w0[2 * q] * bf_lo(SRC[0][q]) + w1[2 * q] * bf_lo(SRC[1][q]) + w2[2 * q] * bf_lo(SRC[2][q]); \
                const float c1 = bb[2 * q + 1] + w0[2 * q + 1] * bf_hi(SRC[0][q]) + w1[2 * q + 1] * bf_hi(SRC[1][q]) + w2[2 * q + 1] * bf_hi(SRC[2][q]); \
                o_[2 * q] = c0 * fast_sigmoid(c0); o_[2 * q + 1] = c1 * fast_sigmoid(c1); } \
            const f32x4 a0 = acc[ai_][bj_][m_][0], a1 = acc[ai_][bj_][m_][1]; \
            u32x4 w_; w_.x = cvt_pk_bf16(o_[0] * a0[0], o_[1] * a0[1]); w_.y = cvt_pk_bf16(o_[2] * a0[2], o_[3] * a0[3]); w_.z = cvt_pk_bf16(o_[4] * a1[0], o_[5] * a1[1]); w_.w = cvt_pk_bf16(o_[6] * a1[2], o_[7] * a1[3]); \
            *(u32x4*)(HID + tiled_off(row_, col_, DFF / 64)) = w_; } while (0)
#define EU_PARAMS(BJ) do { const int col_ = u.pn * BM + (BJ) * HALF + wc * 32 + 8 * fq; _Pragma("unroll") for (int h = 0; h < 2; ++h) { const f32x4 a = *(const f32x4*)(cw + col_ + 4 * h), b = *(const f32x4*)(cw + DFF + col_ + 4 * h), c = *(const f32x4*)(cw + 2 * DFF + col_ + 4 * h), d = *(const f32x4*)(cb + col_ + 4 * h); \
            _Pragma("unroll") for (int j = 0; j < 4; ++j) { w0[4 * h + j] = a[j]; w1[4 * h + j] = b[j]; w2[4 * h + j] = c[j]; bb[4 * h + j] = d[j]; } } } while (0)
#define EU_STEP2(B) do { EU_LOAD(gb, (B) + 1); asm volatile("" ::: "memory"); EU_COMP(ga, B); EU_LOAD(ga, (B) + 2); asm volatile("" ::: "memory"); EU_COMP(gb, (B) + 1); } while (0)
        float w0[8], w1[8], w2[8], bb[8];
        EU_LOAD(ga, 0); EU_PARAMS(0);
        EU_STEP2(0); EU_STEP2(2); EU_STEP2(4);
        EU_LOAD(gb, 7); asm volatile("" ::: "memory"); EU_COMP(ga, 6); EU_LOAD(ga, 8); asm volatile("" ::: "memory"); EU_COMP(gb, 7);
        EU_PARAMS(1);
        EU_STEP2(8); EU_STEP2(10); EU_STEP2(12);
        EU_LOAD(gb, 15); asm volatile("" ::: "memory"); EU_COMP(ga, 14); EU_COMP(gb, 15);
#undef EU_LOAD
#undef EU_COMP
#undef EU_PARAMS
#undef EU_STEP2
    }
};
template <int CTRL> __device__ __forceinline__ float dpp_upd(float old, float src) { return __int_as_float(__builtin_amdgcn_update_dpp(__float_as_int(old), __float_as_int(src), CTRL, 0xF, 0xF, false)); }
template <int CTRL> __device__ __forceinline__ float dpp_rot(float src) { return __int_as_float(__builtin_amdgcn_mov_dpp(__float_as_int(src), CTRL, 0xF, 0xF, true)); }
struct EpiFfn {
    static constexpr bool PERM = true; static constexpr bool PERMA = true;
    static constexpr int NPRE = 1;
    __device__ __forceinline__ void prefetch(LAS unsigned char* lds, const Unit& u, int wid, int lane) const { const int a = wid >> 1; const float* src = (a < 3 ? cw + (size_t)a * DFF : cb) + u.pn * HALF + (wid & 1) * 64 + lane;
        __builtin_amdgcn_global_load_lds((const unsigned*)src, (LAS unsigned*)(lds + PAR_OFF + wid * 256), 4, 0, 0); }
    bf16_t* HID; const float* cw; const float* cb; float* convp; float* gbnd; float* defc; float* defu; LAS float* scr;
    __device__ __forceinline__ void operator()(const Acc& acc, const Unit& u, int wr, int wc, int fr, int fq) const {
        const int ch0 = u.pn * HALF + wc * 32 + 8 * fq;
#pragma unroll
        for (int ai = 0; ai < 2; ++ai) { const int k = ai * 2 + wr;
            if (fr == 15) {
#pragma unroll
                for (int rr = 0; rr < 2; ++rr) {
                    if (k < 3) { LAS float* p = scr + ((((k * 4 + wc) * 4 + fq) * 2 + rr) * 8); *(LAS f32x4*)p = acc[ai][0][2 + rr][0]; *(LAS f32x4*)(p + 4) = acc[ai][0][2 + rr][1]; }
                    else { float* p = gbnd + (size_t)(u.pm * 2 + rr) * DFF + ch0; *(f32x4*)p = acc[ai][0][2 + rr][0]; *(f32x4*)(p + 4) = acc[ai][0][2 + rr][1];
                        if ((u.pm & 31) == 31) { float* cp = convp + (size_t)((u.pm >> 5) * 2 + rr) * DFF + ch0; *(f32x4*)cp = acc[ai][0][2 + rr][0]; *(f32x4*)(cp + 4) = acc[ai][0][2 + rr][1]; } } } } }
        float w0[8], w1[8], w2[8], bb[8];
        { const LAS float* par = (const LAS float*)((LAS unsigned char*)scr + 4096) + wc * 32 + 8 * fq;
#pragma unroll
        for (int h = 0; h < 2; ++h) { const f32x4 a = *(const LAS f32x4*)(par + 4 * h), b = *(const LAS f32x4*)(par + 128 + 4 * h), c = *(const LAS f32x4*)(par + 256 + 4 * h), d = *(const LAS f32x4*)(par + 384 + 4 * h);
#pragma unroll
            for (int j = 0; j < 4; ++j) { w0[4 * h + j] = -1.4426950408889634f * a[j]; w1[4 * h + j] = -1.4426950408889634f * b[j]; w2[4 * h + j] = -1.4426950408889634f * c[j]; bb[4 * h + j] = -1.4426950408889634f * d[j]; } } }
        asm volatile("s_waitcnt lgkmcnt(0)\n\ts_barrier" ::: "memory");
#pragma unroll
        for (int ai = 0; ai < 2; ++ai) { const int k = ai * 2 + wr;
            float bm1[8], bm2[8];
            if (k >= 1) { const LAS float* p = scr + ((((k - 1) * 4 + wc) * 4 + fq) * 2) * 8; const f32x4 a = *(const LAS f32x4*)p, b = *(const LAS f32x4*)(p + 4), c = *(const LAS f32x4*)(p + 8), d = *(const LAS f32x4*)(p + 12);
#pragma unroll
                for (int j = 0; j < 4; ++j) { bm2[j] = a[j]; bm2[4 + j] = b[j]; bm1[j] = c[j]; bm1[4 + j] = d[j]; } }
            else {
#pragma unroll
                for (int e = 0; e < 8; ++e) { bm1[e] = 0.f; bm2[e] = 0.f; } }
            float s3[8], s2[8];
#pragma unroll
            for (int n = 0; n < 2; ++n)
#pragma unroll
                for (int j = 0; j < 4; ++j) { const int e = 4 * n + j; s3[e] = dpp_upd<0x111>(bm1[e], acc[ai][0][3][n][j]); s2[e] = dpp_upd<0x111>(bm2[e], acc[ai][0][2][n][j]); }
#pragma unroll
            for (int m = 0; m < 4; ++m) { const int row = u.pm * BM + ai * HALF + wr * 64 + 4 * fr + m;
                float cc[8], o[8];
#pragma unroll
                for (int n = 0; n < 2; ++n)
#pragma unroll
                    for (int j = 0; j < 4; ++j) { const int e = 4 * n + j; const float g = acc[ai][0][m][n][j];
                        const float g1 = m == 0 ? s3[e] : acc[ai][0][m > 0 ? m - 1 : 0][n][j], g2 = m == 0 ? s2[e] : (m == 1 ? s3[e] : acc[ai][0][m > 1 ? m - 2 : 0][n][j]);
                        const float c = bb[e] + w0[e] * g2 + w1[e] * g1 + w2[e] * g; cc[e] = c; o[e] = c * __builtin_amdgcn_rcpf(1.0f + __builtin_amdgcn_exp2f(c)) * acc[ai][1][m][n][j]; }
                u32x4 w_; w_.x = cvt_pk_bf16(o[0], o[1]); w_.y = cvt_pk_bf16(o[2], o[3]); w_.z = cvt_pk_bf16(o[4], o[5]); w_.w = cvt_pk_bf16(o[6], o[7]);
                *(u32x4*)(HID + tiled_off(row, ch0, DFF / 64)) = w_;
                if (m < 2 && k == 0 && fr == 0) { float* pc = defc + (size_t)(u.pm * 2 + m) * DFF + ch0; float* pu = defu + (size_t)(u.pm * 2 + m) * DFF + ch0;
                    *(f32x4*)pc = (f32x4){cc[0], cc[1], cc[2], cc[3]}; *(f32x4*)(pc + 4) = (f32x4){cc[4], cc[5], cc[6], cc[7]}; *(f32x4*)pu = acc[ai][1][m][0]; *(f32x4*)(pu + 4) = acc[ai][1][m][1]; } }
        }
    }
};
struct EpiPartial {
    static constexpr int NPRE = 0; static constexpr bool PERMA = false;
    static constexpr bool PERM = false;
    float* P; int ldc;
    __device__ __forceinline__ void operator()(const Acc& acc, const Unit& u, int wr, int wc, int fr, int fq) const {
        const int row0 = (u.pm - 128) * BM + wr * 64 + fr, col0 = u.pn * BM + wc * 32 + 4 * fq;
        float* base = P + ((size_t)u.ks * 512 + row0) * ldc + col0;
#pragma unroll
        for (int ai = 0; ai < 2; ++ai)
#pragma unroll
            for (int m = 0; m < 4; ++m) { float* rowp = base + (size_t)(ai * HALF + m * 16) * ldc;
#pragma unroll
                for (int bj = 0; bj < 2; ++bj)
#pragma unroll
                    for (int n = 0; n < 2; ++n) *(f32x4*)(rowp + bj * HALF + n * 16) = acc[ai][bj][m][n]; }
    }
};
struct EpiXloc {
    static constexpr int NPRE = 0; static constexpr bool PERMA = false;
    static constexpr bool PERM = true;
    bf16_t* X;
    __device__ __forceinline__ void operator()(const Acc& acc, const Unit& u, int wr, int wc, int fr, int fq) const {
        const int row0 = u.pm * BM + wr * 64 + fr, col0 = wc * 32 + 8 * fq;
#pragma unroll
        for (int ai = 0; ai < 2; ++ai)
#pragma unroll
            for (int m = 0; m < 4; ++m) *(u32x4*)(X + (size_t)(row0 + ai * HALF + m * 16) * 128 + col0) = pack8(acc[ai][0][m][0], acc[ai][0][m][1]);
    }
};
struct EpiY {
    static constexpr int NPRE = 0; static constexpr bool PERMA = false;
    static constexpr bool PERM = true;
    const bf16_t* UP; bf16_t* Z; const float* Dv;
    __device__ __forceinline__ void operator()(const Acc& acc, const Unit& u, int wr, int wc, int fr, int fq) const {
        const int g = u.pn, cbase = (u.pm - 9 * g) * BM;
        const int q0 = (8 * fq) & 15;
        const f32x4 d0 = *(const f32x4*)(Dv + 16 * g + q0), d1 = *(const f32x4*)(Dv + 16 * g + q0 + 4);
#pragma unroll
        for (int ai = 0; ai < 2; ++ai) {
            const int c0 = cbase + ai * HALF + wr * 64 + fr;
            u32x4 uq[4][2];
#pragma unroll
            for (int m = 0; m < 4; ++m) { const int c = c0 + m * 16 < 2080 ? c0 + m * 16 : 2079;
#pragma unroll
                for (int bj = 0; bj < 2; ++bj) uq[m][bj] = *(const u32x4*)(UP + ((size_t)g * NSUB + c) * 384 + bj * HALF + wc * 32 + 8 * fq); }
#pragma unroll
            for (int m = 0; m < 4; ++m) { const int c = c0 + m * 16;
                if (c < 2080) {
#pragma unroll
                    for (int bj = 0; bj < 2; ++bj) { const int cc = bj * HALF + wc * 32 + 8 * fq; const int t = cc >> 4;
                        const u32x4 uu = uq[m][bj];
                        const f32x4 a0 = acc[ai][bj][m][0], a1 = acc[ai][bj][m][1];
                        float y[8];
                        y[0] = a0[0] + d0[0] * bf_lo(uu[0]); y[1] = a0[1] + d0[1] * bf_hi(uu[0]); y[2] = a0[2] + d0[2] * bf_lo(uu[1]); y[3] = a0[3] + d0[3] * bf_hi(uu[1]);
                        y[4] = a1[0] + d1[0] * bf_lo(uu[2]); y[5] = a1[1] + d1[1] * bf_hi(uu[2]); y[6] = a1[2] + d1[2] * bf_lo(uu[3]); y[7] = a1[3] + d1[3] * bf_hi(uu[3]);
#pragma unroll
                        for (int j = 0; j < 8; ++j) { const float v = y[j]; const float w2 = v * (-2.3022081983f + -0.1029432395f * (v * v)); y[j] = v * __builtin_amdgcn_rcpf(1.0f + __builtin_amdgcn_exp2f(w2)); }
                        u32x4 w; w.x = cvt_pk_bf16(y[0], y[1]); w.y = cvt_pk_bf16(y[2], y[3]); w.z = cvt_pk_bf16(y[4], y[5]); w.w = cvt_pk_bf16(y[6], y[7]);
                        *(u32x4*)(Z + (size_t)(16 * c + t) * DM + 16 * g + q0) = w; }
                } }
            asm volatile("" ::: "memory");
        }
    }
};
}

namespace att {
constexpr int SHM_V = 64 * 128 * 2, SHM_K = 64 * 384, OFF_V = 0, OFF_K = 3 * SHM_V, OFF_SCR = OFF_K + 3 * SHM_K, ATT_LDS = OFF_SCR + 8 * 256;
static_assert(ATT_LDS <= 131072, "attention LDS");
constexpr float THR2 = 11.54f;
#define SBAR() __builtin_amdgcn_sched_barrier(0)
__device__ __forceinline__ int crow(int r, int hi) { return (r & 3) + 8 * (r >> 2) + 4 * hi; }
__device__ __forceinline__ int kswz(int row, int c16) { return row * 384 + ((c16 ^ ((row >> 1) & 7)) << 4); }
template <bool FX> __device__ __forceinline__ void partialSM(f32x16& p0, f32x16& p1, float& m_reg, float& mn, float& alpha, bool vis) {
  if (!vis) {
#pragma unroll
    for (int r = 0; r < 16; ++r) { p0[r] = -__builtin_inff(); p1[r] = -__builtin_inff(); } }
  if constexpr (FX) { mn = 0.f; alpha = 1.f;
#pragma unroll
    for (int r = 0; r < 16; ++r) p0[r] = __builtin_amdgcn_exp2f(p0[r]);
    return; }
  float pmax = p0[0];
#pragma unroll
  for (int r = 1; r < 16; ++r) pmax = fmaxf(pmax, p0[r]);
#pragma unroll
  for (int r = 0; r < 16; ++r) pmax = fmaxf(pmax, p1[r]);
  { auto rr = __builtin_amdgcn_permlane32_swap(__float_as_uint(pmax), __float_as_uint(pmax), false, false);
    pmax = fmaxf(__uint_as_float(rr[0]), __uint_as_float(rr[1])); }
  if (__builtin_expect(__all(pmax - m_reg <= THR2), 1)) { mn = m_reg; alpha = 1.f; }
  else { mn = fmaxf(m_reg, pmax); alpha = __builtin_amdgcn_exp2f(m_reg - mn); m_reg = mn; }
#pragma unroll
  for (int r = 0; r < 16; ++r) p0[r] = __builtin_amdgcn_exp2f(p0[r] - mn);
#pragma unroll
  for (int r = 0; r < 16; ++r) p1[r] = p1[r] - mn;
}
__device__ __forceinline__ void finishSM(f32x16& p0, f32x16& p1, float alpha, float& l_reg, bf16x8& pa0, bf16x8& pa1, bf16x8& pa2, bf16x8& pa3) {
#pragma unroll
  for (int r = 0; r < 16; ++r) p1[r] = __builtin_amdgcn_exp2f(p1[r]);
  float ps = 0;
#pragma unroll
  for (int r = 0; r < 16; ++r) ps += p0[r];
#pragma unroll
  for (int r = 0; r < 16; ++r) ps += p1[r];
  { auto rr = __builtin_amdgcn_permlane32_swap(__float_as_uint(ps), __float_as_uint(ps), false, false);
    ps = __uint_as_float(rr[0]) + __uint_as_float(rr[1]); }
  l_reg = l_reg * alpha + ps;
#define PK4(P, BASE, OUT) do { unsigned a0 = cvt_pk_bf16(P[BASE + 0], P[BASE + 1]), a1 = cvt_pk_bf16(P[BASE + 2], P[BASE + 3]);   \
    unsigned b0 = cvt_pk_bf16(P[BASE + 4], P[BASE + 5]), b1 = cvt_pk_bf16(P[BASE + 6], P[BASE + 7]);                              \
    auto r0 = __builtin_amdgcn_permlane32_swap(a0, b0, false, false); auto r1 = __builtin_amdgcn_permlane32_swap(a1, b1, false, false); \
    u32x4 w = {r0[0], r1[0], r0[1], r1[1]}; OUT = *reinterpret_cast<bf16x8*>(&w); } while (0)
  PK4(p0, 0, pa0); PK4(p0, 8, pa1); PK4(p1, 0, pa2); PK4(p1, 8, pa3);
#undef PK4
}
__device__ __forceinline__ void qkt(f32x16& p0, f32x16& p1, const bf16x8* qr, const int* kb, int so) {
  p0 = f32x16{}; p1 = f32x16{};
  const int k0 = kb[0] + so, k1 = kb[1] + so, k2 = kb[2] + so, k3 = kb[3] + so;
  bf16x8 fa[4], fb[4];
#define KADDR(d0) (((d0) & 3) == 0 ? k0 : ((d0) & 3) == 1 ? k1 : ((d0) & 3) == 2 ? k2 : k3)
#define LOADK(F, d0) do { F[0] = *(const LAS bf16x8*)(uintptr_t)(unsigned)(KADDR(d0) + ((d0) >> 2) * 128); F[1] = *(const LAS bf16x8*)(uintptr_t)(unsigned)(KADDR(d0) + ((d0) >> 2) * 128 + 32 * 384); \
    F[2] = *(const LAS bf16x8*)(uintptr_t)(unsigned)(KADDR((d0) + 1) + (((d0) + 1) >> 2) * 128); F[3] = *(const LAS bf16x8*)(uintptr_t)(unsigned)(KADDR((d0) + 1) + (((d0) + 1) >> 2) * 128 + 32 * 384); } while (0)
#define MMAK(F, d0) do { p0 = __builtin_amdgcn_mfma_f32_32x32x16_bf16(F[0], qr[d0], p0, 0, 0, 0); p1 = __builtin_amdgcn_mfma_f32_32x32x16_bf16(F[1], qr[d0], p1, 0, 0, 0); \
    p0 = __builtin_amdgcn_mfma_f32_32x32x16_bf16(F[2], qr[(d0) + 1], p0, 0, 0, 0); p1 = __builtin_amdgcn_mfma_f32_32x32x16_bf16(F[3], qr[(d0) + 1], p1, 0, 0, 0); } while (0)
  LOADK(fa, 0); SBAR(); LOADK(fb, 2); SBAR();
  MMAK(fa, 0); SBAR(); LOADK(fa, 4); SBAR();
  MMAK(fb, 2); SBAR(); LOADK(fb, 6); SBAR();
  MMAK(fa, 4); SBAR(); LOADK(fa, 8); SBAR();
  MMAK(fb, 6); SBAR(); LOADK(fb, 10); SBAR();
  MMAK(fa, 8); SBAR();
  MMAK(fb, 10); SBAR();
#undef KADDR
#undef LOADK
#undef MMAK
}
__device__ __forceinline__ int v_st(int k, int c) { const int kk = (k & ~0xC) | ((k & 4) << 1) | ((k & 8) >> 1); return ((kk >> 3) * 4 + (c >> 5)) * 512 + ((kk & 7) * 32 + (c & 31)) * 2; }
__device__ __forceinline__ int v_rd_base(int lane) { return ((lane & 3) << 3) | (((lane >> 2) & 3) << 6) | (((lane >> 4) & 1) << 5) | (((lane >> 5) & 1) << 8); }
constexpr int v_rd_off(int d0, int ks, int half) { return d0 * 512 + ks * 4096 + half * 2048; }
typedef short v4i16_t __attribute__((ext_vector_type(4)));
template <int OFF> __device__ __forceinline__ s16x4 tr_read(int vb) {
  return __builtin_bit_cast(s16x4, __builtin_amdgcn_ds_read_tr16_b64_v4i16((LAS v4i16_t*)(uintptr_t)(unsigned)(vb + OFF)));
}
template <int D0> __device__ __forceinline__ void pv_load(s16x4* f, int vb) {
  f[0] = tr_read<v_rd_off(D0, 0, 0)>(vb); f[1] = tr_read<v_rd_off(D0, 0, 1)>(vb); f[2] = tr_read<v_rd_off(D0, 1, 0)>(vb); f[3] = tr_read<v_rd_off(D0, 1, 1)>(vb);
  f[4] = tr_read<v_rd_off(D0, 2, 0)>(vb); f[5] = tr_read<v_rd_off(D0, 2, 1)>(vb); f[6] = tr_read<v_rd_off(D0, 3, 0)>(vb); f[7] = tr_read<v_rd_off(D0, 3, 1)>(vb);
}
__device__ __forceinline__ void pv_mma(f32x16& od, const s16x4* f, bf16x8 pa0, bf16x8 pa1, bf16x8 pa2, bf16x8 pa3) {
#define PK(L, H) (bf16x8){L[0], L[1], L[2], L[3], H[0], H[1], H[2], H[3]}
  od = __builtin_amdgcn_mfma_f32_32x32x16_bf16(pa0, PK(f[0], f[1]), od, 0, 0, 0);
  od = __builtin_amdgcn_mfma_f32_32x32x16_bf16(pa1, PK(f[2], f[3]), od, 0, 0, 0);
  od = __builtin_amdgcn_mfma_f32_32x32x16_bf16(pa2, PK(f[4], f[5]), od, 0, 0, 0);
  od = __builtin_amdgcn_mfma_f32_32x32x16_bf16(pa3, PK(f[6], f[7]), od, 0, 0, 0);
#undef PK
}
__device__ __forceinline__ void pv_d0(f32x16* o, int vb, bf16x8 pa0, bf16x8 pa1, bf16x8 pa2, bf16x8 pa3) {
  s16x4 va[8], vbf[8];
  pv_load<0>(va, vb); SBAR(); pv_load<1>(vbf, vb); SBAR();
  pv_mma(o[0], va, pa0, pa1, pa2, pa3); SBAR(); pv_load<2>(va, vb); SBAR();
  pv_mma(o[1], vbf, pa0, pa1, pa2, pa3); SBAR(); pv_load<3>(vbf, vb); SBAR();
  pv_mma(o[2], va, pa0, pa1, pa2, pa3); SBAR();
  pv_mma(o[3], vbf, pa0, pa1, pa2, pa3); SBAR();
}
__device__ __forceinline__ int k_src(int s) { const int row = s / 24, cp = s - row * 24, c = cp ^ ((row >> 1) & 7); return row * 5120 + c * 8; }
__device__ __forceinline__ int v_src(int s) { const int sub = s >> 5, w = s & 31, kk = (sub >> 2) * 8 + (w >> 2), c = (sub & 3) * 32 + (w & 3) * 8; const int k = (kk & ~0xC) | ((kk & 4) << 1) | ((kk & 8) >> 1); return k * 5120 + c; }
template <bool FX> __device__ __forceinline__ void attn_unit(const bf16_t* __restrict__ Qb, const bf16_t* __restrict__ Kh, const bf16_t* __restrict__ Vh, bf16_t* __restrict__ Ob,
                                          int NT, int NTreal, int nvis, int wq, int rev, LAS char* lds, const int tid, const float* __restrict__ gqn, const float* __restrict__ rope, int pos0) {
  int lane_ = tid & 63; asm volatile("" : "+v"(lane_));
  const int wid = __builtin_amdgcn_readfirstlane(tid >> 6), lane = lane_, r32 = lane & 31, hi = lane >> 5, grp = wid >> 2;
  LAS char* V_lds = lds + OFF_V; LAS char* K_lds = lds + OFF_K;
  LAS float* ws = (LAS float*)(lds + OFF_SCR) + wid * 64; LAS float* li_l = ws; LAS float* al_l = ws + 32;
  float m_reg = -1e30f, l_reg = 0; f32x16 o[4] = {}; bf16x8 qr[12];
  const bf16_t* Qw = Qb + (size_t)(wq * 32 + r32) * 3072 + hi * 8;
  {
    u32x4 raw[12];
#pragma unroll
    for (int d0 = 0; d0 < 12; ++d0) raw[d0] = *(const u32x4*)(Qw + d0 * 16);
    float ss = 0.f;
#pragma unroll
    for (int d0 = 0; d0 < 12; ++d0)
#pragma unroll
      for (int e = 0; e < 4; ++e) { const float a = bf_lo(raw[d0][e]), b = bf_hi(raw[d0][e]); ss += a * a + b * b; }
    { auto rr = __builtin_amdgcn_permlane32_swap(__float_as_uint(ss), __float_as_uint(ss), false, false); ss = __uint_as_float(rr[0]) + __uint_as_float(rr[1]); }
    const float rq = (1.0f / sqrtf(ss * (1.0f / 192.0f) + EPS)) * (0.07216878364870323f * 1.4426950408889634f);
#pragma unroll
    for (int d0 = 0; d0 < 8; ++d0) { const f32x4 g0 = *(const f32x4*)(gqn + d0 * 16 + hi * 8), g1 = *(const f32x4*)(gqn + d0 * 16 + hi * 8 + 4); u32x4 w;
      w.x = cvt_pk_bf16(bf_lo(raw[d0][0]) * rq * g0[0], bf_hi(raw[d0][0]) * rq * g0[1]); w.y = cvt_pk_bf16(bf_lo(raw[d0][1]) * rq * g0[2], bf_hi(raw[d0][1]) * rq * g0[3]);
      w.z = cvt_pk_bf16(bf_lo(raw[d0][2]) * rq * g1[0], bf_hi(raw[d0][2]) * rq * g1[1]); w.w = cvt_pk_bf16(bf_lo(raw[d0][3]) * rq * g1[2], bf_hi(raw[d0][3]) * rq * g1[3]);
      qr[d0] = *reinterpret_cast<bf16x8*>(&w); }
    const float* rt = rope + (size_t)(pos0 + wq * 32 + r32) * 64;
#pragma unroll
    for (int dd = 0; dd < 2; ++dd) {
      u32x4 w1, w2;
#pragma unroll
      for (int e2 = 0; e2 < 4; ++e2) { const int j = 16 * dd + 8 * hi + 2 * e2;
        const f32x4 cs = *(const f32x4*)(rt + 2 * j);
        const f32x2 ga = *(const f32x2*)(gqn + 128 + j), gb = *(const f32x2*)(gqn + 160 + j);
        const float x10 = bf_lo(raw[8 + dd][e2]) * rq * ga.x, x11 = bf_hi(raw[8 + dd][e2]) * rq * ga.y, x20 = bf_lo(raw[10 + dd][e2]) * rq * gb.x, x21 = bf_hi(raw[10 + dd][e2]) * rq * gb.y;
        w1[e2] = cvt_pk_bf16(x10 * cs[0] - x20 * cs[1], x11 * cs[2] - x21 * cs[3]);
        w2[e2] = cvt_pk_bf16(x10 * cs[1] + x20 * cs[0], x11 * cs[3] + x21 * cs[2]); }
      qr[8 + dd] = *reinterpret_cast<bf16x8*>(&w1); qr[10 + dd] = *reinterpret_cast<bf16x8*>(&w2); }
  }
  int kb[4];
#pragma unroll
  for (int v = 0; v < 4; ++v) kb[v] = (int)(uintptr_t)K_lds + r32 * 384 + ((((2 * v) | hi) ^ ((r32 >> 1) & 7)) << 4);
  unsigned kg[3], vg[2];
#pragma unroll
  for (int i = 0; i < 3; ++i) kg[i] = (unsigned)k_src((wid * 3 + i) * 64 + lane) * 2u;
#pragma unroll
  for (int i = 0; i < 2; ++i) vg[i] = (unsigned)v_src((wid * 2 + i) * 64 + lane) * 2u;
  const int vb0 = (int)(uintptr_t)V_lds + v_rd_base(lane);
#define DMA(jt, st) do { const int _p = rev ? NT - 1 - (jt) : (jt); const int _t = _p < NTreal ? _p : NTreal - 1; const char* _k = (const char*)(Kh + (size_t)_t * 64 * 5120); const char* _v = (const char*)(Vh + (size_t)_t * 64 * 5120); \
    _Pragma("unroll") for (int _i = 0; _i < 3; ++_i) __builtin_amdgcn_global_load_lds((const unsigned*)(_k + kg[_i]), (LAS unsigned*)(K_lds + (st) * SHM_K + (wid * 3 + _i) * 1024), 16, 0, 0); \
    _Pragma("unroll") for (int _i = 0; _i < 2; ++_i) __builtin_amdgcn_global_load_lds((const unsigned*)(_v + vg[_i]), (LAS unsigned*)(V_lds + (st) * SHM_V + (wid * 2 + _i) * 1024), 16, 0, 0); } while (0)
#define WAITBAR(N) asm volatile("s_waitcnt vmcnt(" #N ")\n\ts_barrier" ::: "memory")
#define RESC(a) do { if constexpr (!FX) if (__any((a) < 1.f)) { if (hi == 0) al_l[r32] = (a); asm volatile("s_waitcnt lgkmcnt(0)" ::: "memory"); \
    _Pragma("unroll") for (int d = 0; d < 4; ++d) _Pragma("unroll") for (int r = 0; r < 16; ++r) o[d][r] *= al_l[crow(r, hi)]; } } while (0)
#define VIS(j) ((rev ? NT - 1 - (j) : (j)) < nvis)
  if (grp) __builtin_amdgcn_s_setprio(1);
  f32x16 pA0, pA1, pB0, pB1; float mnA, mnB, alA, alB; bf16x8 pa0, pa1, pa2, pa3;
  int sp = 0, sc = 1, sn = 2;
  DMA(0, 0); DMA(1, 1);
  WAITBAR(5);
  if (VIS(0)) qkt(pA0, pA1, qr, kb, 0);
  partialSM<FX>(pA0, pA1, m_reg, mnA, alA, VIS(0));
  for (int j = 1; j + 1 < NT; j += 2) {
    WAITBAR(0);
    DMA(j + 1, sn);
    SBAR(); if (VIS(j)) qkt(pB0, pB1, qr, kb, sc * SHM_K);
    finishSM(pA0, pA1, alA, l_reg, pa0, pa1, pa2, pa3); SBAR();
    if (VIS(j - 1)) pv_d0(o, vb0 + sp * SHM_V, pa0, pa1, pa2, pa3);
    partialSM<FX>(pB0, pB1, m_reg, mnB, alB, VIS(j));
    RESC(alB);
    { const int t = sp; sp = sc; sc = sn; sn = t; }
    WAITBAR(0);
    DMA(j + 2, sn);
    SBAR(); if (VIS(j + 1)) qkt(pA0, pA1, qr, kb, sc * SHM_K);
    finishSM(pB0, pB1, alB, l_reg, pa0, pa1, pa2, pa3); SBAR();
    if (VIS(j)) pv_d0(o, vb0 + sp * SHM_V, pa0, pa1, pa2, pa3);
    partialSM<FX>(pA0, pA1, m_reg, mnA, alA, VIS(j + 1));
    RESC(alA);
    { const int t = sp; sp = sc; sc = sn; sn = t; }
  }
  WAITBAR(0);
  SBAR(); if (VIS(NT - 1)) qkt(pB0, pB1, qr, kb, sc * SHM_K);
  finishSM(pA0, pA1, alA, l_reg, pa0, pa1, pa2, pa3); SBAR();
  if (VIS(NT - 2)) pv_d0(o, vb0 + sp * SHM_V, pa0, pa1, pa2, pa3);
  partialSM<FX>(pB0, pB1, m_reg, mnB, alB, VIS(NT - 1));
  RESC(alB);
  finishSM(pB0, pB1, alB, l_reg, pa0, pa1, pa2, pa3); SBAR();
  if (VIS(NT - 1)) pv_d0(o, vb0 + sc * SHM_V, pa0, pa1, pa2, pa3);
  if (nvis > 0) {
    if (hi == 0) li_l[r32] = l_reg; asm volatile("s_waitcnt lgkmcnt(0)" ::: "memory");
    bf16_t* Ow = Ob + (size_t)(wq * 32) * 2048;
    const bool odd = (lane & 1) != 0;
#pragma unroll
    for (int r = 0; r < 16; r += 2) {
      const float ra = __builtin_amdgcn_rcpf(li_l[crow(r, hi)]), rb = __builtin_amdgcn_rcpf(li_l[crow(r + 1, hi)]);
      const int orow = odd ? crow(r + 1, hi) : crow(r, hi);
#pragma unroll
      for (int d0 = 0; d0 < 4; ++d0) {
        const float e = o[d0][r] * ra, f = o[d0][r + 1] * rb;
        const float keep = odd ? f : e, send = odd ? e : f;
        const float got = __int_as_float(__builtin_amdgcn_mov_dpp(__float_as_int(send), 0xB1, 0xF, 0xF, true));
        const unsigned w = odd ? cvt_pk_bf16(got, keep) : cvt_pk_bf16(keep, got);
        *(unsigned*)(Ow + (size_t)orow * 2048 + d0 * 32 + (r32 & ~1)) = w; } }
  }
  __builtin_amdgcn_s_setprio(0);
  asm volatile("s_waitcnt lgkmcnt(0)\n\ts_barrier" ::: "memory");
#undef DMA
#undef VIS
#undef WAITBAR
#undef RESC
}
}

#define XB_TMO      128
#define XB_XCNT(j)  (256  + 64 * (j))
#define XB_XSUB(j)  (1280 + 64 * (j))
#define XB_XGEN(j)  (2304 + 64 * (j))
#define XB_TOP      3328
#define XB_TOPGEN   3392
#define XCD_BAR_WORDS 3456
#define XB_SPIN_CAP (1u << 18)
__device__ __forceinline__ unsigned xb_ld(unsigned* p)              { return __hip_atomic_load(p, __ATOMIC_RELAXED, __HIP_MEMORY_SCOPE_AGENT); }
__device__ __forceinline__ unsigned xb_add(unsigned* p, unsigned v) { return __hip_atomic_fetch_add(p, v, __ATOMIC_RELAXED, __HIP_MEMORY_SCOPE_AGENT); }
__device__ __forceinline__ unsigned xb_xcc_id() { return (unsigned)__builtin_amdgcn_s_getreg((3 << 11) | 20) & 0xFu; }
#define XB_SPIN(cond, bar) do { unsigned _sp = 0; while (cond) { __builtin_amdgcn_s_sleep(1); \
    if ((++_sp & 255u) == 0u) { if (xb_ld(&(bar)[XB_TMO])) break; if (_sp > XB_SPIN_CAP) { atomicAdd(&(bar)[XB_TMO], 1u); break; } } } } while (0)
struct XcdBarrier { unsigned* bar; unsigned x; volatile LAS unsigned* st; };
__device__ __forceinline__ XcdBarrier xcd_barrier_post(unsigned* bar, volatile LAS unsigned* st) {
    XcdBarrier b; b.bar = bar; b.x = xb_xcc_id(); b.st = st;
    if (threadIdx.x == 0) (void)xb_add(&bar[XB_XCNT(b.x)], 1u);
    return b;
}
__device__ __forceinline__ void xcd_barrier_complete(unsigned* bar, unsigned x, unsigned& nloc, unsigned& nx) {
    const unsigned G = gridDim.x * gridDim.y * gridDim.z;
    unsigned sum, cnt, mine, sp = 0u;
    for (;;) {
        sum = 0u; cnt = 0u; mine = 0u;
#pragma unroll
        for (unsigned j = 0; j < 16; ++j) { const unsigned c = xb_ld(&bar[XB_XCNT(j)]); sum += c; cnt += (c > 0u) ? 1u : 0u; mine = (j == x) ? c : mine; }
        if (sum == G) break;
        __builtin_amdgcn_s_sleep(1);
        if ((++sp & 255u) == 0u) { if (xb_ld(&bar[XB_TMO])) break; if (sp > XB_SPIN_CAP) { atomicAdd(&bar[XB_TMO], 1u); break; } }
    }
    nloc = mine > 0u ? mine : 1u; nx = cnt > 0u ? cnt : 1u;
}
__device__ __forceinline__ void xcd_barrier(const XcdBarrier& b, const int tid) {
    asm volatile("s_waitcnt vmcnt(0)" ::: "memory");
    __syncthreads();
    if (tid == 0) {
        unsigned* bar = b.bar; asm volatile("" : "+s"(bar));
        __builtin_amdgcn_s_waitcnt(0);
        unsigned nloc = b.st[0], nx = b.st[1];
        if (nloc == 0u) { xcd_barrier_complete(bar, b.x, nloc, nx); b.st[0] = nloc; b.st[1] = nx; }
        const unsigned old = xb_add(&bar[XB_XSUB(b.x)], 1u);
        const unsigned gen = old / nloc;
        if (old + 1u == (gen + 1u) * nloc) {
            __builtin_amdgcn_fence(__ATOMIC_RELEASE, "agent");
            asm volatile("s_waitcnt vmcnt(0)" ::: "memory");
            const unsigned og = xb_add(&bar[XB_TOP], 1u);
            const unsigned tg = og / nx;
            if (og + 1u == (tg + 1u) * nx) xb_add(&bar[XB_TOPGEN], 1u);
            else XB_SPIN(xb_ld(&bar[XB_TOPGEN]) == tg, bar);
            __builtin_amdgcn_fence(__ATOMIC_ACQUIRE, "agent");
            xb_add(&bar[XB_XGEN(b.x)], 1u);
            asm volatile("s_waitcnt vmcnt(0)" ::: "memory");
        } else {
            XB_SPIN(xb_ld(&bar[XB_XGEN(b.x)]) == gen, bar);
            __builtin_amdgcn_fence(__ATOMIC_ACQUIRE, "agent");
            asm volatile("s_waitcnt vmcnt(0)" ::: "memory");
        }
    }
    __syncthreads();
}

struct Args { const float* in[37]; float* out; unsigned char* ws; int ph_lo, ph_hi; };
enum { I_XP = 0, I_XS, I_CCKV, I_CKR, I_SRE, I_SIM, I_CCONV, I_CP, I_CS, I_WMOD, I_BMOD, I_GMIX, I_GFFN, I_WDQ, I_GQA, I_WUQ, I_GQN, I_WDKV, I_GKVA, I_WUKV, I_GKN, I_WO,
       I_ARE, I_AIM, I_LDT, I_BRE, I_BIM, I_CRE, I_CIM, I_SD, I_WGLU, I_WSG, I_FG, I_FU, I_FCW, I_FCB, I_FD };

__device__ const double ROPE_INV[32] = {
 1.0, 0.7498942093324559, 0.5623413251903491, 0.4216965034285822, 0.31622776601683794, 0.23713737056616552, 0.1778279410038923, 0.1333521432163324,
 0.1, 0.07498942093324558, 0.05623413251903491, 0.04216965034285822, 0.03162277660168379, 0.023713737056616554, 0.01778279410038923, 0.01333521432163324,
 0.01, 0.007498942093324558, 0.005623413251903491, 0.004216965034285823, 0.0031622776601683794, 0.0023713737056616554, 0.0017782794100389228, 0.001333521432163324,
 0.001, 0.0007498942093324559, 0.0005623413251903491, 0.0004216965034285823, 0.00031622776601683794, 0.00023713737056616554, 0.00017782794100389227, 0.0001333521432163324 };
__device__ __forceinline__ void sincos_red(double a, float& s, float& c) {
    const double k = __builtin_rint(a * 0.15915494309189535);
    const float r = (float)__builtin_fma(-k, 6.283185307179586, a);
    s = __sinf(r); c = __cosf(r);
}

__device__ __forceinline__ void transpose_item(const float* W, int K, int N, bf16_t* WT, int row_off, int mode, LAS float* scr, int item, int lane, const float sc = 1.0f, const float* ksc = nullptr) {
    const int nblk = N / 32, kb = item / nblk, nb = item - kb * nblk, k0 = 64 * kb, n0 = 32 * nb;
#pragma unroll 8
    for (int i = 0; i < 32; ++i) { const int kk = 2 * i + (lane >> 5); scr[kk * 33 + (lane & 31)] = W[(size_t)(k0 + kk) * N + n0 + (lane & 31)] * (ksc ? ksc[k0 + kk] : 1.0f); }
    LDS_WAIT(); asm volatile("" ::: "memory");
    const int c = lane & 7;
#pragma unroll
    for (int j = 0; j < 4; ++j) { const int n = (lane >> 3) + 8 * j; const LAS float* s = scr + (8 * c) * 33 + n;
        u32x4 o; o.x = cvt_pk_bf16(sc * s[0 * 33], sc * s[1 * 33]); o.y = cvt_pk_bf16(sc * s[2 * 33], sc * s[3 * 33]); o.z = cvt_pk_bf16(sc * s[4 * 33], sc * s[5 * 33]); o.w = cvt_pk_bf16(sc * s[6 * 33], sc * s[7 * 33]);
        const int nn = n0 + n; const int drow = mode == 0 ? row_off + nn : ((nn >> 7) * 256 + (nn & 127) + (mode == 2 ? 128 : 0));
        if (mode == 3) *(u32x4*)(WT + pg8::tiled_off(nn, k0 + 8 * c, K / 64)) = o;
        else *(u32x4*)(WT + (size_t)drow * K + k0 + 8 * c) = o; }
    LDS_WAIT(); asm volatile("" ::: "memory");
}

__global__ void __launch_bounds__(NWAVES * 64, 2) fwd_kernel(Args args) {
    extern __shared__ __attribute__((aligned(16))) unsigned char lds_raw[];
    LAS unsigned char* lds = (LAS unsigned char*)lds_raw;
    volatile LAS unsigned* MISC = (volatile LAS unsigned*)(lds + MISC_OFF);
    const int tid0 = threadIdx.x; const int wave0 = __builtin_amdgcn_readfirstlane(tid0 >> 6);
    const int G = gridDim.x; const int bx = blockIdx.x; const int vcu = (G % 8 == 0) ? (bx % 8) * (G / 8) + bx / 8 : bx;
    const int NGW = G * NWAVES;
    unsigned char* ws0 = args.ws; float* out0 = args.out;
    unsigned* ctl = (unsigned*)(ws0 + WS_CTL);
    for (int u = tid0; u < 64; u += NWAVES * 64) ((LAS unsigned*)(lds + MISC_OFF))[u] = 0u;
    __syncthreads();
    XcdBarrier bar; bar.bar = ctl + 1024; bar.x = 0; bar.st = nullptr;
    if (!MK_PER_PHASE) bar = xcd_barrier_post(ctl + 1024, MISC + 8);
    const int lo = args.ph_lo, hi = args.ph_hi;
    int ph = 0;
#define PH_BEGIN if (lo <= ph && ph < hi) { int tid; asm volatile("v_mbcnt_lo_u32_b32 %0, -1, 0\n\tv_mbcnt_hi_u32_b32 %0, -1, %0" : "=v"(tid)); tid |= wave0 << 6; \
    const int lane = tid & 63, wave = __builtin_amdgcn_readfirstlane(tid >> 6), gw = vcu * NWAVES + wave; (void)lane; (void)gw; \
    __attribute__((address_space(1))) unsigned char* wsg_; __attribute__((address_space(1))) float* outg_; asm volatile("s_mov_b64 %0, %1" : "=s"(wsg_) : "s"(ws0)); asm volatile("s_mov_b64 %0, %1" : "=s"(outg_) : "s"(out0)); unsigned char* ws = (unsigned char*)wsg_; float* out = (float*)outg_; (void)ws; (void)out;
#define PH_END if (ph + 1 < hi) xcd_barrier(bar, tid); } ++ph;

#define MOD ((float*)(ws + WS_MOD))
#define A16 ((float*)(ws + WS_A16))
#define KRSS ((float*)(ws + WS_KRSS))
#define ROPE ((float*)(ws + WS_ROPE))
#define Hb ((bf16_t*)(ws + WS_H))
#define QA ((bf16_t*)((unsigned char*)out + OY_QA))
#define CKV ((bf16_t*)((unsigned char*)out + OY_CKV))
#define Rr ((float*)((unsigned char*)out + OY_R))
#define STATQ ((float*)((unsigned char*)out + OY_STATQ))
#define RSTDQ ((float*)((unsigned char*)out + OY_RSTDQ))
#define XBs ((bf16_t*)(ws + WS_XB))
#define Qb ((bf16_t*)(ws + WS_Q))
#define KB ((bf16_t*)(ws + WS_KB))
#define QKVA ((float*)(ws + WS_QKVA))
#define Gb ((bf16_t*)(ws + WS_G))
#define HID ((bf16_t*)(ws + WS_HID))
#define GBND ((float*)(ws + WS_G))
#define DEFC ((float*)(ws + WS_G + 8 * MiB))
#define DEFU ((float*)(ws + WS_G + 16 * MiB))
#define UP ((bf16_t*)(ws + WS_UP))
#define XLOC ((bf16_t*)(ws + WS_XLOC))
#define PART ((float*)(ws + WS_PART))
#define PGU ((float*)(ws + WS_PGU))

    PH_BEGIN
#ifndef NO_P0
    {
        for (int it = vcu; it < 4 * 64; it += G) {
            const int l = it >> 6, cb = it & 63;
            LAS float* sc = (LAS float*)lds;
            for (int e = tid; e < NSLOT * DM; e += NWAVES * 64) { const int s = e >> 11, k = e & 2047; const float c = s < 4 ? args.in[I_CP][s * DM + k] : args.in[I_CS][(s - 4) * DM + k]; sc[e] = c * fast_sigmoid(c); }
            __syncthreads();
            f32x4 acc[NSLOT];
#pragma unroll
            for (int s = 0; s < NSLOT; ++s) acc[s] = (f32x4){0.f, 0.f, 0.f, 0.f};
            const int lc = lane < 48 ? lane : 47;
            const float* Wp = args.in[I_WMOD] + (size_t)l * DM * 12288 + (size_t)(wave * 256) * 12288 + cb * 192 + 4 * lc;
            for (int k0 = 0; k0 < 256; k0 += 8) {
                f32x4 w[8];
#pragma unroll
                for (int kk = 0; kk < 8; ++kk) w[kk] = *(const f32x4*)(Wp + (size_t)(k0 + kk) * 12288);
#pragma unroll
                for (int s = 0; s < NSLOT; ++s) { const f32x4 c0 = *(const LAS f32x4*)(sc + s * DM + wave * 256 + k0), c1 = *(const LAS f32x4*)(sc + s * DM + wave * 256 + k0 + 4);
#pragma unroll
                    for (int kk = 0; kk < 4; ++kk) { acc[s] += c0[kk] * w[kk]; acc[s] += c1[kk] * w[4 + kk]; } }
            }
            __syncthreads();
            LAS float* red = (LAS float*)lds;
            if (lane < 48) {
#pragma unroll
                for (int s = 0; s < NSLOT; ++s) *(LAS f32x4*)(red + (wave * NSLOT + s) * 192 + 4 * lane) = acc[s]; }
            __syncthreads();
            for (int e = tid; e < NSLOT * 192; e += NWAVES * 64) { const int s = e / 192, c = e - s * 192; float v = args.in[I_BMOD][l * 12288 + cb * 192 + c];
#pragma unroll
                for (int w8 = 0; w8 < 8; ++w8) v += red[(w8 * NSLOT + s) * 192 + c];
                MOD[(size_t)(l * NSLOT + s) * 12288 + cb * 192 + c] = v; }
            __syncthreads();
        }
        for (int e = gw * 64 + lane; e < SEQ * 32; e += NGW * 64) { float s, c; sincos_red((double)(e >> 5) * ROPE_INV[e & 31], s, c); *(f32x2*)(ROPE + 2 * (size_t)e) = (f32x2){c, s}; }
        for (int it = vcu; it < 2 * NGRP; it += G) {
            const int i = it >> 7, g = it & 127;
            LAS float* pwr = (LAS float*)lds;
            LAS float* pwi = pwr + 17 * 64;
            LAS float* bbr = pwi + 17 * 64;
            LAS float* bbi = bbr + 1024;
            LAS float* ccr = bbi + 1024;
            LAS float* cci = ccr + 1024;
            LAS float* kd = cci + 1024;
            const float dt = expf(args.in[I_LDT][i * NGRP + g]);
            if (tid < 64) {
                const int n = tid; const float are = args.in[I_ARE][(i * NGRP + g) * 64 + n], aim = args.in[I_AIM][(i * NGRP + g) * 64 + n];
                const double xr = (double)are * (double)dt, xi = (double)aim * (double)dt;
                for (int d = 0; d <= 16; ++d) { float s, c; sincos_red(xi * d, s, c); const float e = expf((float)(xr * d)); pwr[d * 64 + n] = e * c; pwi[d * 64 + n] = e * s; }
                A16[((i * NGRP + g) * 64 + n) * 2] = pwr[16 * 64 + n]; A16[((i * NGRP + g) * 64 + n) * 2 + 1] = pwi[16 * 64 + n];
                const float nr = pwr[64 + n] - 1.0f, ni = pwi[64 + n]; const float den = 1.0f / (are * are + aim * aim);
                const float fr_ = (nr * are + ni * aim) * den, fi_ = (ni * are - nr * aim) * den;
                for (int p = 0; p < 16; ++p) { const float br = args.in[I_BRE][((size_t)(i * NGRP + g) * 64 + n) * 16 + p], bi = args.in[I_BIM][((size_t)(i * NGRP + g) * 64 + n) * 16 + p];
                    bbr[n * 16 + p] = fr_ * br - fi_ * bi; bbi[n * 16 + p] = fr_ * bi + fi_ * br; }
            } else {
                for (int e = tid - 64; e < 1024; e += NWAVES * 64 - 64) { ccr[e] = args.in[I_CRE][(size_t)(i * NGRP + g) * 1024 + e]; cci[e] = args.in[I_CIM][(size_t)(i * NGRP + g) * 1024 + e]; }
            }
            __syncthreads();
            for (int e = tid; e < 4096; e += NWAVES * 64) { const int d = e >> 8, q = (e >> 4) & 15, p = e & 15; float s = 0.f;
                for (int n = 0; n < 64; ++n) { const float mr = pwr[d * 64 + n] * bbr[n * 16 + p] - pwi[d * 64 + n] * bbi[n * 16 + p], mi = pwr[d * 64 + n] * bbi[n * 16 + p] + pwi[d * 64 + n] * bbr[n * 16 + p];
                    s += ccr[q * 64 + n] * mr - cci[q * 64 + n] * mi; }
                kd[e] = s; }
            __syncthreads();
            bf16_t* BtY = (bf16_t*)(ws + WS_S5 + i * WSZ_S5 + WSZ_GG) + (size_t)g * 256 * 384;
            bf16_t* BtX = (bf16_t*)(ws + WS_S5 + i * WSZ_S5 + WSZ_GG + WSZ_BTY) + (size_t)g * 256 * 256;
            for (int e = tid; e < 256 * 192; e += NWAVES * 64) { const int rr = e / 192, k2 = (e - rr * 192) * 2; const int t = rr >> 4, q = rr & 15; float v[2];
#pragma unroll
                for (int z = 0; z < 2; ++z) { const int k = k2 + z;
                    if (k < 256) { const int s = k >> 4, p = k & 15; v[z] = (s <= t) ? kd[((t - s) * 16 + q) * 16 + p] : 0.f; }
                    else if (k < 320) { const int n = k - 256; v[z] = ccr[q * 64 + n] * pwr[(t + 1) * 64 + n] - cci[q * 64 + n] * pwi[(t + 1) * 64 + n]; }
                    else { const int n = k - 320; v[z] = -(ccr[q * 64 + n] * pwi[(t + 1) * 64 + n] + cci[q * 64 + n] * pwr[(t + 1) * 64 + n]); } }
                *(unsigned*)(BtY + (size_t)rr * 384 + k2) = cvt_pk_bf16(v[0], v[1]); }
            for (int e = tid; e < 256 * 128; e += NWAVES * 64) { const int rr = e >> 7, k2 = (e & 127) * 2; float v[2];
#pragma unroll
                for (int z = 0; z < 2; ++z) { const int k = k2 + z, s = k >> 4, p = k & 15;
                    if (rr < 64) { const int n = rr; v[z] = pwr[(15 - s) * 64 + n] * bbr[n * 16 + p] - pwi[(15 - s) * 64 + n] * bbi[n * 16 + p]; }
                    else if (rr < 128) { const int n = rr - 64; v[z] = pwr[(15 - s) * 64 + n] * bbi[n * 16 + p] + pwi[(15 - s) * 64 + n] * bbr[n * 16 + p]; }
                    else v[z] = 0.f; }
                *(unsigned*)(BtX + (size_t)rr * 256 + k2) = cvt_pk_bf16(v[0], v[1]); }
            __syncthreads();
        }
        {
            LAS float* scr = (LAS float*)(lds + wave * 16384);
            constexpr int I_DQ_ = 32 * 16, I_DKV_ = 32 * 10, I_UQ_ = 8 * 96, I_UKV_ = 4 * 128, I_O_ = 32 * 64, I_MLA_ = I_DQ_ + I_DKV_ + I_UQ_ + I_UKV_ + I_O_;
            constexpr int I_GL_ = 32 * 64, I_S5_ = 2 * I_GL_;
            constexpr int I_FG_ = 32 * 176, I_FD_ = 88 * 64, I_FFN_ = 2 * I_FG_ + I_FD_;
            constexpr int NIT = 2 * I_MLA_ + 2 * I_S5_ + 4 * I_FFN_;
            for (int it = gw; it < NIT; it += NGW) {
                int r = it;
                if (r < 2 * I_MLA_) { const int i = r / I_MLA_; r -= i * I_MLA_; unsigned char* wb = ws + WS_MLA + i * WSZ_MLA;
                    if (r < I_DQ_) { transpose_item(args.in[I_WDQ] + (size_t)i * DM * QLORA, DM, QLORA, (bf16_t*)wb, 0, 0, scr, r, lane); continue; } r -= I_DQ_;
                    if (r < I_DKV_) { transpose_item(args.in[I_WDKV] + (size_t)i * DM * 320, DM, 320, (bf16_t*)wb, 512, 0, scr, r, lane); continue; } r -= I_DKV_;
                    if (r < I_UQ_) { transpose_item(args.in[I_WUQ] + (size_t)i * QLORA * 3072, QLORA, 3072, (bf16_t*)(wb + WSZ_DQKV), 0, 0, scr, r, lane, 1.0f, args.in[I_GQA] + i * QLORA); continue; }     r -= I_UQ_;
                    if (r < I_UKV_) { transpose_item(args.in[I_WUKV] + (size_t)i * KVLORA * 4096, KVLORA, 4096, (bf16_t*)(wb + WSZ_DQKV + WSZ_UQ), 0, 0, scr, r, lane); continue; } r -= I_UKV_;
                    transpose_item(args.in[I_WO] + (size_t)i * DM * DM, DM, DM, (bf16_t*)(wb + WSZ_DQKV + WSZ_UQ + WSZ_UKV), 0, 0, scr, r, lane); continue; }
                r -= 2 * I_MLA_;
                if (r < 2 * I_S5_) { const int i = r / I_S5_; r -= i * I_S5_; bf16_t* wb = (bf16_t*)(ws + WS_S5 + i * WSZ_S5);
                    if (r < I_GL_) { transpose_item(args.in[I_WGLU] + (size_t)i * DM * DM, DM, DM, wb, 0, 1, scr, r, lane); continue; } r -= I_GL_;
                    transpose_item(args.in[I_WSG] + (size_t)i * DM * DM, DM, DM, wb, 0, 2, scr, r, lane); continue; }
                r -= 2 * I_S5_;
                { const int l = r / I_FFN_; r -= l * I_FFN_; unsigned char* wb = ws + WS_FFN + l * WSZ_FFN;
                    if (r < I_FG_) { transpose_item(args.in[I_FG] + (size_t)l * DM * DFF, DM, DFF, (bf16_t*)wb, 0, 1, scr, r, lane); continue; } r -= I_FG_;
                    if (r < I_FG_) { transpose_item(args.in[I_FU] + (size_t)l * DM * DFF, DM, DFF, (bf16_t*)wb, 0, 2, scr, r, lane); continue; } r -= I_FG_;
                    transpose_item(args.in[I_FD] + (size_t)l * DFF * DM, DFF, DM, (bf16_t*)(wb + 2 * WSZ_FF1), 0, 3, scr, r, lane, -0.6931471805599453f); }
            }
            for (int i = 0; i < 2; ++i) { u32x4* z = (u32x4*)(ws + WS_MLA + i * WSZ_MLA + (size_t)832 * DM * 2);
                for (int e = gw * 64 + lane; e < 192 * DM * 2 / 16; e += NGW * 64) z[e] = (u32x4){0u, 0u, 0u, 0u}; }
        }
    }
#endif
    PH_END

    for (int l = 0; l < 4; ++l) {
        const int li = l >> 1;
#define modl (MOD + (size_t)l * NSLOT * 12288)

#define NCOL(jj) (8 * lane + 512 * ((jj) >> 1) + 4 * ((jj) & 1))
#define NORM_STORE(V, ROW, RR16) do { \
                _Pragma("unroll") for (int j = 0; j < 4; ++j) { const f32x4 h0 = V[2 * j] * rstd * mul[2 * j] + add[2 * j], h1 = V[2 * j + 1] * rstd * mul[2 * j + 1] + add[2 * j + 1]; const u32x4 w = pg8::pack8(h0, h1); \
                    if (MODE_ == 0) *(u32x4*)(Hb + (size_t)(ROW) * DM + 8 * lane + 512 * j) = w; \
                    else { const int c = ((ROW) >> 4); *(u32x4*)(UP + ((size_t)((lane >> 1) + 32 * j) * NSUB + c) * 384 + (RR16) * 16 + 8 * (lane & 1)) = w; } } } while (0)
#define NORM_STAGE(V, RR16) do { \
                _Pragma("unroll") for (int j = 0; j < 4; ++j) { const f32x4 h0 = V[2 * j] * rstd * mul[2 * j] + add[2 * j], h1 = V[2 * j + 1] * rstd * mul[2 * j + 1] + add[2 * j + 1]; \
                    *(LAS u32x4*)(lds + wave * 16384 + ((RR16) & 3) * 4096 + 16 * lane + 1024 * j) = pg8::pack8(h0, h1); } } while (0)
#define NORM_FLUSH(RR4) do { asm volatile("s_waitcnt lgkmcnt(0)" ::: "memory"); const int t_ = lane >> 4, gl_ = (lane >> 1) & 7, h_ = lane & 1; \
                _Pragma("unroll") for (int i_ = 0; i_ < 16; ++i_) { const int g_ = 8 * i_ + gl_; const u32x4 w_ = *(const LAS u32x4*)(lds + wave * 16384 + t_ * 4096 + g_ * 32 + h_ * 16); \
                    *(u32x4*)(UP + ((size_t)g_ * NSUB + gw) * 384 + ((RR4) + t_) * 16 + 8 * h_) = w_; } \
                asm volatile("s_waitcnt lgkmcnt(0)" ::: "memory"); } while (0)
#define NORM_LOADP(MULADD_SLOT, GAIN, SHOFF, SCOFF) \
            f32x4 mul[8], add[8]; \
            _Pragma("unroll") for (int jj = 0; jj < 8; ++jj) { const int col = NCOL(jj); const f32x4 gg = *(const f32x4*)((GAIN) + col); const f32x4 scv = *(const f32x4*)(modl + (MULADD_SLOT) * 12288 + (SCOFF) + col); \
                add[jj] = *(const f32x4*)(modl + (MULADD_SLOT) * 12288 + (SHOFF) + col); mul[jj] = gg * (scv + 1.0f); }
#define LD8_BF16(V0, V1, P) do { const u32x4 w_ = *(const u32x4*)(P); V0 = (f32x4){bf_lo(w_[0]), bf_hi(w_[0]), bf_lo(w_[1]), bf_hi(w_[1])}; V1 = (f32x4){bf_lo(w_[2]), bf_hi(w_[2]), bf_lo(w_[3]), bf_hi(w_[3])}; } while (0)
#define NORM_ROWS(P32, S32, GAIN, SHOFF, SCOFF, MODE, NPART, PGATE, PMODE) do { constexpr int MODE_ = MODE; \
        { const int row0 = gw * 16; const int slot = slot_of_row(row0); \
            NORM_LOADP(slot, GAIN, SHOFF, SCOFF) \
            for (int rr = 0; rr < 16; rr += 2) { \
                f32x4 va[8], vb[8]; float sa = 0.f, sb = 0.f; \
                if (P32) { const float* xs = args.in[I_XP] + (size_t)(row0 + rr) * DM; \
                    _Pragma("unroll") for (int jj = 0; jj < 8; ++jj) { va[jj] = *(const f32x4*)(xs + NCOL(jj)); vb[jj] = *(const f32x4*)(xs + DM + NCOL(jj)); } } \
                else { const bf16_t* xh = XBs + (size_t)(row0 + rr) * DM + 8 * lane; \
                    _Pragma("unroll") for (int j = 0; j < 4; ++j) { LD8_BF16(va[2 * j], va[2 * j + 1], xh + 512 * j); LD8_BF16(vb[2 * j], vb[2 * j + 1], xh + DM + 512 * j); } } \
                _Pragma("unroll") for (int jj = 0; jj < 8; ++jj) { sa += (va[jj].x * va[jj].x + va[jj].y * va[jj].y) + (va[jj].z * va[jj].z + va[jj].w * va[jj].w); sb += (vb[jj].x * vb[jj].x + vb[jj].y * vb[jj].y) + (vb[jj].z * vb[jj].z + vb[jj].w * vb[jj].w); } \
                _Pragma("unroll") for (int o_ = 1; o_ < 64; o_ <<= 1) { sa += shx(sa, o_, lane); sb += shx(sb, o_, lane); } \
                { const float rstd = 1.0f / sqrtf(sa * (1.0f / DM) + EPS); if (MODE_ == 1) NORM_STAGE(va, rr); else NORM_STORE(va, row0 + rr, rr); } \
                { const float rstd = 1.0f / sqrtf(sb * (1.0f / DM) + EPS); if (MODE_ == 1) NORM_STAGE(vb, rr + 1); else NORM_STORE(vb, row0 + rr + 1, rr + 1); } \
                if (MODE_ == 1 && (rr & 2)) NORM_FLUSH(rr & ~3); } } \
        if (gw < 512) { const int row = NPROMPT + gw; const int slot = 4 + (gw >> 6); const int np_ = (NPART); \
              \
            f32x4 v[8]; float ss = 0.f; \
            if (S32) { _Pragma("unroll") for (int jj = 0; jj < 8; ++jj) v[jj] = *(const f32x4*)(args.in[I_XS] + (size_t)gw * DM + NCOL(jj)); } \
            else { const bf16_t* xh = XBs + (size_t)row * DM + 8 * lane; u32x4 xr_[4]; _Pragma("unroll") for (int j = 0; j < 4; ++j) xr_[j] = *(const u32x4*)(xh + 512 * j); asm volatile("" ::: "memory"); \
                _Pragma("unroll") for (int j = 0; j < 4; ++j) { v[2 * j] = (f32x4){bf_lo(xr_[j][0]), bf_hi(xr_[j][0]), bf_lo(xr_[j][1]), bf_hi(xr_[j][1])}; v[2 * j + 1] = (f32x4){bf_lo(xr_[j][2]), bf_hi(xr_[j][2]), bf_lo(xr_[j][3]), bf_hi(xr_[j][3])}; } } \
            if (np_ > 0) { const int pm_ = (PMODE); \
                f32x4 sp[8]; _Pragma("unroll") for (int jj = 0; jj < 8; ++jj) sp[jj] = (f32x4){0.f, 0.f, 0.f, 0.f}; \
                if (pm_ == 0) { \
                    for (int ks = 0; ks < np_; ++ks) { f32x4 t_[8]; _Pragma("unroll") for (int jj = 0; jj < 8; ++jj) t_[jj] = *(const f32x4*)(PART + ((size_t)ks * 512 + gw) * DM + NCOL(jj)); asm volatile("" ::: "memory"); \
                        _Pragma("unroll") for (int jj = 0; jj < 8; ++jj) sp[jj] += t_[jj]; } \
                } else { \
                    _Pragma("unroll") for (int h_ = 0; h_ < 2; ++h_) { f32x4 sg[4]; _Pragma("unroll") for (int q = 0; q < 4; ++q) sg[q] = (f32x4){0.f, 0.f, 0.f, 0.f}; \
                        for (int ks = 0; ks < np_; ++ks) { f32x4 t_[4], u_[4]; \
                            _Pragma("unroll") for (int q = 0; q < 4; ++q) { const int col = NCOL(4 * h_ + q); const float* pp = PART + ((size_t)ks * 512 + gw) * 4096 + (col >> 7) * 256 + (col & 127); t_[q] = *(const f32x4*)pp; u_[q] = *(const f32x4*)(pp + 128); } \
                            asm volatile("" ::: "memory"); \
                            _Pragma("unroll") for (int q = 0; q < 4; ++q) { sp[4 * h_ + q] += t_[q]; sg[q] += u_[q]; } } \
                        _Pragma("unroll") for (int q = 0; q < 4; ++q) _Pragma("unroll") for (int e = 0; e < 4; ++e) sp[4 * h_ + q][e] *= fast_sigmoid(sg[q][e]); } } \
                { f32x4 gt_[8]; _Pragma("unroll") for (int jj = 0; jj < 8; ++jj) gt_[jj] = *(const f32x4*)((PGATE) + (size_t)slot * 12288 + NCOL(jj)); asm volatile("" ::: "memory"); \
                  _Pragma("unroll") for (int jj = 0; jj < 8; ++jj) v[jj] += gt_[jj] * sp[jj]; } \
                _Pragma("unroll") for (int j = 0; j < 4; ++j) { const u32x4 w_ = pg8::pack8(v[2 * j], v[2 * j + 1]); *(u32x4*)(XBs + (size_t)row * DM + 8 * lane + 512 * j) = w_;     \
                    v[2 * j] = (f32x4){bf_lo(w_[0]), bf_hi(w_[0]), bf_lo(w_[1]), bf_hi(w_[1])}; v[2 * j + 1] = (f32x4){bf_lo(w_[2]), bf_hi(w_[2]), bf_lo(w_[3]), bf_hi(w_[3])}; } } \
            _Pragma("unroll") for (int jj = 0; jj < 8; ++jj) ss += (v[jj].x * v[jj].x + v[jj].y * v[jj].y) + (v[jj].z * v[jj].z + v[jj].w * v[jj].w); \
            const float rstd = 1.0f / sqrtf(wave_sum(ss, lane) * (1.0f / DM) + EPS); \
            NORM_LOADP(slot, GAIN, SHOFF, SCOFF) \
            NORM_STORE(v, row, row & 15); } } while (0)
#define PREV_GATE_F (MOD + (size_t)(l - 1) * NSLOT * 12288 + 10240)

        if ((l & 1) == 0) {
#define wb (ws + WS_MLA + li * WSZ_MLA)
            PH_BEGIN
#ifndef NO_A0
            NORM_ROWS(l == 0, l == 0, args.in[I_GMIX] + l * DM, 0, 2048, 0, (l > 0 ? 11 : 0), PREV_GATE_F, 0);
#endif
            PH_END
            PH_BEGIN
#ifndef NO_A1
            { pg8::Gemm g = pg8::gemm_rm(Hb, (const bf16_t*)wb, DM, DM, DM); pg8::StaticOrder S; S.init(128, 4, G, bx); pg8::EpiA1 E{QKVA, QA, STATQ};
              pg8::gemm_phase<pg8::EpiA1, pg8::StaticOrder, true>(lds, g, S, E, tid); }
            { pg8::Gemm g = pg8::gemm_rm(Hb, (const bf16_t*)wb, DM, DM, 512); pg8::SplitOrder S{bx, 4, 4, (size_t)1024}; pg8::EpiPartial E{PART, 1024};
              pg8::gemm_phase<pg8::EpiPartial, pg8::SplitOrder, true>(lds, g, S, E, tid); }
#endif
            PH_END
            PH_BEGIN
#ifndef NO_A2
            {
                const float* gqa = args.in[I_GQA] + li * QLORA; const float* gkva = args.in[I_GKVA] + li * KVLORA; const float* gkn = args.in[I_GKN] + li * DQK;
                for (int it = gw; it < NTOK + 8 * PAST; it += NGW) {
                    int kvrow, pos; f32x4 kr = (f32x4){0.f, 0.f, 0.f, 0.f};
                    if (it < NTOK) {
                        const int row = it;
                        f32x4 v[4];
                        const bool pr = row < NPROMPT;
                        if (pr) { const float* src = QKVA + (size_t)row * 1024;
                            v[0] = v[1] = (f32x4){0.f, 0.f, 0.f, 0.f};
#pragma unroll
                            for (int j = 2; j < 4; ++j) v[j] = *(const f32x4*)(src + 4 * lane + 256 * j); }
                        else { const float* src = PART + (size_t)(row - NPROMPT) * 1024;
#pragma unroll
                            for (int j = 0; j < 4; ++j) v[j] = (*(const f32x4*)(src + 4 * lane + 256 * j) + *(const f32x4*)(src + 512 * 1024 + 4 * lane + 256 * j)) + (*(const f32x4*)(src + 2 * 512 * 1024 + 4 * lane + 256 * j) + *(const f32x4*)(src + 3 * 512 * 1024 + 4 * lane + 256 * j)); }
                        float sq = 0.f, sk = 0.f;
#pragma unroll
                        for (int j = 0; j < 2; ++j) sq += (v[j].x * v[j].x + v[j].y * v[j].y) + (v[j].z * v[j].z + v[j].w * v[j].w);
                        if (pr) sq = lane < 8 ? STATQ[(size_t)row * 8 + lane] : 0.f;
                        sk = (v[2].x * v[2].x + v[2].y * v[2].y) + (v[2].z * v[2].z + v[2].w * v[2].w);
                        const float rq = 1.0f / sqrtf(wave_sum(sq, lane) * (1.0f / QLORA) + EPS), rk = 1.0f / sqrtf(wave_sum(sk, lane) * (1.0f / KVLORA) + EPS);
                        if (!pr) {
#pragma unroll
                            for (int j = 0; j < 2; ++j) { const f32x4 h = v[j] * rq; u32x2 w; w.x = cvt_pk_bf16(h.x, h.y); w.y = cvt_pk_bf16(h.z, h.w);
                                *(u32x2*)(QA + (size_t)row * QLORA + 4 * lane + 256 * j) = w; } }
                        if (lane == 0) RSTDQ[row] = pr ? rq : 1.0f;
                        const f32x4 gk = *(const f32x4*)(gkva + 4 * lane); const f32x4 ck = v[2] * rk * gk;
                        int t;
                        if (row < NPROMPT) { kvrow = row; t = row & (SEQ - 1); pos = t; const int b = row >> 13;
                            *(f32x4*)(out + O_CKVP + ((size_t)(li * 4 + b) * SEQ + t) * KVLORA + 4 * lane) = ck;
                            if (lane < 16) *(f32x4*)(out + O_KRP + ((size_t)(li * 4 + b) * SEQ + t) * 64 + 4 * lane) = v[3]; }
                        else { const int r2 = row - NPROMPT, b = r2 >> 6; t = r2 & 63; kvrow = NPROMPT + b * SKV + PAST + t; pos = PAST + t;
                            *(f32x4*)(out + O_CKVS + ((size_t)(li * 8 + b) * DSEQ + t) * KVLORA + 4 * lane) = ck;
                            if (lane < 16) *(f32x4*)(out + O_KRS + ((size_t)(li * 8 + b) * DSEQ + t) * 64 + 4 * lane) = v[3]; }
                        u32x2 w; w.x = cvt_pk_bf16(ck.x, ck.y); w.y = cvt_pk_bf16(ck.z, ck.w); *(u32x2*)(CKV + (size_t)kvrow * KVLORA + 4 * lane) = w;
                        kr = v[3];
                    } else {
                        const int c2 = it - NTOK, b = c2 >> 12, p = c2 & (PAST - 1); kvrow = NPROMPT + b * SKV + p; pos = p;
                        const f32x4 ck = *(const f32x4*)(args.in[I_CCKV] + ((size_t)(li * 8 + b) * PAST + p) * KVLORA + 4 * lane);
                        u32x2 w; w.x = cvt_pk_bf16(ck.x, ck.y); w.y = cvt_pk_bf16(ck.z, ck.w); *(u32x2*)(CKV + (size_t)kvrow * KVLORA + 4 * lane) = w;
                        if (lane < 16) kr = *(const f32x4*)(args.in[I_CKR] + ((size_t)(li * 8 + b) * PAST + p) * 64 + 4 * lane);
                    }
                    float ssk = (lane < 16) ? (kr.x * kr.x + kr.y * kr.y) + (kr.z * kr.z + kr.w * kr.w) : 0.f;
                    ssk = sum16(ssk, lane);
                    const f32x4 gr = (lane < 16) ? *(const f32x4*)(gkn + 128 + 4 * lane) : (f32x4){0.f, 0.f, 0.f, 0.f};
                    const f32x4 kg = kr * gr;
                    f32x4 other; other.x = shx(kg.x, 8, lane); other.y = shx(kg.y, 8, lane); other.z = shx(kg.z, 8, lane); other.w = shx(kg.w, 8, lane);
                    if (lane < 16) {
                        const int jb = 4 * (lane & 7); f32x4 o;
#pragma unroll
                        for (int e = 0; e < 4; ++e) { const f32x2 cs = *(const f32x2*)(ROPE + ((size_t)pos * 32 + jb + e) * 2); const float c = cs.x, s = cs.y;
                            o[e] = (lane < 8) ? kg[e] * c - other[e] * s : other[e] * s + kg[e] * c; }
                        *(f32x4*)(Rr + (size_t)kvrow * 64 + 4 * lane) = o;
                        if (lane == 0) KRSS[kvrow] = ssk;
                    }
                }
            }
#endif
            PH_END
            PH_BEGIN
#ifndef NO_A3
            { pg8::Gemm g = pg8::gemm_rm(QA, (const bf16_t*)(wb + WSZ_DQKV), QLORA, QLORA, QLORA); pg8::StaticOrder S; S.init(NTOK / 256, 12, G, bx); pg8::EpiBf16 E{Qb, 3072, RSTDQ};
              pg8::gemm_phase<pg8::EpiBf16, pg8::StaticOrder, true>(lds, g, S, E, tid); }
            { pg8::Gemm g = pg8::gemm_rm(CKV, (const bf16_t*)(wb + WSZ_DQKV + WSZ_UQ), KVLORA, KVLORA, KVLORA); pg8::StaticOrder S; S.init(NKV / 256, 16, G, (G % 8 == 0 && G > 64) ? (bx + 32) % G : bx);     pg8::EpiKV E{KB, KRSS, Rr, args.in[I_GKN] + li * DQK, (LAS float*)(lds + MISC_OFF + 1024)};
              pg8::gemm_phase<pg8::EpiKV, pg8::StaticOrder, true>(lds, g, S, E, tid); }
#endif
            PH_END
            PH_BEGIN
#ifndef NO_A5
            {
                bool fx_ok;
                { float gq = 0.f, gk = 0.f;
                  for (int e = lane; e < DQK; e += 64) { gq = fmaxf(gq, fabsf(args.in[I_GQN][li * DQK + e])); gk = fmaxf(gk, fabsf(args.in[I_GKN][li * DQK + e])); }
#pragma unroll
                  for (int o_ = 1; o_ < 64; o_ <<= 1) { gq = fmaxf(gq, shx(gq, o_, lane)); gk = fmaxf(gk, shx(gk, o_, lane)); }
                  fx_ok = __builtin_amdgcn_readfirstlane(__float_as_int(gq * gk * (1.4427f * 13.8564f * 1.03f))) < __float_as_int(60.0f); }
                const int nun = ((vcu & 1) == 0) ? 9 : 8;
                for (int un = 0; un < nun; ++un) {
                    const bf16_t* q_; const bf16_t* k_; const bf16_t* v_; bf16_t* o_; int NT_, NTr_, nv_, wq_, pos0_, rev_;
                    if (un < 8) { const int x = vcu >> 5, i = vcu & 31; const int bh = x * 8 + (un >> 1) * 2 + (un & 1), b = bh >> 4, h = bh & 15; const int qb = (un & 1) == 0 ? i : ((un >> 1) < 2 ? 31 - (i ^ 1) : 31 - i);     const size_t qrow = (size_t)b * SEQ + 256 * qb;
                        q_ = Qb + qrow * 3072 + h * DQK; k_ = KB + (size_t)b * SEQ * 5120 + h * 320; v_ = k_ + 192; o_ = Hb + qrow * DM + h * 128;
                        NT_ = 4 * (qb + 1); NTr_ = NT_; nv_ = 4 * qb + (wave >> 1) + 1; wq_ = wave; pos0_ = 256 * qb; rev_ = un & 1; }
                    else { const int su = vcu >> 1, b = su >> 4, h = su & 15; const size_t qrow = NPROMPT + (size_t)b * DSEQ, kvr = NPROMPT + (size_t)b * SKV;
                        q_ = Qb + qrow * 3072 + h * DQK; k_ = KB + kvr * 5120 + h * 320; v_ = k_ + 192; o_ = Hb + qrow * DM + h * 128;
                        NT_ = 66; NTr_ = 65; nv_ = wave < 2 ? 65 : 0; wq_ = wave & 1; pos0_ = PAST; rev_ = 0; }
                    if (fx_ok) att::attn_unit<true>(q_, k_, v_, o_, NT_, NTr_, nv_, wq_, rev_, (LAS char*)lds, tid, args.in[I_GQN] + li * DQK, ROPE, pos0_);
                    else att::attn_unit<false>(q_, k_, v_, o_, NT_, NTr_, nv_, wq_, rev_, (LAS char*)lds, tid, args.in[I_GQN] + li * DQK, ROPE, pos0_);
                }
            }
#endif
            PH_END
            PH_BEGIN
#ifndef NO_A6
            { pg8::Gemm g = pg8::gemm_rm(Hb, (const bf16_t*)(wb + WSZ_DQKV + WSZ_UQ + WSZ_UKV), DM, DM, DM); pg8::StaticOrder S; S.init(128, 8, G, bx); pg8::EpiResid E{args.in[I_XP], out, XBs, modl + 4096, (l == 0) ? 1 : 0, 0};
              pg8::gemm_phase<pg8::EpiResid, pg8::StaticOrder, true>(lds, g, S, E, tid); }
            { pg8::Gemm g = pg8::gemm_rm(Hb, (const bf16_t*)(wb + WSZ_DQKV + WSZ_UQ + WSZ_UKV), DM, DM, 512); pg8::SplitOrder S{bx, 8, 4, (size_t)1024}; pg8::EpiPartial E{PART, DM};
              pg8::gemm_phase<pg8::EpiPartial, pg8::SplitOrder, true>(lds, g, S, E, tid); }
#endif
            PH_END
        } else {
#undef wb
#define wb (ws + WS_S5 + li * WSZ_S5)
            PH_BEGIN
#ifndef NO_S0
            NORM_ROWS(false, false, args.in[I_GMIX] + l * DM, 0, 2048, 1, 11, PREV_GATE_F, 0);
#endif
            PH_END
            PH_BEGIN
#ifndef NO_S1
            { pg8::Gemm g = pg8::gemm_rm(UP, (const bf16_t*)(wb + WSZ_GG + WSZ_BTY), 384, 256, 256); pg8::GroupOrder S{G, bx}; pg8::EpiXloc E{XLOC};
              pg8::gemm_phase<pg8::EpiXloc, pg8::GroupOrder, true>(lds, g, S, E, tid); }
#endif
            PH_END
            PH_BEGIN
#ifndef NO_S2
            {
                for (int it = gw; it < NSLOT * NGRP; it += NGW) {
                    const int slot = it >> 7, g = it & 127, n = lane;
                    const float ar = A16[((li * NGRP + g) * 64 + n) * 2], ai = A16[((li * NGRP + g) * 64 + n) * 2 + 1];
                    float xr = 0.f, xi = 0.f; int c0, nc;
                    if (slot < 4) { c0 = slot * 512; nc = 512; }
                    else { const int b = slot - 4; c0 = 2048 + 4 * b; nc = 4; xr = args.in[I_SRE][((size_t)(li * 8 + b) * NGRP + g) * 64 + n]; xi = args.in[I_SIM][((size_t)(li * 8 + b) * NGRP + g) * 64 + n]; }
                    const bf16_t* xl = XLOC + ((size_t)g * NSUB + c0) * 128; bf16_t* up = UP + ((size_t)g * NSUB + c0) * 384 + 256;
#define S2_STEP(LR, LI, Q) do { const unsigned pk = cvt_pk_bf16(xr, xi); up[(size_t)(c + (Q)) * 384 + n] = (bf16_t)(pk & 0xffffu); up[(size_t)(c + (Q)) * 384 + 64 + n] = (bf16_t)(pk >> 16); \
                            const float nr = ar * xr - ai * xi + (LR), ni = ar * xi + ai * xr + (LI); xr = nr; xi = ni; } while (0)
                    if (nc == 4) { const int c = 0; float lr[4], lim[4];
#pragma unroll
                        for (int q = 0; q < 4; ++q) { lr[q] = bf_lo((unsigned)xl[(size_t)q * 128 + n]); lim[q] = bf_lo((unsigned)xl[(size_t)q * 128 + 64 + n]); }
#pragma unroll
                        for (int q = 0; q < 4; ++q) S2_STEP(lr[q], lim[q], q);
                    } else {
                        float lr[16], lim[16];
#pragma unroll
                        for (int q = 0; q < 16; ++q) { lr[q] = bf_lo((unsigned)xl[(size_t)q * 128 + n]); lim[q] = bf_lo((unsigned)xl[(size_t)q * 128 + 64 + n]); }
                        for (int c = 0; c < nc; c += 16) {
                            float nr_[16], ni_[16]; const int cn = c + 16 < nc ? c + 16 : c;
#pragma unroll
                            for (int q = 0; q < 16; ++q) { nr_[q] = bf_lo((unsigned)xl[(size_t)(cn + q) * 128 + n]); ni_[q] = bf_lo((unsigned)xl[(size_t)(cn + q) * 128 + 64 + n]); }
#pragma unroll
                            for (int q = 0; q < 16; ++q) S2_STEP(lr[q], lim[q], q);
#pragma unroll
                            for (int q = 0; q < 16; ++q) { lr[q] = nr_[q]; lim[q] = ni_[q]; }
                        }
                    }
#undef S2_STEP
                    if (slot < 4) { out[O_REP + ((size_t)(li * 4 + slot) * NGRP + g) * 64 + n] = xr; out[O_IMP + ((size_t)(li * 4 + slot) * NGRP + g) * 64 + n] = xi; }
                    else { out[O_RES + ((size_t)(li * 8 + slot - 4) * NGRP + g) * 64 + n] = xr; out[O_IMS + ((size_t)(li * 8 + slot - 4) * NGRP + g) * 64 + n] = xi; }
                }
            }
#endif
            PH_END
            PH_BEGIN
#ifndef NO_S3
            { pg8::Gemm g = pg8::gemm_rm(UP, (const bf16_t*)(wb + WSZ_GG), 384, 384, 384); pg8::GroupOrder S{G, bx}; pg8::EpiY E{UP, Hb, args.in[I_SD] + li * DM};
              pg8::gemm_phase<pg8::EpiY, pg8::GroupOrder, true>(lds, g, S, E, tid); }
#endif
            PH_END
            PH_BEGIN
#ifndef NO_S4
            { pg8::Gemm g = pg8::gemm_rm(Hb, (const bf16_t*)wb, DM, DM, DM); pg8::StaticOrder S; S.init(128, 16, G, bx); pg8::EpiGlu E{XBs, modl + 4096};
              pg8::gemm_phase<pg8::EpiGlu, pg8::StaticOrder, true>(lds, g, S, E, tid); }
            { pg8::Gemm g = pg8::gemm_rm(Hb, (const bf16_t*)wb, DM, DM, 512); pg8::SplitOrder S{bx, 16, 4, (size_t)1024}; pg8::EpiPartial E{PART, 4096};
              pg8::gemm_phase<pg8::EpiPartial, pg8::SplitOrder, true>(lds, g, S, E, tid); }
#endif
            PH_END
        }
        {
#undef wb
#define wb (ws + WS_FFN + l * WSZ_FFN)
            PH_BEGIN
#ifndef NO_F0
            NORM_ROWS(false, l == 0, args.in[I_GFFN] + l * DM, 6144, 8192, 0, 4, modl + 4096, (l & 1));
#endif
            PH_END
            PH_BEGIN
#ifndef NO_F1
            { pg8::Gemm g = pg8::gemm_rm(Hb, (const bf16_t*)wb, DM, DM, DM); pg8::StaticOrder S; S.init(128, 44, G, bx);
              pg8::EpiFfn E{HID, args.in[I_FCW] + (size_t)l * 3 * DFF, args.in[I_FCB] + (size_t)l * DFF, out + O_CONVP + (size_t)l * 4 * 2 * DFF, GBND, DEFC, DEFU, (LAS float*)(lds + MISC_OFF + 1024)};
              pg8::gemm_phase<pg8::EpiFfn, pg8::StaticOrder, true>(lds, g, S, E, tid); }
            { pg8::Gemm g = pg8::gemm_rm(Hb, (const bf16_t*)wb, DM, DM, 1024); pg8::SplitOrder S{bx, 44, 2, (size_t)2048}; pg8::EpiPartial E{PGU, 2 * DFF};
              pg8::gemm_phase<pg8::EpiPartial, pg8::SplitOrder, true>(lds, g, S, E, tid); }
#endif
            PH_END
            PH_BEGIN
#ifndef NO_F2
            for (int it = gw; it < 512 * 22; it += NGW) { const int r = it / 22, c = (it - r * 22) * 256 + 4 * lane; const int b = r >> 6, t = r & 63;
                const float* cwp = args.in[I_FCW] + (size_t)l * 3 * DFF + c; const f32x4 w0 = *(const f32x4*)cwp, w1 = *(const f32x4*)(cwp + DFF), w2 = *(const f32x4*)(cwp + 2 * DFF), cbv = *(const f32x4*)(args.in[I_FCB] + (size_t)l * DFF + c);
                const float* pg = PGU + (size_t)r * (2 * DFF) + (c >> 7) * 256 + (c & 127); const size_t ps = (size_t)512 * 2 * DFF;
                const float* cc = args.in[I_CCONV] + ((size_t)(l * 8 + b) * 2) * DFF + c;
                const f32x4 g2 = *(const f32x4*)pg + *(const f32x4*)(pg + ps);
                const f32x4 g1 = t >= 1 ? *(const f32x4*)(pg - 2 * DFF) + *(const f32x4*)(pg - 2 * DFF + ps) : *(const f32x4*)(cc + DFF);
                const f32x4 g0 = t >= 2 ? *(const f32x4*)(pg - 4 * DFF) + *(const f32x4*)(pg - 4 * DFF + ps) : *(const f32x4*)(cc + (t == 1 ? DFF : 0));
                const f32x4 uu = *(const f32x4*)(pg + 128) + *(const f32x4*)(pg + 128 + ps);
                f32x4 h;
#pragma unroll
                for (int e = 0; e < 4; ++e) { const float gc = cbv[e] + w0[e] * g0[e] + w1[e] * g1[e] + w2[e] * g2[e]; h[e] = -1.4426950408889634f * (gc * fast_sigmoid(gc) * uu[e]); }
                u32x2 w; w.x = cvt_pk_bf16(h[0], h[1]); w.y = cvt_pk_bf16(h[2], h[3]);
                *(u32x2*)(HID + pg8::tiled_off(NPROMPT + r, c, DFF / 64)) = w;
                if (t >= DSEQ - 2) *(f32x4*)(out + O_CONVS + ((size_t)(l * 8 + b) * 2 + (t - (DSEQ - 2))) * DFF + c) = g2; }
            for (int it = gw * 64 + lane; it < 128 * 2 * (DFF / 4); it += NGW * 64) { const int pm = it / (2 * (DFF / 4)), rem = it - pm * (2 * (DFF / 4)), rr = rem / (DFF / 4), c = (rem - rr * (DFF / 4)) * 4;
                if ((pm & 31) == 0) continue;
                const float* cwp = args.in[I_FCW] + (size_t)l * 3 * DFF + c; const f32x4 w0 = *(const f32x4*)cwp, w1 = *(const f32x4*)(cwp + DFF);
                const f32x4 p254 = *(const f32x4*)(GBND + (size_t)((pm - 1) * 2) * DFF + c), p255 = *(const f32x4*)(GBND + (size_t)((pm - 1) * 2 + 1) * DFF + c);
                const f32x4 cp = *(const f32x4*)(DEFC + (size_t)(pm * 2 + rr) * DFF + c), uu = *(const f32x4*)(DEFU + (size_t)(pm * 2 + rr) * DFF + c);
                f32x4 h;
#pragma unroll
                for (int e = 0; e < 4; ++e) { const float gc = rr == 0 ? cp[e] + -1.4426950408889634f * (w0[e] * p254[e] + w1[e] * p255[e]) : cp[e] + -1.4426950408889634f * (w0[e] * p255[e]); h[e] = gc * __builtin_amdgcn_rcpf(1.0f + __builtin_amdgcn_exp2f(gc)) * uu[e]; }
                u32x2 w; w.x = cvt_pk_bf16(h[0], h[1]); w.y = cvt_pk_bf16(h[2], h[3]);
                *(u32x2*)(HID + pg8::tiled_off(pm * 256 + rr, c, DFF / 64)) = w; }
#endif
            PH_END
            PH_BEGIN
#ifndef NO_F3
            { pg8::Gemm g{HID, (const bf16_t*)(wb + 2 * WSZ_FF1), 64, 64, DFF, 32768, 32768, (size_t)88 * 32768, (size_t)88 * 32768};
              pg8::StaticOrder S; S.init(128, 8, G, bx); pg8::EpiResid E{args.in[I_XP], out, XBs, modl + 10240, 0, (l == 3) ? 1 : 0};
              pg8::gemm_phase<pg8::EpiResid, pg8::StaticOrder, true>(lds, g, S, E, tid); }
            { pg8::Gemm g{HID, (const bf16_t*)(wb + 2 * WSZ_FF1), 64, 64, 512, 32768, 32768, (size_t)88 * 32768, (size_t)88 * 32768};
              pg8::SplitOrder S{bx, 8, 11, (size_t)8 * 32768}; pg8::EpiPartial E{PART, DM};
              pg8::gemm_phase<pg8::EpiPartial, pg8::SplitOrder, true>(lds, g, S, E, tid); }
#endif
            PH_END
        }
    }
    PH_BEGIN
    if (gw < 512) { const int row = NPROMPT + gw; const int slot = 4 + (gw >> 6); const float* pg = MOD + (size_t)(3 * NSLOT + slot) * 12288 + 10240;
        f32x4 sp[8];
#pragma unroll
        for (int j = 0; j < 8; ++j) sp[j] = (f32x4){0.f, 0.f, 0.f, 0.f};
        for (int ks = 0; ks < 11; ++ks) {
#pragma unroll
            for (int j = 0; j < 8; ++j) sp[j] += *(const f32x4*)(PART + ((size_t)ks * 512 + gw) * DM + 4 * lane + 256 * j); }
#pragma unroll
        for (int j = 0; j < 8; ++j) { const u32x2 xw = *(const u32x2*)(XBs + (size_t)row * DM + 4 * lane + 256 * j); const f32x4 xv = (f32x4){bf_lo(xw.x), bf_hi(xw.x), bf_lo(xw.y), bf_hi(xw.y)};
            *(f32x4*)(out + (size_t)row * DM + 4 * lane + 256 * j) = xv + *(const f32x4*)(pg + 4 * lane + 256 * j) * sp[j]; } }
    PH_END
#undef wb
#undef PH_BEGIN
#undef PH_END
}

constexpr int NPHASES = 1 + 2 * (6 + 4) + 2 * (5 + 4) + 1;

extern "C" void kernel_launch(void* const* d_in, const int* in_sizes, int n_in, void* d_out, int out_size, void* d_ws, size_t ws_size, hipStream_t stream) {
    static int grid = 0;
    if (grid == 0) {
        if (n_in != 37 || (size_t)out_size != O_END || ws_size < WS_END) { fprintf(stderr, "kernel_launch: unexpected shapes (n_in %d out %d ws %zu)\n", n_in, out_size, ws_size); grid = -1; return; }
        int dev = 0, cus = 0, per_cu = 0;
        if (hipGetDevice(&dev) != hipSuccess || hipDeviceGetAttribute(&cus, hipDeviceAttributeMultiprocessorCount, dev) != hipSuccess) { grid = -1; return; }
        if (hipFuncSetAttribute((const void*)fwd_kernel, hipFuncAttributeMaxDynamicSharedMemorySize, LDS_BYTES) != hipSuccess) { fprintf(stderr, "kernel_launch: hipFuncSetAttribute failed\n"); grid = -1; return; }
        if (hipOccupancyMaxActiveBlocksPerMultiprocessor(&per_cu, (const void*)fwd_kernel, NWAVES * 64, LDS_BYTES) != hipSuccess || per_cu < 1) { fprintf(stderr, "kernel_launch: occupancy query says %d\n", per_cu); }
        (void)hipGetLastError();
        grid = cus;
    }
    if (grid < 0) return;
    (void)hipMemsetAsync((char*)d_ws + WS_CTL, 0, CTL_ZERO_BYTES, stream);
    Args a{};
    for (int i = 0; i < 37; ++i) a.in[i] = (const float*)d_in[i];
    a.out = (float*)d_out; a.ws = (unsigned char*)d_ws;
#if MK_PER_PHASE
    for (int p = 0; p < NPHASES; ++p) { a.ph_lo = p; a.ph_hi = p + 1; hipLaunchKernelGGL(fwd_kernel, dim3(grid), dim3(NWAVES * 64), LDS_BYTES, stream, a); }
#else
    a.ph_lo = 0; a.ph_hi = NPHASES;
    hipLaunchKernelGGL(fwd_kernel, dim3(grid), dim3(NWAVES * 64), LDS_BYTES, stream, a);
#endif
    const hipError_t le = hipPeekAtLastError();
    if (le != hipSuccess) fprintf(stderr, "kernel_launch: launch failed: %s\n", hipGetErrorName(le));
}
```

```cpp
#include <hip/hip_runtime.h>
#include <cstdio>
#include <cstdint>

#ifndef MK_PER_PHASE
#define MK_PER_PHASE 0
#endif

#define LAS __attribute__((address_space(3)))
#define GAS __attribute__((address_space(1)))
typedef unsigned short bf16_t;
typedef short bf16x8 __attribute__((ext_vector_type(8)));
typedef short s16x4 __attribute__((ext_vector_type(4)));
typedef float f32x4 __attribute__((ext_vector_type(4)));
typedef float f32x2 __attribute__((ext_vector_type(2)));
typedef float f32x16 __attribute__((ext_vector_type(16)));
typedef unsigned u32x4 __attribute__((ext_vector_type(4)));
typedef unsigned u32x2 __attribute__((ext_vector_type(2)));

constexpr int DM = 2048, NPROMPT = 32768, NTOK = 33280, SEQ = 8192, DSEQ = 64, PAST = 4096, SKV = 4160, NKV = 66048, DFF = 5632;
constexpr int NH = 16, DQK = 192, QLORA = 512, KVLORA = 256;
constexpr int NSLOT = 12;
constexpr int NWAVES = 8;
constexpr float EPS = 1e-6f;
constexpr int NGRP = 128, NSUB = 2304;

constexpr size_t O_Y = 0, O_CKVP = 68157440, O_KRP = 84934656, O_CKVS = 89128960, O_KRS = 89391104, O_REP = 89456640, O_IMP = 89522176,
                 O_RES = 89587712, O_IMS = 89718784, O_CONVP = 89849856, O_CONVS = 90030080, O_END = 90390528;

constexpr size_t MiB = 1u << 20;
constexpr size_t WS_CTL = 0, CTL_ZERO_BYTES = 1 * MiB, WS_ZGATE = 128 * 1024;
constexpr size_t WS_MOD = 1 * MiB;
constexpr size_t WS_A16 = 4 * MiB;
constexpr size_t WS_KRSS = 5 * MiB;
constexpr size_t WS_ROPE = 6 * MiB;
constexpr size_t WS_W = 8 * MiB;
constexpr size_t WSZ_DQKV = 4 * MiB, WSZ_UQ = 3 * MiB, WSZ_UKV = 2 * MiB, WSZ_WO = 8 * MiB, WSZ_MLA = 17 * MiB;
constexpr size_t WS_MLA = WS_W;
constexpr size_t WSZ_GG = 16 * MiB, WSZ_BTY = 24 * MiB, WSZ_BTX = 16 * MiB, WSZ_S5 = 56 * MiB;
constexpr size_t WS_S5 = WS_MLA + 2 * WSZ_MLA;
constexpr size_t WSZ_FF1 = 22 * MiB, WSZ_FFN = 66 * MiB;
constexpr size_t WS_FFN = WS_S5 + 2 * WSZ_S5;
constexpr size_t WS_H = WS_FFN + 4 * WSZ_FFN;
constexpr size_t WS_XB = WS_H + 130 * MiB;
constexpr size_t WS_BIG = WS_XB + 130 * MiB;
constexpr size_t OY_QA = 0;
constexpr size_t OY_CKV = 33 * MiB;
constexpr size_t OY_STATQ = 100 * MiB;
constexpr size_t OY_RSTDQ = 102 * MiB;
constexpr size_t OY_R = 66 * MiB;
constexpr size_t WS_Q = WS_BIG;
constexpr size_t WS_KB = WS_Q + 195 * MiB;
constexpr size_t WS_QKVA = WS_KB;
constexpr size_t WS_G = WS_BIG;
constexpr size_t WS_HID = WS_BIG + 358 * MiB;
constexpr size_t WS_PART = WS_BIG + 716 * MiB;
constexpr size_t WS_PGU = WS_BIG + 764 * MiB;
constexpr size_t WS_UP = WS_BIG;
constexpr size_t WS_XLOC = WS_BIG + 216 * MiB;
constexpr size_t WS_END = WS_KB + 645 * MiB;
static_assert(WS_END <= 1536 * MiB, "workspace map");
static_assert(WS_HID + 358 * MiB <= WS_PART && WS_PART + 48 * MiB <= WS_PGU && WS_PGU + 48 * MiB <= WS_END && WS_XLOC + 144 * MiB <= WS_PART, "aliases");

constexpr int RING_BYTES = 131072;
constexpr int MISC_OFF = RING_BYTES;
constexpr int PAR_OFF = RING_BYTES + 1024 + 4096;
constexpr int LDS_BYTES = RING_BYTES + 1024 + 4096 + 2048;

#define RLX_AGENT __ATOMIC_RELAXED, __HIP_MEMORY_SCOPE_AGENT
#define LDS_WAIT() asm volatile("s_waitcnt lgkmcnt(0)" ::: "memory")
#define VM_WAIT() asm volatile("s_waitcnt vmcnt(0)" ::: "memory")

__device__ __forceinline__ unsigned cvt_pk_bf16(float lo, float hi) { unsigned r; asm volatile("v_cvt_pk_bf16_f32 %0, %1, %2" : "=v"(r) : "v"(lo), "v"(hi)); return r; }
__device__ __forceinline__ float bf_lo(unsigned w) { return __uint_as_float(w << 16); }
__device__ __forceinline__ float bf_hi(unsigned w) { return __uint_as_float(w & 0xffff0000u); }
__device__ __forceinline__ float bf1(bf16_t b) { return __uint_as_float(((unsigned)b) << 16); }
__device__ __forceinline__ float shx(float v, int m, int lane) { return __int_as_float(__builtin_amdgcn_ds_bpermute((lane ^ m) << 2, __float_as_int(v))); }
template <int CTRL> __device__ __forceinline__ float dpp_rotf(float v) { return __int_as_float(__builtin_amdgcn_mov_dpp(__float_as_int(v), CTRL, 0xF, 0xF, true)); }
__device__ __forceinline__ float row_sum16(float v) { v += dpp_rotf<0x128>(v); v += dpp_rotf<0x124>(v); v += dpp_rotf<0x122>(v); v += dpp_rotf<0x121>(v); return v; }
__device__ __forceinline__ float wave_sum(float v, int lane) { (void)lane;
    v = row_sum16(v);
    const float s0 = __int_as_float(__builtin_amdgcn_readlane(__float_as_int(v), 0)), s1 = __int_as_float(__builtin_amdgcn_readlane(__float_as_int(v), 16)),
                s2 = __int_as_float(__builtin_amdgcn_readlane(__float_as_int(v), 32)), s3 = __int_as_float(__builtin_amdgcn_readlane(__float_as_int(v), 48));
    return (s0 + s1) + (s2 + s3);
}
__device__ __forceinline__ float sum16(float v, int lane) { (void)lane; return row_sum16(v); }
__device__ __forceinline__ float sum16_old(float v, int lane) {
#pragma unroll
    for (int o = 1; o < 16; o <<= 1) v += shx(v, o, lane);
    return v;
}
__device__ __forceinline__ int slot_of_row(int r) { return r < NPROMPT ? (r >> 13) : 4 + ((r - NPROMPT) >> 6); }
__device__ __forceinline__ float fast_sigmoid(float x) { return __builtin_amdgcn_rcpf(1.0f + __builtin_amdgcn_exp2f(-1.4426950408889634f * x)); }

#ifndef GEMM_SP2
#define GEMM_SP2 true
#endif
namespace pg8 {
constexpr int BM = 256, BK = 64, HALF = 128, HTB = HALF * BK * 2, STAGE_BYTES = 8 * HTB, NXCD = 8, WGM = 8;
__host__ __device__ __forceinline__ int lds_byte(int r, int c) { const int st = (r >> 4) * 2 + (c >> 5), rr = r & 15, cc = c & 31, ob = rr * 64 + cc * 2; return st * 1024 + (ob ^ (((ob >> 9) & 1) << 5)); }
__host__ __device__ __forceinline__ void stage_rc(int b, int& R, int& C) { const int st = b / 1024, sb = b % 1024, swz = sb ^ (((sb >> 9) & 1) << 5); R = (st >> 1) * 16 + swz / 64; C = (st & 1) * 32 + (swz % 64) / 2; }
__host__ __device__ __forceinline__ int perm32(int rho) { const int n = rho >> 4, i = rho & 15; return 8 * (i >> 2) + 4 * n + (i & 3); }

struct Unit { int pm, pn, ks; size_t koff; };
struct Gemm { const bf16_t* A; const bf16_t* Bt; int lda, ldb, K; size_t ksA, ksB, tsA, tsB; };
__device__ __forceinline__ Gemm gemm_rm(const bf16_t* A, const bf16_t* Bt, int lda, int ldb, int K) { return Gemm{A, Bt, lda, ldb, K, 128, 128, (size_t)512 * lda, (size_t)512 * ldb}; }
__device__ __forceinline__ size_t tiled_off(int row, int col, int nkt) { return (((size_t)(row >> 8) * nkt + (col >> 6)) * 256 + (row & 255)) * 64 + (col & 63); }

struct StaticOrder {
    int nM, nN, nwg, G, c;
    __device__ void init(int nM_, int nN_, int G_, int c_) { nM = nM_; nN = nN_; nwg = nM * nN; G = G_; c = c_; }
    __device__ bool next(int i, Unit& u) const {
        const long L = (long)i * G + c; if (L >= nwg) return false;
        int wgid = (int)L; { const int q = nwg / NXCD, r = nwg % NXCD, xcd = wgid % NXCD, off = wgid / NXCD; wgid = (xcd < r ? xcd * (q + 1) : r * (q + 1) + (xcd - r) * q) + off; }
        const int nig = WGM * nN, gid = wgid / nig, fm = gid * WGM, gsz = (nM - fm) < WGM ? (nM - fm) : WGM;
        u.pm = fm + ((wgid % nig) % gsz); u.pn = (wgid % nig) / gsz; u.ks = 0; u.koff = 0; return true;
    }
};
struct SplitOrder {
    int c, nN, nsplit; size_t kbytes;
    __device__ bool next(int i, Unit& u) const { if (i > 0 || c >= 2 * nN * nsplit) return false; const int ks = c % nsplit, t = c / nsplit; u.pm = 128 + t / nN; u.pn = t % nN; u.ks = ks; u.koff = ks * kbytes; return true; }
};
struct GroupOrder {
    int G, c;
    __device__ bool next(int i, Unit& u) const { const int L = i * G + c; if (L >= NGRP * 9) return false; const int g = L < NGRP * 8 ? L >> 3 : L - NGRP * 8, p = L < NGRP * 8 ? (L & 7) : 8;
        u.pm = 9 * g + p; u.pn = g; u.ks = 0; u.koff = 0; return true; }
};

template <class Epi, class Sched, bool ALIGN_EPI, bool SP2 = GEMM_SP2>
__device__ __forceinline__ void gemm_phase(LAS unsigned char* lds, const Gemm g, const Sched& S, const Epi& E, const int tid) {
    const int wid = __builtin_amdgcn_readfirstlane(tid >> 6), lane = tid & 63, wr = wid >> 2, wc = wid & 3, fr = lane & 15, fq = lane >> 4;
    const int K = g.K, nt = K / BK;
    unsigned voffA[2], voffB[2];
#pragma unroll
    for (int i = 0; i < 2; ++i) { int R, C; stage_rc(tid * 16 + i * 8192, R, C); const int Rb = Epi::PERM ? ((R & ~31) + perm32(R & 31)) : R;
        const int Ra = Epi::PERMA ? ((R & ~63) + ((R & 15) << 2) + ((R >> 4) & 3)) : R;
        voffA[i] = (unsigned)(Ra * g.lda + C) * 2u; voffB[i] = (unsigned)(Rb * g.ldb + C) * 2u; }
    const size_t kstepA = g.ksA, kstepB = g.ksB;
    const size_t hstepA = (size_t)HALF * g.lda * 2, hstepB = (size_t)HALF * g.ldb * 2;
    const size_t tstepA = g.tsA, tstepB = g.tsB;
    const unsigned ldsw = (unsigned)wid * 1024u;
    const int aoff = lds_byte(wr * 64 + fr, fq * 8), boff = lds_byte(wc * 32 + fr, fq * 8);
#define PG8_SA(b, h) (((b) * 2 + (h)) * HTB)
#define PG8_SB(b, h) ((4 + (b) * 2 + (h)) * HTB)
#define PG8_STAGE(bufoff, gbase, voff) do { _Pragma("unroll") for (int _i = 0; _i < 2; ++_i) \
        __builtin_amdgcn_global_load_lds((const unsigned*)((const char*)(gbase) + (voff)[_i]), (LAS unsigned*)(lds + (bufoff) + ldsw + _i * 8192), 16, 0, 0); } while (0)
#define PG8_LDA(dst, b, h) do { _Pragma("unroll") for (int m = 0; m < 4; ++m) _Pragma("unroll") for (int k = 0; k < 2; ++k) dst[m][k] = *(const LAS bf16x8*)(lds + PG8_SA(b, h) + aoff + m * 2048 + k * 1024); } while (0)
#define PG8_LDB(dst, b, h) do { _Pragma("unroll") for (int n = 0; n < 2; ++n) _Pragma("unroll") for (int k = 0; k < 2; ++k) dst[n][k] = *(const LAS bf16x8*)(lds + PG8_SB(b, h) + boff + n * 2048 + k * 1024); } while (0)
#define PG8_MMA(ai, bj, At, Bt) do { __builtin_amdgcn_s_setprio(1); _Pragma("unroll") for (int m = 0; m < 4; ++m) _Pragma("unroll") for (int n = 0; n < 2; ++n) _Pragma("unroll") for (int k = 0; k < 2; ++k) \
        acc[ai][bj][m][n] = __builtin_amdgcn_mfma_f32_16x16x32_bf16(Bt[n][k], At[m][k], acc[ai][bj][m][n], 0, 0, 0); __builtin_amdgcn_s_setprio(0); } while (0)
#define PG8_WAIT_V(n) asm volatile("s_waitcnt vmcnt(" #n ")" ::: "memory")
#define PG8_WAIT_L(n) asm volatile("s_waitcnt lgkmcnt(" #n ")" ::: "memory")
#define PG8_WAIT_VP(n) do { if constexpr (Epi::NPRE == 0) { PG8_WAIT_V(n); } else { static_assert(Epi::NPRE == 1 && n == 8, "counts"); if (pf) PG8_WAIT_V(9); else PG8_WAIT_V(8); } } while (0)
#define PG8_BAR __builtin_amdgcn_s_barrier()
#define PG8_SCHED __builtin_amdgcn_sched_barrier(0)
    Unit cur, nxt; int ui = 0;
    if (!S.next(0, cur)) return;
    f32x4 acc[2][2][4][2];
#pragma unroll
    for (int a = 0; a < 2; ++a)
#pragma unroll
        for (int b = 0; b < 2; ++b)
#pragma unroll
            for (int m = 0; m < 4; ++m)
#pragma unroll
                for (int n = 0; n < 2; ++n) acc[a][b][m][n] = (f32x4){0.f, 0.f, 0.f, 0.f};
    bf16x8 At[4][2], B0[2][2], B1[2][2];
    const char* cA = (const char*)g.A + (size_t)cur.pm * tstepA + cur.koff; const char* cB = (const char*)g.Bt + (size_t)cur.pn * tstepB + cur.koff;
    if constexpr (SP2) {
    PG8_STAGE(PG8_SB(0, 0), cB, voffB); PG8_STAGE(PG8_SB(0, 1), cB + hstepB, voffB); PG8_STAGE(PG8_SA(0, 0), cA, voffA); PG8_STAGE(PG8_SA(0, 1), cA + hstepA, voffA);
    if (wr == 1) PG8_BAR;
    PG8_WAIT_V(2); PG8_BAR;
    PG8_STAGE(PG8_SB(1, 0), cB + kstepB, voffB); PG8_STAGE(PG8_SA(1, 0), cA + kstepA, voffA); PG8_STAGE(PG8_SB(1, 1), cB + hstepB + kstepB, voffB);
    PG8_WAIT_V(6); PG8_BAR;
    } else {
    PG8_STAGE(PG8_SB(0, 0), cB, voffB); PG8_STAGE(PG8_SA(0, 0), cA, voffA); PG8_STAGE(PG8_SB(0, 1), cB + hstepB, voffB); PG8_STAGE(PG8_SA(0, 1), cA + hstepA, voffA);
    if (wr == 1) PG8_BAR;
    PG8_WAIT_V(4); PG8_BAR;
    PG8_STAGE(PG8_SB(1, 0), cB + kstepB, voffB); PG8_STAGE(PG8_SA(1, 0), cA + kstepA, voffA); PG8_STAGE(PG8_SB(1, 1), cB + hstepB + kstepB, voffB);
    PG8_WAIT_V(6); PG8_BAR;
    }
    for (;;) {
        const bool has_next = S.next(ui + 1, nxt);
        const char* nA = has_next ? (const char*)g.A + (size_t)nxt.pm * tstepA + nxt.koff : cA; const char* nB = has_next ? (const char*)g.Bt + (size_t)nxt.pn * tstepB + nxt.koff : cB;
#pragma unroll 1
        for (int t = 0; t < nt; t += 2) {
            const bool last = (t == nt - 2);
            const char* a1 = cA + (size_t)(t + 1) * kstepA;
            const char* a2 = last ? nA : cA + (size_t)(t + 2) * kstepA; const char* b2 = last ? nB : cB + (size_t)(t + 2) * kstepB;
            const char* a3 = a2 + kstepA; const char* b3 = b2 + kstepB;
            const bool pf = Epi::NPRE > 0 && (t == nt - 4);
            if constexpr (Epi::NPRE > 0) { if (pf) E.prefetch(lds, cur, wid, lane); }
            if constexpr (SP2) {
            PG8_LDB(B0, 0, 0); PG8_LDB(B1, 0, 1); PG8_SCHED; PG8_LDA(At, 0, 0); PG8_STAGE(PG8_SA(1, 1), a1 + hstepA, voffA);
            PG8_WAIT_VP(8); PG8_WAIT_L(0); PG8_BAR; PG8_MMA(0, 0, At, B0); PG8_MMA(0, 1, At, B1); PG8_BAR; PG8_SCHED;
            PG8_LDA(At, 0, 1); PG8_STAGE(PG8_SB(0, 0), b2, voffB); PG8_STAGE(PG8_SB(0, 1), b2 + hstepB, voffB); PG8_STAGE(PG8_SA(0, 0), a2, voffA);
            PG8_WAIT_VP(8); PG8_WAIT_L(0); PG8_BAR; PG8_MMA(1, 0, At, B0); PG8_MMA(1, 1, At, B1); PG8_BAR; PG8_SCHED;
            PG8_LDB(B0, 1, 0); PG8_LDB(B1, 1, 1); PG8_SCHED; PG8_LDA(At, 1, 0); PG8_STAGE(PG8_SA(0, 1), a2 + hstepA, voffA);
            PG8_WAIT_VP(8); PG8_WAIT_L(0); PG8_BAR; PG8_MMA(0, 0, At, B0); PG8_MMA(0, 1, At, B1); PG8_BAR; PG8_SCHED;
            PG8_LDA(At, 1, 1); PG8_STAGE(PG8_SB(1, 0), b3, voffB); PG8_STAGE(PG8_SB(1, 1), b3 + hstepB, voffB); PG8_STAGE(PG8_SA(1, 0), a3, voffA);
            PG8_WAIT_VP(8); PG8_WAIT_L(0); PG8_BAR; PG8_MMA(1, 0, At, B0); PG8_MMA(1, 1, At, B1); PG8_BAR; PG8_SCHED;
            } else {
            PG8_LDB(B0, 0, 0); PG8_SCHED; PG8_LDA(At, 0, 0); PG8_STAGE(PG8_SA(1, 1), a1 + hstepA, voffA);
            PG8_WAIT_L(8); PG8_BAR; PG8_WAIT_L(0); PG8_MMA(0, 0, At, B0); PG8_BAR; PG8_SCHED;
            PG8_LDB(B1, 0, 1); PG8_STAGE(PG8_SB(0, 0), b2, voffB);
            PG8_BAR; PG8_WAIT_L(0); PG8_MMA(0, 1, At, B1); PG8_BAR;
            PG8_LDA(At, 0, 1); PG8_STAGE(PG8_SA(0, 0), a2, voffA);
            PG8_BAR; PG8_WAIT_L(0); PG8_MMA(1, 0, At, B0); PG8_BAR; PG8_SCHED;
            PG8_STAGE(PG8_SB(0, 1), b2 + hstepB, voffB);
            PG8_WAIT_V(6); PG8_BAR; PG8_MMA(1, 1, At, B1); PG8_BAR;
            PG8_LDB(B0, 1, 0); PG8_SCHED; PG8_LDA(At, 1, 0); PG8_STAGE(PG8_SA(0, 1), a2 + hstepA, voffA);
            PG8_WAIT_L(8); PG8_BAR; PG8_WAIT_L(0); PG8_MMA(0, 0, At, B0); PG8_BAR; PG8_SCHED;
            PG8_LDB(B1, 1, 1); PG8_STAGE(PG8_SB(1, 0), b3, voffB);
            PG8_BAR; PG8_WAIT_L(0); PG8_MMA(0, 1, At, B1); PG8_BAR;
            PG8_LDA(At, 1, 1); PG8_STAGE(PG8_SA(1, 0), a3, voffA);
            PG8_BAR; PG8_WAIT_L(0); PG8_MMA(1, 0, At, B0); PG8_BAR; PG8_SCHED;
            PG8_STAGE(PG8_SB(1, 1), b3 + hstepB, voffB);
            PG8_WAIT_V(6); PG8_BAR; PG8_MMA(1, 1, At, B1); PG8_BAR;
            }
        }
        if constexpr (ALIGN_EPI) { if (wr == 0) PG8_BAR; }
        E(acc, cur, wr, wc, fr, fq);
        if (!has_next) break;
#pragma unroll
        for (int a = 0; a < 2; ++a)
#pragma unroll
            for (int b = 0; b < 2; ++b)
#pragma unroll
                for (int m = 0; m < 4; ++m)
#pragma unroll
                    for (int n = 0; n < 2; ++n) acc[a][b][m][n] = (f32x4){0.f, 0.f, 0.f, 0.f};
        cur = nxt; cA = nA; cB = nB; ++ui;
        if constexpr (ALIGN_EPI) { if (wr == 1) PG8_BAR; }
    }
    PG8_WAIT_V(0);
    if constexpr (!ALIGN_EPI) { if (wr == 0) PG8_BAR; }
    PG8_BAR;
#undef PG8_SA
#undef PG8_SB
#undef PG8_STAGE
#undef PG8_LDA
#undef PG8_LDB
#undef PG8_MMA
#undef PG8_WAIT_V
#undef PG8_WAIT_VP
#undef PG8_WAIT_L
#undef PG8_BAR
#undef PG8_SCHED
}

typedef f32x4 Acc[2][2][4][2];

struct EpiF32 {
    static constexpr int NPRE = 0; static constexpr bool PERMA = false;
    static constexpr bool PERM = false;
    float* C; int ldc;
    __device__ __forceinline__ void operator()(const Acc& acc, const Unit& u, int wr, int wc, int fr, int fq) const {
        const int row0 = u.pm * BM + wr * 64 + fr, col0 = u.pn * BM + wc * 32 + 4 * fq;
#pragma unroll
        for (int ai = 0; ai < 2; ++ai)
#pragma unroll
            for (int m = 0; m < 4; ++m) { float* rowp = C + (size_t)(row0 + ai * HALF + m * 16) * ldc + col0;
#pragma unroll
                for (int bj = 0; bj < 2; ++bj)
#pragma unroll
                    for (int n = 0; n < 2; ++n) *(f32x4*)(rowp + bj * HALF + n * 16) = acc[ai][bj][m][n]; }
    }
};
__device__ __forceinline__ u32x4 pack8(const f32x4& v0, const f32x4& v1) { u32x4 w; w.x = cvt_pk_bf16(v0[0], v0[1]); w.y = cvt_pk_bf16(v0[2], v0[3]); w.z = cvt_pk_bf16(v1[0], v1[1]); w.w = cvt_pk_bf16(v1[2], v1[3]); return w; }
struct EpiBf16 {
    static constexpr int NPRE = 0; static constexpr bool PERMA = false;
    static constexpr bool PERM = true;
    bf16_t* O; int ldc; const float* rs;
    __device__ __forceinline__ void operator()(const Acc& acc, const Unit& u, int wr, int wc, int fr, int fq) const {
        const int row0 = u.pm * BM + wr * 64 + fr, col0 = u.pn * BM + wc * 32 + 8 * fq;
        float sc[2][4];
#pragma unroll
        for (int ai = 0; ai < 2; ++ai)
#pragma unroll
            for (int m = 0; m < 4; ++m) sc[ai][m] = rs[row0 + ai * HALF + m * 16];
#pragma unroll
        for (int ai = 0; ai < 2; ++ai)
#pragma unroll
            for (int m = 0; m < 4; ++m) { bf16_t* rowp = O + (size_t)(row0 + ai * HALF + m * 16) * ldc + col0;
#pragma unroll
                for (int bj = 0; bj < 2; ++bj) *(u32x4*)(rowp + bj * HALF) = pack8(acc[ai][bj][m][0] * sc[ai][m], acc[ai][bj][m][1] * sc[ai][m]); }
    }
};
struct EpiA1 {
    static constexpr int NPRE = 0; static constexpr bool PERMA = false;
    static constexpr bool PERM = true;
    float* C; bf16_t* Q; float* stat;
    __device__ __forceinline__ void operator()(const Acc& acc, const Unit& u, int wr, int wc, int fr, int fq) const {
        const int lane = fr + 16 * fq;
        const int row0 = u.pm * BM + wr * 64 + fr, col0 = u.pn * BM + wc * 32 + 8 * fq;
        if (u.pn < 2) {
#pragma unroll
            for (int ai = 0; ai < 2; ++ai)
#pragma unroll
                for (int m = 0; m < 4; ++m) { const int row = row0 + ai * HALF + m * 16; float ss = 0.f;
#pragma unroll
                    for (int bj = 0; bj < 2; ++bj) { const f32x4 a = acc[ai][bj][m][0], b = acc[ai][bj][m][1];
                        *(u32x4*)(Q + (size_t)row * QLORA + col0 + bj * HALF) = pack8(a, b);
                        ss += ((a[0] * a[0] + a[1] * a[1]) + (a[2] * a[2] + a[3] * a[3])) + ((b[0] * b[0] + b[1] * b[1]) + (b[2] * b[2] + b[3] * b[3])); }
                    ss += shx(ss, 16, lane); ss += shx(ss, 32, lane);
                    if (fq == 0) stat[(size_t)row * 8 + u.pn * 4 + wc] = ss; }
        } else {
#pragma unroll
            for (int ai = 0; ai < 2; ++ai)
#pragma unroll
                for (int m = 0; m < 4; ++m) { float* rowp = C + (size_t)(row0 + ai * HALF + m * 16) * 1024 + col0;
#pragma unroll
                    for (int bj = 0; bj < 2; ++bj) { *(f32x4*)(rowp + bj * HALF) = acc[ai][bj][m][0]; *(f32x4*)(rowp + bj * HALF + 4) = acc[ai][bj][m][1]; } }
        }
    }
};
struct EpiKV {
    static constexpr int NPRE = 0; static constexpr bool PERMA = false;
    static constexpr bool PERM = true;
    bf16_t* KV; const float* krss; const float* R; const float* gkn; LAS float* scr;
    __device__ __forceinline__ void operator()(const Acc& acc, const Unit& u, int wr, int wc, int fr, int fq) const {
        const int lane = fr + 16 * fq;
#pragma unroll
        for (int ai = 0; ai < 2; ++ai)
#pragma unroll
            for (int m = 0; m < 4; ++m) { const f32x4 a = acc[ai][0][m][0], b = acc[ai][0][m][1];
                float s = (a[0] * a[0] + a[1] * a[1]) + (a[2] * a[2] + a[3] * a[3]) + (b[0] * b[0] + b[1] * b[1]) + (b[2] * b[2] + b[3] * b[3]);
                s += shx(s, 16, lane); s += shx(s, 32, lane);
                if (fq == 0) scr[(ai * HALF + wr * 64 + m * 16 + fr) * 4 + wc] = s; }
        const int row0 = u.pm * BM + wr * 64 + fr;
        bf16_t* base = KV + (size_t)row0 * 5120 + u.pn * 320;
        const f32x4 g0 = *(const f32x4*)(gkn + wc * 32 + 8 * fq), g1 = *(const f32x4*)(gkn + wc * 32 + 8 * fq + 4);
        float kr[2][4]; f32x4 rv[2][4];
#pragma unroll
        for (int ai = 0; ai < 2; ++ai)
#pragma unroll
            for (int m = 0; m < 4; ++m) { const size_t row = (size_t)(row0 + ai * HALF + m * 16); kr[ai][m] = krss[row]; rv[ai][m] = *(const f32x4*)(R + row * 64 + wc * 16 + 4 * fq); }
        asm volatile("s_waitcnt lgkmcnt(0)\n\ts_barrier" ::: "memory");
#pragma unroll
        for (int ai = 0; ai < 2; ++ai)
#pragma unroll
            for (int m = 0; m < 4; ++m) { const int rl = ai * HALF + m * 16;
                const f32x4 sp = *(const LAS f32x4*)(scr + (rl + wr * 64 + fr) * 4);
                const float r = 1.0f / sqrtf(((sp[0] + sp[1]) + (sp[2] + sp[3]) + kr[ai][m]) * (1.0f / 192.0f) + EPS);
                bf16_t* rowp = base + (size_t)rl * 5120;
                *(u32x4*)(rowp + wc * 32 + 8 * fq) = pack8(acc[ai][0][m][0] * g0 * r, acc[ai][0][m][1] * g1 * r);
                *(u32x4*)(rowp + 192 + wc * 32 + 8 * fq) = pack8(acc[ai][1][m][0], acc[ai][1][m][1]);
                const f32x4 rr = rv[ai][m] * r;
                u32x2 w; w.x = cvt_pk_bf16(rr[0], rr[1]); w.y = cvt_pk_bf16(rr[2], rr[3]);
                *(u32x2*)(rowp + 128 + wc * 16 + 4 * fq) = w; }
    }
};
struct EpiResid {
    static constexpr int NPRE = 0; static constexpr bool PERMA = false;
    static constexpr bool PERM = true;
    const float* xin32; float* xout32; bf16_t* xb; const float* gate; int inf32, outf32;
    __device__ __forceinline__ void operator()(const Acc& acc, const Unit& u, int wr, int wc, int fr, int fq) const {
        const int col0 = u.pn * BM + wc * 32 + 8 * fq;
#pragma unroll
        for (int ai = 0; ai < 2; ++ai) {
            const int rbase = u.pm * BM + ai * HALF + wr * 64; const float* gp = gate + (size_t)slot_of_row(rbase) * 12288 + col0;
            const size_t off0 = (size_t)(rbase + fr) * DM + col0;
            f32x4 xi[4][2][2];
            if (inf32) {
#pragma unroll
                for (int m = 0; m < 4; ++m)
#pragma unroll
                    for (int bj = 0; bj < 2; ++bj)
#pragma unroll
                        for (int n = 0; n < 2; ++n) xi[m][bj][n] = *(const f32x4*)(xin32 + off0 + (size_t)m * 16 * DM + bj * HALF + n * 4);
            } else { u32x4 xr[4][2];
#pragma unroll
                for (int m = 0; m < 4; ++m)
#pragma unroll
                    for (int bj = 0; bj < 2; ++bj) xr[m][bj] = *(const u32x4*)(xb + off0 + (size_t)m * 16 * DM + bj * HALF);
#pragma unroll
                for (int m = 0; m < 4; ++m)
#pragma unroll
                    for (int bj = 0; bj < 2; ++bj) { xi[m][bj][0] = (f32x4){bf_lo(xr[m][bj].x), bf_hi(xr[m][bj].x), bf_lo(xr[m][bj].y), bf_hi(xr[m][bj].y)}; xi[m][bj][1] = (f32x4){bf_lo(xr[m][bj].z), bf_hi(xr[m][bj].z), bf_lo(xr[m][bj].w), bf_hi(xr[m][bj].w)}; } }
            f32x4 gv[2][2];
#pragma unroll
            for (int bj = 0; bj < 2; ++bj)
#pragma unroll
                for (int n = 0; n < 2; ++n) gv[bj][n] = *(const f32x4*)(gp + bj * HALF + n * 4);
#pragma unroll
            for (int m = 0; m < 4; ++m)
#pragma unroll
                for (int bj = 0; bj < 2; ++bj) { const f32x4 x0 = xi[m][bj][0] + gv[bj][0] * acc[ai][bj][m][0], x1 = xi[m][bj][1] + gv[bj][1] * acc[ai][bj][m][1]; const size_t o = off0 + (size_t)m * 16 * DM + bj * HALF;
                    if (outf32) { *(f32x4*)(xout32 + o) = x0; *(f32x4*)(xout32 + o + 4) = x1; } else *(u32x4*)(xb + o) = pack8(x0, x1); }
            asm volatile("" ::: "memory");
        }
    }
};
struct EpiGlu {
    static constexpr int NPRE = 0; static constexpr bool PERMA = false;
    static constexpr bool PERM = true;
    bf16_t* xb; const float* gate;
    __device__ __forceinline__ void operator()(const Acc& acc, const Unit& u, int wr, int wc, int fr, int fq) const {
        const int col0 = u.pn * HALF + wc * 32 + 8 * fq;
        u32x4 xr[2][4];
#pragma unroll
        for (int ai = 0; ai < 2; ++ai)
#pragma unroll
            for (int m = 0; m < 4; ++m) xr[ai][m] = *(const u32x4*)(xb + (size_t)(u.pm * BM + ai * HALF + wr * 64 + m * 16 + fr) * DM + col0);
#pragma unroll
        for (int ai = 0; ai < 2; ++ai) {
            const int rbase = u.pm * BM + ai * HALF + wr * 64; const float* gp = gate + (size_t)slot_of_row(rbase) * 12288 + col0;
            f32x4 gv[2];
#pragma unroll
            for (int n = 0; n < 2; ++n) gv[n] = *(const f32x4*)(gp + n * 4);
#pragma unroll
            for (int m = 0; m < 4; ++m) { const size_t off = (size_t)(rbase + m * 16 + fr) * DM + col0; f32x4 o[2];
#pragma unroll
                for (int n = 0; n < 2; ++n) { const f32x4 a = acc[ai][0][m][n], b = acc[ai][1][m][n]; const unsigned lo = n == 0 ? xr[ai][m].x : xr[ai][m].z, hi = n == 0 ? xr[ai][m].y : xr[ai][m].w;
                    const f32x4 xi = (f32x4){bf_lo(lo), bf_hi(lo), bf_lo(hi), bf_hi(hi)};
#pragma unroll
                    for (int j = 0; j < 4; ++j) o[n][j] = xi[j] + gv[n][j] * a[j] * fast_sigmoid(b[j]); }
                *(u32x4*)(xb + off) = pack8(o[0], o[1]); }
        }
    }
};
struct EpiGate {
    static constexpr int NPRE = 0; static constexpr bool PERMA = false;
    static constexpr bool PERM = true;
    bf16_t* G; float* convp; float* convs;
    __device__ __forceinline__ void operator()(const Acc& acc, const Unit& u, int wr, int wc, int fr, int fq) const {
        const int col0 = u.pn * BM + wc * 32 + 8 * fq;
#pragma unroll
        for (int ai = 0; ai < 2; ++ai) {
            const int rbase = u.pm * BM + ai * HALF + wr * 64; const int slot = slot_of_row(rbase);
#pragma unroll
            for (int m = 0; m < 4; ++m) { const int row = rbase + m * 16 + fr; bf16_t* rowp = G + (size_t)(row + 2 * (slot + 1)) * DFF + col0;
#pragma unroll
                for (int bj = 0; bj < 2; ++bj) *(u32x4*)(rowp + bj * HALF) = pack8(acc[ai][bj][m][0], acc[ai][bj][m][1]);
                if (m == 3 && fr >= 14) {
                    const bool lastp = (slot < 4) && ((row & (SEQ - 1)) >= SEQ - 2); const bool lasts = (slot >= 4);
                    if (lastp || lasts) { float* cp = (slot < 4 ? convp + (size_t)(slot * 2 + (row & 1)) * DFF : convs + (size_t)((slot - 4) * 2 + (row & 1)) * DFF) + col0;
#pragma unroll
                        for (int bj = 0; bj < 2; ++bj) { *(f32x4*)(cp + bj * HALF) = acc[ai][bj][m][0]; *(f32x4*)(cp + bj * HALF + 4) = acc[ai][bj][m][1]; } }
                }
            }
        }
    }
};
struct EpiUp {
    static constexpr int NPRE = 0; static constexpr bool PERMA = false;
    static constexpr bool PERM = true;
    const bf16_t* G; bf16_t* HID; const float* cw; const float* cb;
    __device__ __forceinline__ void operator()(const Acc& acc, const Unit& u, int wr, int wc, int fr, int fq) const {
        u32x4 ga[3], gb[3];
        const bf16_t* gbase = G + (size_t)(u.pm * BM + wr * 64 + fr) * DFF + u.pn * BM + wc * 32 + 8 * fq;
        const int sl0 = 2 * (slot_of_row(u.pm * BM + wr * 64) + 1), sl1 = 2 * (slot_of_row(u.pm * BM + HALF + wr * 64) + 1);
#define EU_LOAD(DST, B) do { const bf16_t* gp_ = gbase + (size_t)((((B) >> 2) & 1) * HALF + ((B) & 3) * 16 + ((((B) >> 2) & 1) ? sl1 : sl0)) * DFF + ((B) >> 3) * HALF; \
            DST[2] = *(const u32x4*)gp_; DST[1] = *(const u32x4*)(gp_ - DFF); DST[0] = *(const u32x4*)(gp_ - 2 * DFF); } while (0)
#define EU_COMP(SRC, B) do { constexpr int bj_ = (B) >> 3, ai_ = ((B) >> 2) & 1, m_ = (B) & 3; const int col_ = u.pn * BM + bj_ * HALF + wc * 32 + 8 * fq; \
            const int row_ = u.pm * BM + ai_ * HALF + wr * 64 + m_ * 16 + fr; float o_[8]; \
            _Pragma("unroll") for (int q = 0; q < 4; ++q) { \
                const float c0 = bb[2 * q] + w0[2 * q] * bf_lo(SRC[0][q]) + w1[2 * q] * bf_lo(SRC[1][q]) + w2[2 * q] * bf_lo(SRC[2][q]); \
                const float c1 = bb[2 * q + 1] + w0[2 * q + 1] * bf_hi(SRC[0][q]) + w1[2 * q + 1] * bf_hi(SRC[1][q]) + w2[2 * q + 1] * bf_hi(SRC[2][q]); \
                o_[2 * q] = c0 * fast_sigmoid(c0); o_[2 * q + 1] = c1 * fast_sigmoid(c1); } \
            const f32x4 a0 = acc[ai_][bj_][m_][0], a1 = acc[ai_][bj_][m_][1]; \
            u32x4 w_; w_.x = cvt_pk_bf16(o_[0] * a0[0], o_[1] * a0[1]); w_.y = cvt_pk_bf16(o_[2] * a0[2], o_[3] * a0[3]); w_.z = cvt_pk_bf16(o_[4] * a1[0], o_[5] * a1[1]); w_.w = cvt_pk_bf16(o_[6] * a1[2], o_[7] * a1[3]); \
            *(u32x4*)(HID + tiled_off(row_, col_, DFF / 64)) = w_; } while (0)
#define EU_PARAMS(BJ) do { const int col_ = u.pn * BM + (BJ) * HALF + wc * 32 + 8 * fq; _Pragma("unroll") for (int h = 0; h < 2; ++h) { const f32x4 a = *(const f32x4*)(cw + col_ + 4 * h), b = *(const f32x4*)(cw + DFF + col_ + 4 * h), c = *(const f32x4*)(cw + 2 * DFF + col_ + 4 * h), d = *(const f32x4*)(cb + col_ + 4 * h); \
            _Pragma("unroll") for (int j = 0; j < 4; ++j) { w0[4 * h + j] = a[j]; w1[4 * h + j] = b[j]; w2[4 * h + j] = c[j]; bb[4 * h + j] = d[j]; } } } while (0)
#define EU_STEP2(B) do { EU_LOAD(gb, (B) + 1); asm volatile("" ::: "memory"); EU_COMP(ga, B); EU_LOAD(ga, (B) + 2); asm volatile("" ::: "memory"); EU_COMP(gb, (B) + 1); } while (0)
        float w0[8], w1[8], w2[8], bb[8];
        EU_LOAD(ga, 0); EU_PARAMS(0);
        EU_STEP2(0); EU_STEP2(2); EU_STEP2(4);
        EU_LOAD(gb, 7); asm volatile("" ::: "memory"); EU_COMP(ga, 6); EU_LOAD(ga, 8); asm volatile("" ::: "memory"); EU_COMP(gb, 7);
        EU_PARAMS(1);
        EU_STEP2(8); EU_STEP2(10); EU_STEP2(12);
        EU_LOAD(gb, 15); asm volatile("" ::: "memory"); EU_COMP(ga, 14); EU_COMP(gb, 15);
#undef EU_LOAD
#undef EU_COMP
#undef EU_PARAMS
#undef EU_STEP2
    }
};
template <int CTRL> __device__ __forceinline__ float dpp_upd(float old, float src) { return __int_as_float(__builtin_amdgcn_update_dpp(__float_as_int(old), __float_as_int(src), CTRL, 0xF, 0xF, false)); }
template <int CTRL> __device__ __forceinline__ float dpp_rot(float src) { return __int_as_float(__builtin_amdgcn_mov_dpp(__float_as_int(src), CTRL, 0xF, 0xF, true)); }
struct EpiFfn {
    static constexpr bool PERM = true; static constexpr bool PERMA = true;
    static constexpr int NPRE = 1;
    __device__ __forceinline__ void prefetch(LAS unsigned char* lds, const Unit& u, int wid, int lane) const { const int a = wid >> 1; const float* src = (a < 3 ? cw + (size_t)a * DFF : cb) + u.pn * HALF + (wid & 1) * 64 + lane;
        __builtin_amdgcn_global_load_lds((const unsigned*)src, (LAS unsigned*)(lds + PAR_OFF + wid * 256), 4, 0, 0); }
    bf16_t* HID; const float* cw; const float* cb; float* convp; float* gbnd; float* defc; float* defu; LAS float* scr;
    __device__ __forceinline__ void operator()(const Acc& acc, const Unit& u, int wr, int wc, int fr, int fq) const {
        const int ch0 = u.pn * HALF + wc * 32 + 8 * fq;
#pragma unroll
        for (int ai = 0; ai < 2; ++ai) { const int k = ai * 2 + wr;
            if (fr == 15) {
#pragma unroll
                for (int rr = 0; rr < 2; ++rr) {
                    if (k < 3) { LAS float* p = scr + ((((k * 4 + wc) * 4 + fq) * 2 + rr) * 8); *(LAS f32x4*)p = acc[ai][0][2 + rr][0]; *(LAS f32x4*)(p + 4) = acc[ai][0][2 + rr][1]; }
                    else { float* p = gbnd + (size_t)(u.pm * 2 + rr) * DFF + ch0; *(f32x4*)p = acc[ai][0][2 + rr][0]; *(f32x4*)(p + 4) = acc[ai][0][2 + rr][1];
                        if ((u.pm & 31) == 31) { float* cp = convp + (size_t)((u.pm >> 5) * 2 + rr) * DFF + ch0; *(f32x4*)cp = acc[ai][0][2 + rr][0]; *(f32x4*)(cp + 4) = acc[ai][0][2 + rr][1]; } } } } }
        float w0[8], w1[8], w2[8], bb[8];
        { const LAS float* par = (const LAS float*)((LAS unsigned char*)scr + 4096) + wc * 32 + 8 * fq;
#pragma unroll
        for (int h = 0; h < 2; ++h) { const f32x4 a = *(const LAS f32x4*)(par + 4 * h), b = *(const LAS f32x4*)(par + 128 + 4 * h), c = *(const LAS f32x4*)(par + 256 + 4 * h), d = *(const LAS f32x4*)(par + 384 + 4 * h);
#pragma unroll
            for (int j = 0; j < 4; ++j) { w0[4 * h + j] = -1.4426950408889634f * a[j]; w1[4 * h + j] = -1.4426950408889634f * b[j]; w2[4 * h + j] = -1.4426950408889634f * c[j]; bb[4 * h + j] = -1.4426950408889634f * d[j]; } } }
        asm volatile("s_waitcnt lgkmcnt(0)\n\ts_barrier" ::: "memory");
#pragma unroll
        for (int ai = 0; ai < 2; ++ai) { const int k = ai * 2 + wr;
            float bm1[8], bm2[8];
            if (k >= 1) { const LAS float* p = scr + ((((k - 1) * 4 + wc) * 4 + fq) * 2) * 8; const f32x4 a = *(const LAS f32x4*)p, b = *(const LAS f32x4*)(p + 4), c = *(const LAS f32x4*)(p + 8), d = *(const LAS f32x4*)(p + 12);
#pragma unroll
                for (int j = 0; j < 4; ++j) { bm2[j] = a[j]; bm2[4 + j] = b[j]; bm1[j] = c[j]; bm1[4 + j] = d[j]; } }
            else {
#pragma unroll
                for (int e = 0; e < 8; ++e) { bm1[e] = 0.f; bm2[e] = 0.f; } }
            float s3[8], s2[8];
#pragma unroll
            for (int n = 0; n < 2; ++n)
#pragma unroll
                for (int j = 0; j < 4; ++j) { const int e = 4 * n + j; s3[e] = dpp_upd<0x111>(bm1[e], acc[ai][0][3][n][j]); s2[e] = dpp_upd<0x111>(bm2[e], acc[ai][0][2][n][j]); }
#pragma unroll
            for (int m = 0; m < 4; ++m) { const int row = u.pm * BM + ai * HALF + wr * 64 + 4 * fr + m;
                float cc[8], o[8];
#pragma unroll
                for (int n = 0; n < 2; ++n)
#pragma unroll
                    for (int j = 0; j < 4; ++j) { const int e = 4 * n + j; const float g = acc[ai][0][m][n][j];
                        const float g1 = m == 0 ? s3[e] : acc[ai][0][m > 0 ? m - 1 : 0][n][j], g2 = m == 0 ? s2[e] : (m == 1 ? s3[e] : acc[ai][0][m > 1 ? m - 2 : 0][n][j]);
                        const float c = bb[e] + w0[e] * g2 + w1[e] * g1 + w2[e] * g; cc[e] = c; o[e] = c * __builtin_amdgcn_rcpf(1.0f + __builtin_amdgcn_exp2f(c)) * acc[ai][1][m][n][j]; }
                u32x4 w_; w_.x = cvt_pk_bf16(o[0], o[1]); w_.y = cvt_pk_bf16(o[2], o[3]); w_.z = cvt_pk_bf16(o[4], o[5]); w_.w = cvt_pk_bf16(o[6], o[7]);
                *(u32x4*)(HID + tiled_off(row, ch0, DFF / 64)) = w_;
                if (m < 2 && k == 0 && fr == 0) { float* pc = defc + (size_t)(u.pm * 2 + m) * DFF + ch0; float* pu = defu + (size_t)(u.pm * 2 + m) * DFF + ch0;
                    *(f32x4*)pc = (f32x4){cc[0], cc[1], cc[2], cc[3]}; *(f32x4*)(pc + 4) = (f32x4){cc[4], cc[5], cc[6], cc[7]}; *(f32x4*)pu = acc[ai][1][m][0]; *(f32x4*)(pu + 4) = acc[ai][1][m][1]; } }
        }
    }
};
struct EpiPartial {
    static constexpr int NPRE = 0; static constexpr bool PERMA = false;
    static constexpr bool PERM = false;
    float* P; int ldc;
    __device__ __forceinline__ void operator()(const Acc& acc, const Unit& u, int wr, int wc, int fr, int fq) const {
        const int row0 = (u.pm - 128) * BM + wr * 64 + fr, col0 = u.pn * BM + wc * 32 + 4 * fq;
        float* base = P + ((size_t)u.ks * 512 + row0) * ldc + col0;
#pragma unroll
        for (int ai = 0; ai < 2; ++ai)
#pragma unroll
            for (int m = 0; m < 4; ++m) { float* rowp = base + (size_t)(ai * HALF + m * 16) * ldc;
#pragma unroll
                for (int bj = 0; bj < 2; ++bj)
#pragma unroll
                    for (int n = 0; n < 2; ++n) *(f32x4*)(rowp + bj * HALF + n * 16) = acc[ai][bj][m][n]; }
    }
};
struct EpiXloc {
    static constexpr int NPRE = 0; static constexpr bool PERMA = false;
    static constexpr bool PERM = true;
    bf16_t* X;
    __device__ __forceinline__ void operator()(const Acc& acc, const Unit& u, int wr, int wc, int fr, int fq) const {
        const int row0 = u.pm * BM + wr * 64 + fr, col0 = wc * 32 + 8 * fq;
#pragma unroll
        for (int ai = 0; ai < 2; ++ai)
#pragma unroll
            for (int m = 0; m < 4; ++m) *(u32x4*)(X + (size_t)(row0 + ai * HALF + m * 16) * 128 + col0) = pack8(acc[ai][0][m][0], acc[ai][0][m][1]);
    }
};
struct EpiY {
    static constexpr int NPRE = 0; static constexpr bool PERMA = false;
    static constexpr bool PERM = true;
    const bf16_t* UP; bf16_t* Z; const float* Dv;
    __device__ __forceinline__ void operator()(const Acc& acc, const Unit& u, int wr, int wc, int fr, int fq) const {
        const int g = u.pn, cbase = (u.pm - 9 * g) * BM;
        const int q0 = (8 * fq) & 15;
        const f32x4 d0 = *(const f32x4*)(Dv + 16 * g + q0), d1 = *(const f32x4*)(Dv + 16 * g + q0 + 4);
#pragma unroll
        for (int ai = 0; ai < 2; ++ai) {
            const int c0 = cbase + ai * HALF + wr * 64 + fr;
            u32x4 uq[4][2];
#pragma unroll
            for (int m = 0; m < 4; ++m) { const int c = c0 + m * 16 < 2080 ? c0 + m * 16 : 2079;
#pragma unroll
                for (int bj = 0; bj < 2; ++bj) uq[m][bj] = *(const u32x4*)(UP + ((size_t)g * NSUB + c) * 384 + bj * HALF + wc * 32 + 8 * fq); }
#pragma unroll
            for (int m = 0; m < 4; ++m) { const int c = c0 + m * 16;
                if (c < 2080) {
#pragma unroll
                    for (int bj = 0; bj < 2; ++bj) { const int cc = bj * HALF + wc * 32 + 8 * fq; const int t = cc >> 4;
                        const u32x4 uu = uq[m][bj];
                        const f32x4 a0 = acc[ai][bj][m][0], a1 = acc[ai][bj][m][1];
                        float y[8];
                        y[0] = a0[0] + d0[0] * bf_lo(uu[0]); y[1] = a0[1] + d0[1] * bf_hi(uu[0]); y[2] = a0[2] + d0[2] * bf_lo(uu[1]); y[3] = a0[3] + d0[3] * bf_hi(uu[1]);
                        y[4] = a1[0] + d1[0] * bf_lo(uu[2]); y[5] = a1[1] + d1[1] * bf_hi(uu[2]); y[6] = a1[2] + d1[2] * bf_lo(uu[3]); y[7] = a1[3] + d1[3] * bf_hi(uu[3]);
#pragma unroll
                        for (int j = 0; j < 8; ++j) { const float v = y[j]; const float w2 = v * (-2.3022081983f + -0.1029432395f * (v * v)); y[j] = v * __builtin_amdgcn_rcpf(1.0f + __builtin_amdgcn_exp2f(w2)); }
                        u32x4 w; w.x = cvt_pk_bf16(y[0], y[1]); w.y = cvt_pk_bf16(y[2], y[3]); w.z = cvt_pk_bf16(y[4], y[5]); w.w = cvt_pk_bf16(y[6], y[7]);
                        *(u32x4*)(Z + (size_t)(16 * c + t) * DM + 16 * g + q0) = w; }
                } }
            asm volatile("" ::: "memory");
        }
    }
};
}

namespace att {
constexpr int SHM_V = 64 * 128 * 2, SHM_K = 64 * 384, OFF_V = 0, OFF_K = 3 * SHM_V, OFF_SCR = OFF_K + 3 * SHM_K, ATT_LDS = OFF_SCR + 8 * 256;
static_assert(ATT_LDS <= 131072, "attention LDS");
constexpr float THR2 = 11.54f;
#define SBAR() __builtin_amdgcn_sched_barrier(0)
__device__ __forceinline__ int crow(int r, int hi) { return (r & 3) + 8 * (r >> 2) + 4 * hi; }
__device__ __forceinline__ int kswz(int row, int c16) { return row * 384 + ((c16 ^ ((row >> 1) & 7)) << 4); }
template <bool FX> __device__ __forceinline__ void partialSM(f32x16& p0, f32x16& p1, float& m_reg, float& mn, float& alpha, bool vis) {
  if (!vis) {
#pragma unroll
    for (int r = 0; r < 16; ++r) { p0[r] = -__builtin_inff(); p1[r] = -__builtin_inff(); } }
  if constexpr (FX) { mn = 0.f; alpha = 1.f;
#pragma unroll
    for (int r = 0; r < 16; ++r) p0[r] = __builtin_amdgcn_exp2f(p0[r]);
    return; }
  float pmax = p0[0];
#pragma unroll
  for (int r = 1; r < 16; ++r) pmax = fmaxf(pmax, p0[r]);
#pragma unroll
  for (int r = 0; r < 16; ++r) pmax = fmaxf(pmax, p1[r]);
  { auto rr = __builtin_amdgcn_permlane32_swap(__float_as_uint(pmax), __float_as_uint(pmax), false, false);
    pmax = fmaxf(__uint_as_float(rr[0]), __uint_as_float(rr[1])); }
  if (__builtin_expect(__all(pmax - m_reg <= THR2), 1)) { mn = m_reg; alpha = 1.f; }
  else { mn = fmaxf(m_reg, pmax); alpha = __builtin_amdgcn_exp2f(m_reg - mn); m_reg = mn; }
#pragma unroll
  for (int r = 0; r < 16; ++r) p0[r] = __builtin_amdgcn_exp2f(p0[r] - mn);
#pragma unroll
  for (int r = 0; r < 16; ++r) p1[r] = p1[r] - mn;
}
__device__ __forceinline__ void finishSM(f32x16& p0, f32x16& p1, float alpha, float& l_reg, bf16x8& pa0, bf16x8& pa1, bf16x8& pa2, bf16x8& pa3) {
#pragma unroll
  for (int r = 0; r < 16; ++r) p1[r] = __builtin_amdgcn_exp2f(p1[r]);
  float ps = 0;
#pragma unroll
  for (int r = 0; r < 16; ++r) ps += p0[r];
#pragma unroll
  for (int r = 0; r < 16; ++r) ps += p1[r];
  { auto rr = __builtin_amdgcn_permlane32_swap(__float_as_uint(ps), __float_as_uint(ps), false, false);
    ps = __uint_as_float(rr[0]) + __uint_as_float(rr[1]); }
  l_reg = l_reg * alpha + ps;
#define PK4(P, BASE, OUT) do { unsigned a0 = cvt_pk_bf16(P[BASE + 0], P[BASE + 1]), a1 = cvt_pk_bf16(P[BASE + 2], P[BASE + 3]);   \
    unsigned b0 = cvt_pk_bf16(P[BASE + 4], P[BASE + 5]), b1 = cvt_pk_bf16(P[BASE + 6], P[BASE + 7]);                              \
    auto r0 = __builtin_amdgcn_permlane32_swap(a0, b0, false, false); auto r1 = __builtin_amdgcn_permlane32_swap(a1, b1, false, false); \
    u32x4 w = {r0[0], r1[0], r0[1], r1[1]}; OUT = *reinterpret_cast<bf16x8*>(&w); } while (0)
  PK4(p0, 0, pa0); PK4(p0, 8, pa1); PK4(p1, 0, pa2); PK4(p1, 8, pa3);
#undef PK4
}
__device__ __forceinline__ void qkt(f32x16& p0, f32x16& p1, const bf16x8* qr, const int* kb, int so) {
  p0 = f32x16{}; p1 = f32x16{};
  const int k0 = kb[0] + so, k1 = kb[1] + so, k2 = kb[2] + so, k3 = kb[3] + so;
  bf16x8 fa[4], fb[4];
#define KADDR(d0) (((d0) & 3) == 0 ? k0 : ((d0) & 3) == 1 ? k1 : ((d0) & 3) == 2 ? k2 : k3)
#define LOADK(F, d0) do { F[0] = *(const LAS bf16x8*)(uintptr_t)(unsigned)(KADDR(d0) + ((d0) >> 2) * 128); F[1] = *(const LAS bf16x8*)(uintptr_t)(unsigned)(KADDR(d0) + ((d0) >> 2) * 128 + 32 * 384); \
    F[2] = *(const LAS bf16x8*)(uintptr_t)(unsigned)(KADDR((d0) + 1) + (((d0) + 1) >> 2) * 128); F[3] = *(const LAS bf16x8*)(uintptr_t)(unsigned)(KADDR((d0) + 1) + (((d0) + 1) >> 2) * 128 + 32 * 384); } while (0)
#define MMAK(F, d0) do { p0 = __builtin_amdgcn_mfma_f32_32x32x16_bf16(F[0], qr[d0], p0, 0, 0, 0); p1 = __builtin_amdgcn_mfma_f32_32x32x16_bf16(F[1], qr[d0], p1, 0, 0, 0); \
    p0 = __builtin_amdgcn_mfma_f32_32x32x16_bf16(F[2], qr[(d0) + 1], p0, 0, 0, 0); p1 = __builtin_amdgcn_mfma_f32_32x32x16_bf16(F[3], qr[(d0) + 1], p1, 0, 0, 0); } while (0)
  LOADK(fa, 0); SBAR(); LOADK(fb, 2); SBAR();
  MMAK(fa, 0); SBAR(); LOADK(fa, 4); SBAR();
  MMAK(fb, 2); SBAR(); LOADK(fb, 6); SBAR();
  MMAK(fa, 4); SBAR(); LOADK(fa, 8); SBAR();
  MMAK(fb, 6); SBAR(); LOADK(fb, 10); SBAR();
  MMAK(fa, 8); SBAR();
  MMAK(fb, 10); SBAR();
#undef KADDR
#undef LOADK
#undef MMAK
}
__device__ __forceinline__ int v_st(int k, int c) { const int kk = (k & ~0xC) | ((k & 4) << 1) | ((k & 8) >> 1); return ((kk >> 3) * 4 + (c >> 5)) * 512 + ((kk & 7) * 32 + (c & 31)) * 2; }
__device__ __forceinline__ int v_rd_base(int lane) { return ((lane & 3) << 3) | (((lane >> 2) & 3) << 6) | (((lane >> 4) & 1) << 5) | (((lane >> 5) & 1) << 8); }
constexpr int v_rd_off(int d0, int ks, int half) { return d0 * 512 + ks * 4096 + half * 2048; }
typedef short v4i16_t __attribute__((ext_vector_type(4)));
template <int OFF> __device__ __forceinline__ s16x4 tr_read(int vb) {
  return __builtin_bit_cast(s16x4, __builtin_amdgcn_ds_read_tr16_b64_v4i16((LAS v4i16_t*)(uintptr_t)(unsigned)(vb + OFF)));
}
template <int D0> __device__ __forceinline__ void pv_load(s16x4* f, int vb) {
  f[0] = tr_read<v_rd_off(D0, 0, 0)>(vb); f[1] = tr_read<v_rd_off(D0, 0, 1)>(vb); f[2] = tr_read<v_rd_off(D0, 1, 0)>(vb); f[3] = tr_read<v_rd_off(D0, 1, 1)>(vb);
  f[4] = tr_read<v_rd_off(D0, 2, 0)>(vb); f[5] = tr_read<v_rd_off(D0, 2, 1)>(vb); f[6] = tr_read<v_rd_off(D0, 3, 0)>(vb); f[7] = tr_read<v_rd_off(D0, 3, 1)>(vb);
}
__device__ __forceinline__ void pv_mma(f32x16& od, const s16x4* f, bf16x8 pa0, bf16x8 pa1, bf16x8 pa2, bf16x8 pa3) {
#define PK(L, H) (bf16x8){L[0], L[1], L[2], L[3], H[0], H[1], H[2], H[3]}
  od = __builtin_amdgcn_mfma_f32_32x32x16_bf16(pa0, PK(f[0], f[1]), od, 0, 0, 0);
  od = __builtin_amdgcn_mfma_f32_32x32x16_bf16(pa1, PK(f[2], f[3]), od, 0, 0, 0);
  od = __builtin_amdgcn_mfma_f32_32x32x16_bf16(pa2, PK(f[4], f[5]), od, 0, 0, 0);
  od = __builtin_amdgcn_mfma_f32_32x32x16_bf16(pa3, PK(f[6], f[7]), od, 0, 0, 0);
#undef PK
}
__device__ __forceinline__ void pv_d0(f32x16* o, int vb, bf16x8 pa0, bf16x8 pa1, bf16x8 pa2, bf16x8 pa3) {
  s16x4 va[8], vbf[8];
  pv_load<0>(va, vb); SBAR(); pv_load<1>(vbf, vb); SBAR();
  pv_mma(o[0], va, pa0, pa1, pa2, pa3); SBAR(); pv_load<2>(va, vb); SBAR();
  pv_mma(o[1], vbf, pa0, pa1, pa2, pa3); SBAR(); pv_load<3>(vbf, vb); SBAR();
  pv_mma(o[2], va, pa0, pa1, pa2, pa3); SBAR();
  pv_mma(o[3], vbf, pa0, pa1, pa2, pa3); SBAR();
}
__device__ __forceinline__ int k_src(int s) { const int row = s / 24, cp = s - row * 24, c = cp ^ ((row >> 1) & 7); return row * 5120 + c * 8; }
__device__ __forceinline__ int v_src(int s) { const int sub = s >> 5, w = s & 31, kk = (sub >> 2) * 8 + (w >> 2), c = (sub & 3) * 32 + (w & 3) * 8; const int k = (kk & ~0xC) | ((kk & 4) << 1) | ((kk & 8) >> 1); return k * 5120 + c; }
template <bool FX> __device__ __forceinline__ void attn_unit(const bf16_t* __restrict__ Qb, const bf16_t* __restrict__ Kh, const bf16_t* __restrict__ Vh, bf16_t* __restrict__ Ob,
                                          int NT, int NTreal, int nvis, int wq, int rev, LAS char* lds, const int tid, const float* __restrict__ gqn, const float* __restrict__ rope, int pos0) {
  int lane_ = tid & 63; asm volatile("" : "+v"(lane_));
  const int wid = __builtin_amdgcn_readfirstlane(tid >> 6), lane = lane_, r32 = lane & 31, hi = lane >> 5, grp = wid >> 2;
  LAS char* V_lds = lds + OFF_V; LAS char* K_lds = lds + OFF_K;
  LAS float* ws = (LAS float*)(lds + OFF_SCR) + wid * 64; LAS float* li_l = ws; LAS float* al_l = ws + 32;
  float m_reg = -1e30f, l_reg = 0; f32x16 o[4] = {}; bf16x8 qr[12];
  const bf16_t* Qw = Qb + (size_t)(wq * 32 + r32) * 3072 + hi * 8;
  {
    u32x4 raw[12];
#pragma unroll
    for (int d0 = 0; d0 < 12; ++d0) raw[d0] = *(const u32x4*)(Qw + d0 * 16);
    float ss = 0.f;
#pragma unroll
    for (int d0 = 0; d0 < 12; ++d0)
#pragma unroll
      for (int e = 0; e < 4; ++e) { const float a = bf_lo(raw[d0][e]), b = bf_hi(raw[d0][e]); ss += a * a + b * b; }
    { auto rr = __builtin_amdgcn_permlane32_swap(__float_as_uint(ss), __float_as_uint(ss), false, false); ss = __uint_as_float(rr[0]) + __uint_as_float(rr[1]); }
    const float rq = (1.0f / sqrtf(ss * (1.0f / 192.0f) + EPS)) * (0.07216878364870323f * 1.4426950408889634f);
#pragma unroll
    for (int d0 = 0; d0 < 8; ++d0) { const f32x4 g0 = *(const f32x4*)(gqn + d0 * 16 + hi * 8), g1 = *(const f32x4*)(gqn + d0 * 16 + hi * 8 + 4); u32x4 w;
      w.x = cvt_pk_bf16(bf_lo(raw[d0][0]) * rq * g0[0], bf_hi(raw[d0][0]) * rq * g0[1]); w.y = cvt_pk_bf16(bf_lo(raw[d0][1]) * rq * g0[2], bf_hi(raw[d0][1]) * rq * g0[3]);
      w.z = cvt_pk_bf16(bf_lo(raw[d0][2]) * rq * g1[0], bf_hi(raw[d0][2]) * rq * g1[1]); w.w = cvt_pk_bf16(bf_lo(raw[d0][3]) * rq * g1[2], bf_hi(raw[d0][3]) * rq * g1[3]);
      qr[d0] = *reinterpret_cast<bf16x8*>(&w); }
    const float* rt = rope + (size_t)(pos0 + wq * 32 + r32) * 64;
#pragma unroll
    for (int dd = 0; dd < 2; ++dd) {
      u32x4 w1, w2;
#pragma unroll
      for (int e2 = 0; e2 < 4; ++e2) { const int j = 16 * dd + 8 * hi + 2 * e2;
        const f32x4 cs = *(const f32x4*)(rt + 2 * j);
        const f32x2 ga = *(const f32x2*)(gqn + 128 + j), gb = *(const f32x2*)(gqn + 160 + j);
        const float x10 = bf_lo(raw[8 + dd][e2]) * rq * ga.x, x11 = bf_hi(raw[8 + dd][e2]) * rq * ga.y, x20 = bf_lo(raw[10 + dd][e2]) * rq * gb.x, x21 = bf_hi(raw[10 + dd][e2]) * rq * gb.y;
        w1[e2] = cvt_pk_bf16(x10 * cs[0] - x20 * cs[1], x11 * cs[2] - x21 * cs[3]);
        w2[e2] = cvt_pk_bf16(x10 * cs[1] + x20 * cs[0], x11 * cs[3] + x21 * cs[2]); }
      qr[8 + dd] = *reinterpret_cast<bf16x8*>(&w1); qr[10 + dd] = *reinterpret_cast<bf16x8*>(&w2); }
  }
  int kb[4];
#pragma unroll
  for (int v = 0; v < 4; ++v) kb[v] = (int)(uintptr_t)K_lds + r32 * 384 + ((((2 * v) | hi) ^ ((r32 >> 1) & 7)) << 4);
  unsigned kg[3], vg[2];
#pragma unroll
  for (int i = 0; i < 3; ++i) kg[i] = (unsigned)k_src((wid * 3 + i) * 64 + lane) * 2u;
#pragma unroll
  for (int i = 0; i < 2; ++i) vg[i] = (unsigned)v_src((wid * 2 + i) * 64 + lane) * 2u;
  const int vb0 = (int)(uintptr_t)V_lds + v_rd_base(lane);
#define DMA(jt, st) do { const int _p = rev ? NT - 1 - (jt) : (jt); const int _t = _p < NTreal ? _p : NTreal - 1; const char* _k = (const char*)(Kh + (size_t)_t * 64 * 5120); const char* _v = (const char*)(Vh + (size_t)_t * 64 * 5120); \
    _Pragma("unroll") for (int _i = 0; _i < 3; ++_i) __builtin_amdgcn_global_load_lds((const unsigned*)(_k + kg[_i]), (LAS unsigned*)(K_lds + (st) * SHM_K + (wid * 3 + _i) * 1024), 16, 0, 0); \
    _Pragma("unroll") for (int _i = 0; _i < 2; ++_i) __builtin_amdgcn_global_load_lds((const unsigned*)(_v + vg[_i]), (LAS unsigned*)(V_lds + (st) * SHM_V + (wid * 2 + _i) * 1024), 16, 0, 0); } while (0)
#define WAITBAR(N) asm volatile("s_waitcnt vmcnt(" #N ")\n\ts_barrier" ::: "memory")
#define RESC(a) do { if constexpr (!FX) if (__any((a) < 1.f)) { if (hi == 0) al_l[r32] = (a); asm volatile("s_waitcnt lgkmcnt(0)" ::: "memory"); \
    _Pragma("unroll") for (int d = 0; d < 4; ++d) _Pragma("unroll") for (int r = 0; r < 16; ++r) o[d][r] *= al_l[crow(r, hi)]; } } while (0)
#define VIS(j) ((rev ? NT - 1 - (j) : (j)) < nvis)
  if (grp) __builtin_amdgcn_s_setprio(1);
  f32x16 pA0, pA1, pB0, pB1; float mnA, mnB, alA, alB; bf16x8 pa0, pa1, pa2, pa3;
  int sp = 0, sc = 1, sn = 2;
  DMA(0, 0); DMA(1, 1);
  WAITBAR(5);
  if (VIS(0)) qkt(pA0, pA1, qr, kb, 0);
  partialSM<FX>(pA0, pA1, m_reg, mnA, alA, VIS(0));
  for (int j = 1; j + 1 < NT; j += 2) {
    WAITBAR(0);
    DMA(j + 1, sn);
    SBAR(); if (VIS(j)) qkt(pB0, pB1, qr, kb, sc * SHM_K);
    finishSM(pA0, pA1, alA, l_reg, pa0, pa1, pa2, pa3); SBAR();
    if (VIS(j - 1)) pv_d0(o, vb0 + sp * SHM_V, pa0, pa1, pa2, pa3);
    partialSM<FX>(pB0, pB1, m_reg, mnB, alB, VIS(j));
    RESC(alB);
    { const int t = sp; sp = sc; sc = sn; sn = t; }
    WAITBAR(0);
    DMA(j + 2, sn);
    SBAR(); if (VIS(j + 1)) qkt(pA0, pA1, qr, kb, sc * SHM_K);
    finishSM(pB0, pB1, alB, l_reg, pa0, pa1, pa2, pa3); SBAR();
    if (VIS(j)) pv_d0(o, vb0 + sp * SHM_V, pa0, pa1, pa2, pa3);
    partialSM<FX>(pA0, pA1, m_reg, mnA, alA, VIS(j + 1));
    RESC(alA);
    { const int t = sp; sp = sc; sc = sn; sn = t; }
  }
  WAITBAR(0);
  SBAR(); if (VIS(NT - 1)) qkt(pB0, pB1, qr, kb, sc * SHM_K);
  finishSM(pA0, pA1, alA, l_reg, pa0, pa1, pa2, pa3); SBAR();
  if (VIS(NT - 2)) pv_d0(o, vb0 + sp * SHM_V, pa0, pa1, pa2, pa3);
  partialSM<FX>(pB0, pB1, m_reg, mnB, alB, VIS(NT - 1));
  RESC(alB);
  finishSM(pB0, pB1, alB, l_reg, pa0, pa1, pa2, pa3); SBAR();
  if (VIS(NT - 1)) pv_d0(o, vb0 + sc * SHM_V, pa0, pa1, pa2, pa3);
  if (nvis > 0) {
    if (hi == 0) li_l[r32] = l_reg; asm volatile("s_waitcnt lgkmcnt(0)" ::: "memory");
    bf16_t* Ow = Ob + (size_t)(wq * 32) * 2048;
    const bool odd = (lane & 1) != 0;
#pragma unroll
    for (int r = 0; r < 16; r += 2) {
      const float ra = __builtin_amdgcn_rcpf(li_l[crow(r, hi)]), rb = __builtin_amdgcn_rcpf(li_l[crow(r + 1, hi)]);
      const int orow = odd ? crow(r + 1, hi) : crow(r, hi);
#pragma unroll
      for (int d0 = 0; d0 < 4; ++d0) {
        const float e = o[d0][r] * ra, f = o[d0][r + 1] * rb;
        const float keep = odd ? f : e, send = odd ? e : f;
        const float got = __int_as_float(__builtin_amdgcn_mov_dpp(__float_as_int(send), 0xB1, 0xF, 0xF, true));
        const unsigned w = odd ? cvt_pk_bf16(got, keep) : cvt_pk_bf16(keep, got);
        *(unsigned*)(Ow + (size_t)orow * 2048 + d0 * 32 + (r32 & ~1)) = w; } }
  }
  __builtin_amdgcn_s_setprio(0);
  asm volatile("s_waitcnt lgkmcnt(0)\n\ts_barrier" ::: "memory");
#undef DMA
#undef VIS
#undef WAITBAR
#undef RESC
}
}

#define XB_TMO      128
#define XB_XCNT(j)  (256  + 64 * (j))
#define XB_XSUB(j)  (1280 + 64 * (j))
#define XB_XGEN(j)  (2304 + 64 * (j))
#define XB_TOP      3328
#define XB_TOPGEN   3392
#define XCD_BAR_WORDS 3456
#define XB_SPIN_CAP (1u << 18)
__device__ __forceinline__ unsigned xb_ld(unsigned* p)              { return __hip_atomic_load(p, __ATOMIC_RELAXED, __HIP_MEMORY_SCOPE_AGENT); }
__device__ __forceinline__ unsigned xb_add(unsigned* p, unsigned v) { return __hip_atomic_fetch_add(p, v, __ATOMIC_RELAXED, __HIP_MEMORY_SCOPE_AGENT); }
__device__ __forceinline__ unsigned xb_xcc_id() { return (unsigned)__builtin_amdgcn_s_getreg((3 << 11) | 20) & 0xFu; }
#define XB_SPIN(cond, bar) do { unsigned _sp = 0; while (cond) { __builtin_amdgcn_s_sleep(1); \
    if ((++_sp & 255u) == 0u) { if (xb_ld(&(bar)[XB_TMO])) break; if (_sp > XB_SPIN_CAP) { atomicAdd(&(bar)[XB_TMO], 1u); break; } } } } while (0)
struct XcdBarrier { unsigned* bar; unsigned x; volatile LAS unsigned* st; };
__device__ __forceinline__ XcdBarrier xcd_barrier_post(unsigned* bar, volatile LAS unsigned* st) {
    XcdBarrier b; b.bar = bar; b.x = xb_xcc_id(); b.st = st;
    if (threadIdx.x == 0) (void)xb_add(&bar[XB_XCNT(b.x)], 1u);
    return b;
}
__device__ __forceinline__ void xcd_barrier_complete(unsigned* bar, unsigned x, unsigned& nloc, unsigned& nx) {
    const unsigned G = gridDim.x * gridDim.y * gridDim.z;
    unsigned sum, cnt, mine, sp = 0u;
    for (;;) {
        sum = 0u; cnt = 0u; mine = 0u;
#pragma unroll
        for (unsigned j = 0; j < 16; ++j) { const unsigned c = xb_ld(&bar[XB_XCNT(j)]); sum += c; cnt += (c > 0u) ? 1u : 0u; mine = (j == x) ? c : mine; }
        if (sum == G) break;
        __builtin_amdgcn_s_sleep(1);
        if ((++sp & 255u) == 0u) { if (xb_ld(&bar[XB_TMO])) break; if (sp > XB_SPIN_CAP) { atomicAdd(&bar[XB_TMO], 1u); break; } }
    }
    nloc = mine > 0u ? mine : 1u; nx = cnt > 0u ? cnt : 1u;
}
__device__ __forceinline__ void xcd_barrier(const XcdBarrier& b, const int tid) {
    asm volatile("s_waitcnt vmcnt(0)" ::: "memory");
    __syncthreads();
    if (tid == 0) {
        unsigned* bar = b.bar; asm volatile("" : "+s"(bar));
        __builtin_amdgcn_s_waitcnt(0);
        unsigned nloc = b.st[0], nx = b.st[1];
        if (nloc == 0u) { xcd_barrier_complete(bar, b.x, nloc, nx); b.st[0] = nloc; b.st[1] = nx; }
        const unsigned old = xb_add(&bar[XB_XSUB(b.x)], 1u);
        const unsigned gen = old / nloc;
        if (old + 1u == (gen + 1u) * nloc) {
            __builtin_amdgcn_fence(__ATOMIC_RELEASE, "agent");
            asm volatile("s_waitcnt vmcnt(0)" ::: "memory");
            const unsigned og = xb_add(&bar[XB_TOP], 1u);
            const unsigned tg = og / nx;
            if (og + 1u == (tg + 1u) * nx) xb_add(&bar[XB_TOPGEN], 1u);
            else XB_SPIN(xb_ld(&bar[XB_TOPGEN]) == tg, bar);
            __builtin_amdgcn_fence(__ATOMIC_ACQUIRE, "agent");
            xb_add(&bar[XB_XGEN(b.x)], 1u);
            asm volatile("s_waitcnt vmcnt(0)" ::: "memory");
        } else {
            XB_SPIN(xb_ld(&bar[XB_XGEN(b.x)]) == gen, bar);
            __builtin_amdgcn_fence(__ATOMIC_ACQUIRE, "agent");
            asm volatile("s_waitcnt vmcnt(0)" ::: "memory");
        }
    }
    __syncthreads();
}

struct Args { const float* in[37]; float* out; unsigned char* ws; int ph_lo, ph_hi; };
enum { I_XP = 0, I_XS, I_CCKV, I_CKR, I_SRE, I_SIM, I_CCONV, I_CP, I_CS, I_WMOD, I_BMOD, I_GMIX, I_GFFN, I_WDQ, I_GQA, I_WUQ, I_GQN, I_WDKV, I_GKVA, I_WUKV, I_GKN, I_WO,
       I_ARE, I_AIM, I_LDT, I_BRE, I_BIM, I_CRE, I_CIM, I_SD, I_WGLU, I_WSG, I_FG, I_FU, I_FCW, I_FCB, I_FD };

__device__ const double ROPE_INV[32] = {
 1.0, 0.7498942093324559, 0.5623413251903491, 0.4216965034285822, 0.31622776601683794, 0.23713737056616552, 0.1778279410038923, 0.1333521432163324,
 0.1, 0.07498942093324558, 0.05623413251903491, 0.04216965034285822, 0.03162277660168379, 0.023713737056616554, 0.01778279410038923, 0.01333521432163324,
 0.01, 0.007498942093324558, 0.005623413251903491, 0.004216965034285823, 0.0031622776601683794, 0.0023713737056616554, 0.0017782794100389228, 0.001333521432163324,
 0.001, 0.0007498942093324559, 0.0005623413251903491, 0.0004216965034285823, 0.00031622776601683794, 0.00023713737056616554, 0.00017782794100389227, 0.0001333521432163324 };
__device__ __forceinline__ void sincos_red(double a, float& s, float& c) {
    const double k = __builtin_rint(a * 0.15915494309189535);
    const float r = (float)__builtin_fma(-k, 6.283185307179586, a);
    s = __sinf(r); c = __cosf(r);
}

__device__ __forceinline__ void transpose_item(const float* W, int K, int N, bf16_t* WT, int row_off, int mode, LAS float* scr, int item, int lane, const float sc = 1.0f, const float* ksc = nullptr) {
    const int nblk = N / 32, kb = item / nblk, nb = item - kb * nblk, k0 = 64 * kb, n0 = 32 * nb;
#pragma unroll 8
    for (int i = 0; i < 32; ++i) { const int kk = 2 * i + (lane >> 5); scr[kk * 33 + (lane & 31)] = W[(size_t)(k0 + kk) * N + n0 + (lane & 31)] * (ksc ? ksc[k0 + kk] : 1.0f); }
    LDS_WAIT(); asm volatile("" ::: "memory");
    const int c = lane & 7;
#pragma unroll
    for (int j = 0; j < 4; ++j) { const int n = (lane >> 3) + 8 * j; const LAS float* s = scr + (8 * c) * 33 + n;
        u32x4 o; o.x = cvt_pk_bf16(sc * s[0 * 33], sc * s[1 * 33]); o.y = cvt_pk_bf16(sc * s[2 * 33], sc * s[3 * 33]); o.z = cvt_pk_bf16(sc * s[4 * 33], sc * s[5 * 33]); o.w = cvt_pk_bf16(sc * s[6 * 33], sc * s[7 * 33]);
        const int nn = n0 + n; const int drow = mode == 0 ? row_off + nn : ((nn >> 7) * 256 + (nn & 127) + (mode == 2 ? 128 : 0));
        if (mode == 3) *(u32x4*)(WT + pg8::tiled_off(nn, k0 + 8 * c, K / 64)) = o;
        else *(u32x4*)(WT + (size_t)drow * K + k0 + 8 * c) = o; }
    LDS_WAIT(); asm volatile("" ::: "memory");
}

__global__ void __launch_bounds__(NWAVES * 64, 2) fwd_kernel(Args args) {
    extern __shared__ __attribute__((aligned(16))) unsigned char lds_raw[];
    LAS unsigned char* lds = (LAS unsigned char*)lds_raw;
    volatile LAS unsigned* MISC = (volatile LAS unsigned*)(lds + MISC_OFF);
    const int tid0 = threadIdx.x; const int wave0 = __builtin_amdgcn_readfirstlane(tid0 >> 6);
    const int G = gridDim.x; const int bx = blockIdx.x; const int vcu = (G % 8 == 0) ? (bx % 8) * (G / 8) + bx / 8 : bx;
    const int NGW = G * NWAVES;
    unsigned char* ws0 = args.ws; float* out0 = args.out;
    unsigned* ctl = (unsigned*)(ws0 + WS_CTL);
    for (int u = tid0; u < 64; u += NWAVES * 64) ((LAS unsigned*)(lds + MISC_OFF))[u] = 0u;
    __syncthreads();
    XcdBarrier bar; bar.bar = ctl + 1024; bar.x = 0; bar.st = nullptr;
    if (!MK_PER_PHASE) bar = xcd_barrier_post(ctl + 1024, MISC + 8);
    const int lo = args.ph_lo, hi = args.ph_hi;
    int ph = 0;
#define PH_BEGIN if (lo <= ph && ph < hi) { int tid; asm volatile("v_mbcnt_lo_u32_b32 %0, -1, 0\n\tv_mbcnt_hi_u32_b32 %0, -1, %0" : "=v"(tid)); tid |= wave0 << 6; \
    const int lane = tid & 63, wave = __builtin_amdgcn_readfirstlane(tid >> 6), gw = vcu * NWAVES + wave; (void)lane; (void)gw; \
    __attribute__((address_space(1))) unsigned char* wsg_; __attribute__((address_space(1))) float* outg_; asm volatile("s_mov_b64 %0, %1" : "=s"(wsg_) : "s"(ws0)); asm volatile("s_mov_b64 %0, %1" : "=s"(outg_) : "s"(out0)); unsigned char* ws = (unsigned char*)wsg_; float* out = (float*)outg_; (void)ws; (void)out;
#define PH_END if (ph + 1 < hi) xcd_barrier(bar, tid); } ++ph;

#define MOD ((float*)(ws + WS_MOD))
#define A16 ((float*)(ws + WS_A16))
#define KRSS ((float*)(ws + WS_KRSS))
#define ROPE ((float*)(ws + WS_ROPE))
#define Hb ((bf16_t*)(ws + WS_H))
#define QA ((bf16_t*)((unsigned char*)out + OY_QA))
#define CKV ((bf16_t*)((unsigned char*)out + OY_CKV))
#define Rr ((float*)((unsigned char*)out + OY_R))
#define STATQ ((float*)((unsigned char*)out + OY_STATQ))
#define RSTDQ ((float*)((unsigned char*)out + OY_RSTDQ))
#define XBs ((bf16_t*)(ws + WS_XB))
#define Qb ((bf16_t*)(ws + WS_Q))
#define KB ((bf16_t*)(ws + WS_KB))
#define QKVA ((float*)(ws + WS_QKVA))
#define Gb ((bf16_t*)(ws + WS_G))
#define HID ((bf16_t*)(ws + WS_HID))
#define GBND ((float*)(ws + WS_G))
#define DEFC ((float*)(ws + WS_G + 8 * MiB))
#define DEFU ((float*)(ws + WS_G + 16 * MiB))
#define UP ((bf16_t*)(ws + WS_UP))
#define XLOC ((bf16_t*)(ws + WS_XLOC))
#define PART ((float*)(ws + WS_PART))
#define PGU ((float*)(ws + WS_PGU))

    PH_BEGIN
#ifndef NO_P0
    {
        for (int it = vcu; it < 4 * 64; it += G) {
            const int l = it >> 6, cb = it & 63;
            LAS float* sc = (LAS float*)lds;
            for (int e = tid; e < NSLOT * DM; e += NWAVES * 64) { const int s = e >> 11, k = e & 2047; const float c = s < 4 ? args.in[I_CP][s * DM + k] : args.in[I_CS][(s - 4) * DM + k]; sc[e] = c * fast_sigmoid(c); }
            __syncthreads();
            f32x4 acc[NSLOT];
#pragma unroll
            for (int s = 0; s < NSLOT; ++s) acc[s] = (f32x4){0.f, 0.f, 0.f, 0.f};
            const int lc = lane < 48 ? lane : 47;
            const float* Wp = args.in[I_WMOD] + (size_t)l * DM * 12288 + (size_t)(wave * 256) * 12288 + cb * 192 + 4 * lc;
            for (int k0 = 0; k0 < 256; k0 += 8) {
                f32x4 w[8];
#pragma unroll
                for (int kk = 0; kk < 8; ++kk) w[kk] = *(const f32x4*)(Wp + (size_t)(k0 + kk) * 12288);
#pragma unroll
                for (int s = 0; s < NSLOT; ++s) { const f32x4 c0 = *(const LAS f32x4*)(sc + s * DM + wave * 256 + k0), c1 = *(const LAS f32x4*)(sc + s * DM + wave * 256 + k0 + 4);
#pragma unroll
                    for (int kk = 0; kk < 4; ++kk) { acc[s] += c0[kk] * w[kk]; acc[s] += c1[kk] * w[4 + kk]; } }
            }
            __syncthreads();
            LAS float* red = (LAS float*)lds;
            if (lane < 48) {
#pragma unroll
                for (int s = 0; s < NSLOT; ++s) *(LAS f32x4*)(red + (wave * NSLOT + s) * 192 + 4 * lane) = acc[s]; }
            __syncthreads();
            for (int e = tid; e < NSLOT * 192; e += NWAVES * 64) { const int s = e / 192, c = e - s * 192; float v = args.in[I_BMOD][l * 12288 + cb * 192 + c];
#pragma unroll
                for (int w8 = 0; w8 < 8; ++w8) v += red[(w8 * NSLOT + s) * 192 + c];
                MOD[(size_t)(l * NSLOT + s) * 12288 + cb * 192 + c] = v; }
            __syncthreads();
        }
        for (int e = gw * 64 + lane; e < SEQ * 32; e += NGW * 64) { float s, c; sincos_red((double)(e >> 5) * ROPE_INV[e & 31], s, c); *(f32x2*)(ROPE + 2 * (size_t)e) = (f32x2){c, s}; }
        for (int it = vcu; it < 2 * NGRP; it += G) {
            const int i = it >> 7, g = it & 127;
            LAS float* pwr = (LAS float*)lds;
            LAS float* pwi = pwr + 17 * 64;
            LAS float* bbr = pwi + 17 * 64;
            LAS float* bbi = bbr + 1024;
            LAS float* ccr = bbi + 1024;
            LAS float* cci = ccr + 1024;
            LAS float* kd = cci + 1024;
            const float dt = expf(args.in[I_LDT][i * NGRP + g]);
            if (tid < 64) {
                const int n = tid; const float are = args.in[I_ARE][(i * NGRP + g) * 64 + n], aim = args.in[I_AIM][(i * NGRP + g) * 64 + n];
                const double xr = (double)are * (double)dt, xi = (double)aim * (double)dt;
                for (int d = 0; d <= 16; ++d) { float s, c; sincos_red(xi * d, s, c); const float e = expf((float)(xr * d)); pwr[d * 64 + n] = e * c; pwi[d * 64 + n] = e * s; }
                A16[((i * NGRP + g) * 64 + n) * 2] = pwr[16 * 64 + n]; A16[((i * NGRP + g) * 64 + n) * 2 + 1] = pwi[16 * 64 + n];
                const float nr = pwr[64 + n] - 1.0f, ni = pwi[64 + n]; const float den = 1.0f / (are * are + aim * aim);
                const float fr_ = (nr * are + ni * aim) * den, fi_ = (ni * are - nr * aim) * den;
                for (int p = 0; p < 16; ++p) { const float br = args.in[I_BRE][((size_t)(i * NGRP + g) * 64 + n) * 16 + p], bi = args.in[I_BIM][((size_t)(i * NGRP + g) * 64 + n) * 16 + p];
                    bbr[n * 16 + p] = fr_ * br - fi_ * bi; bbi[n * 16 + p] = fr_ * bi + fi_ * br; }
            } else {
                for (int e = tid - 64; e < 1024; e += NWAVES * 64 - 64) { ccr[e] = args.in[I_CRE][(size_t)(i * NGRP + g) * 1024 + e]; cci[e] = args.in[I_CIM][(size_t)(i * NGRP + g) * 1024 + e]; }
            }
            __syncthreads();
            for (int e = tid; e < 4096; e += NWAVES * 64) { const int d = e >> 8, q = (e >> 4) & 15, p = e & 15; float s = 0.f;
                for (int n = 0; n < 64; ++n) { const float mr = pwr[d * 64 + n] * bbr[n * 16 + p] - pwi[d * 64 + n] * bbi[n * 16 + p], mi = pwr[d * 64 + n] * bbi[n * 16 + p] + pwi[d * 64 + n] * bbr[n * 16 + p];
                    s += ccr[q * 64 + n] * mr - cci[q * 64 + n] * mi; }
                kd[e] = s; }
            __syncthreads();
            bf16_t* BtY = (bf16_t*)(ws + WS_S5 + i * WSZ_S5 + WSZ_GG) + (size_t)g * 256 * 384;
            bf16_t* BtX = (bf16_t*)(ws + WS_S5 + i * WSZ_S5 + WSZ_GG + WSZ_BTY) + (size_t)g * 256 * 256;
            for (int e = tid; e < 256 * 192; e += NWAVES * 64) { const int rr = e / 192, k2 = (e - rr * 192) * 2; const int t = rr >> 4, q = rr & 15; float v[2];
#pragma unroll
                for (int z = 0; z < 2; ++z) { const int k = k2 + z;
                    if (k < 256) { const int s = k >> 4, p = k & 15; v[z] = (s <= t) ? kd[((t - s) * 16 + q) * 16 + p] : 0.f; }
                    else if (k < 320) { const int n = k - 256; v[z] = ccr[q * 64 + n] * pwr[(t + 1) * 64 + n] - cci[q * 64 + n] * pwi[(t + 1) * 64 + n]; }
                    else { const int n = k - 320; v[z] = -(ccr[q * 64 + n] * pwi[(t + 1) * 64 + n] + cci[q * 64 + n] * pwr[(t + 1) * 64 + n]); } }
                *(unsigned*)(BtY + (size_t)rr * 384 + k2) = cvt_pk_bf16(v[0], v[1]); }
            for (int e = tid; e < 256 * 128; e += NWAVES * 64) { const int rr = e >> 7, k2 = (e & 127) * 2; float v[2];
#pragma unroll
                for (int z = 0; z < 2; ++z) { const int k = k2 + z, s = k >> 4, p = k & 15;
                    if (rr < 64) { const int n = rr; v[z] = pwr[(15 - s) * 64 + n] * bbr[n * 16 + p] - pwi[(15 - s) * 64 + n] * bbi[n * 16 + p]; }
                    else if (rr < 128) { const int n = rr - 64; v[z] = pwr[(15 - s) * 64 + n] * bbi[n * 16 + p] + pwi[(15 - s) * 64 + n] * bbr[n * 16 + p]; }
                    else v[z] = 0.f; }
                *(unsigned*)(BtX + (size_t)rr * 256 + k2) = cvt_pk_bf16(v[0], v[1]); }
            __syncthreads();
        }
        {
            LAS float* scr = (LAS float*)(lds + wave * 16384);
            constexpr int I_DQ_ = 32 * 16, I_DKV_ = 32 * 10, I_UQ_ = 8 * 96, I_UKV_ = 4 * 128, I_O_ = 32 * 64, I_MLA_ = I_DQ_ + I_DKV_ + I_UQ_ + I_UKV_ + I_O_;
            constexpr int I_GL_ = 32 * 64, I_S5_ = 2 * I_GL_;
            constexpr int I_FG_ = 32 * 176, I_FD_ = 88 * 64, I_FFN_ = 2 * I_FG_ + I_FD_;
            constexpr int NIT = 2 * I_MLA_ + 2 * I_S5_ + 4 * I_FFN_;
            for (int it = gw; it < NIT; it += NGW) {
                int r = it;
                if (r < 2 * I_MLA_) { const int i = r / I_MLA_; r -= i * I_MLA_; unsigned char* wb = ws + WS_MLA + i * WSZ_MLA;
                    if (r < I_DQ_) { transpose_item(args.in[I_WDQ] + (size_t)i * DM * QLORA, DM, QLORA, (bf16_t*)wb, 0, 0, scr, r, lane); continue; } r -= I_DQ_;
                    if (r < I_DKV_) { transpose_item(args.in[I_WDKV] + (size_t)i * DM * 320, DM, 320, (bf16_t*)wb, 512, 0, scr, r, lane); continue; } r -= I_DKV_;
                    if (r < I_UQ_) { transpose_item(args.in[I_WUQ] + (size_t)i * QLORA * 3072, QLORA, 3072, (bf16_t*)(wb + WSZ_DQKV), 0, 0, scr, r, lane, 1.0f, args.in[I_GQA] + i * QLORA); continue; }     r -= I_UQ_;
                    if (r < I_UKV_) { transpose_item(args.in[I_WUKV] + (size_t)i * KVLORA * 4096, KVLORA, 4096, (bf16_t*)(wb + WSZ_DQKV + WSZ_UQ), 0, 0, scr, r, lane); continue; } r -= I_UKV_;
                    transpose_item(args.in[I_WO] + (size_t)i * DM * DM, DM, DM, (bf16_t*)(wb + WSZ_DQKV + WSZ_UQ + WSZ_UKV), 0, 0, scr, r, lane); continue; }
                r -= 2 * I_MLA_;
                if (r < 2 * I_S5_) { const int i = r / I_S5_; r -= i * I_S5_; bf16_t* wb = (bf16_t*)(ws + WS_S5 + i * WSZ_S5);
                    if (r < I_GL_) { transpose_item(args.in[I_WGLU] + (size_t)i * DM * DM, DM, DM, wb, 0, 1, scr, r, lane); continue; } r -= I_GL_;
                    transpose_item(args.in[I_WSG] + (size_t)i * DM * DM, DM, DM, wb, 0, 2, scr, r, lane); continue; }
                r -= 2 * I_S5_;
                { const int l = r / I_FFN_; r -= l * I_FFN_; unsigned char* wb = ws + WS_FFN + l * WSZ_FFN;
                    if (r < I_FG_) { transpose_item(args.in[I_FG] + (size_t)l * DM * DFF, DM, DFF, (bf16_t*)wb, 0, 1, scr, r, lane); continue; } r -= I_FG_;
                    if (r < I_FG_) { transpose_item(args.in[I_FU] + (size_t)l * DM * DFF, DM, DFF, (bf16_t*)wb, 0, 2, scr, r, lane); continue; } r -= I_FG_;
                    transpose_item(args.in[I_FD] + (size_t)l * DFF * DM, DFF, DM, (bf16_t*)(wb + 2 * WSZ_FF1), 0, 3, scr, r, lane, -0.6931471805599453f); }
            }
            for (int i = 0; i < 2; ++i) { u32x4* z = (u32x4*)(ws + WS_MLA + i * WSZ_MLA + (size_t)832 * DM * 2);
                for (int e = gw * 64 + lane; e < 192 * DM * 2 / 16; e += NGW * 64) z[e] = (u32x4){0u, 0u, 0u, 0u}; }
        }
    }
#endif
    PH_END

    for (int l = 0; l < 4; ++l) {
        const int li = l >> 1;
#define modl (MOD + (size_t)l * NSLOT * 12288)

#define NCOL(jj) (8 * lane + 512 * ((jj) >> 1) + 4 * ((jj) & 1))
#define NORM_STORE(V, ROW, RR16) do { \
                _Pragma("unroll") for (int j = 0; j < 4; ++j) { const f32x4 h0 = V[2 * j] * rstd * mul[2 * j] + add[2 * j], h1 = V[2 * j + 1] * rstd * mul[2 * j + 1] + add[2 * j + 1]; const u32x4 w = pg8::pack8(h0, h1); \
                    if (MODE_ == 0) *(u32x4*)(Hb + (size_t)(ROW) * DM + 8 * lane + 512 * j) = w; \
                    else { const int c = ((ROW) >> 4); *(u32x4*)(UP + ((size_t)((lane >> 1) + 32 * j) * NSUB + c) * 384 + (RR16) * 16 + 8 * (lane & 1)) = w; } } } while (0)
#define NORM_STAGE(V, RR16) do { \
                _Pragma("unroll") for (int j = 0; j < 4; ++j) { const f32x4 h0 = V[2 * j] * rstd * mul[2 * j] + add[2 * j], h1 = V[2 * j + 1] * rstd * mul[2 * j + 1] + add[2 * j + 1]; \
                    *(LAS u32x4*)(lds + wave * 16384 + ((RR16) & 3) * 4096 + 16 * lane + 1024 * j) = pg8::pack8(h0, h1); } } while (0)
#define NORM_FLUSH(RR4) do { asm volatile("s_waitcnt lgkmcnt(0)" ::: "memory"); const int t_ = lane >> 4, gl_ = (lane >> 1) & 7, h_ = lane & 1; \
                _Pragma("unroll") for (int i_ = 0; i_ < 16; ++i_) { const int g_ = 8 * i_ + gl_; const u32x4 w_ = *(const LAS u32x4*)(lds + wave * 16384 + t_ * 4096 + g_ * 32 + h_ * 16); \
                    *(u32x4*)(UP + ((size_t)g_ * NSUB + gw) * 384 + ((RR4) + t_) * 16 + 8 * h_) = w_; } \
                asm volatile("s_waitcnt lgkmcnt(0)" ::: "memory"); } while (0)
#define NORM_LOADP(MULADD_SLOT, GAIN, SHOFF, SCOFF) \
            f32x4 mul[8], add[8]; \
            _Pragma("unroll") for (int jj = 0; jj < 8; ++jj) { const int col = NCOL(jj); const f32x4 gg = *(const f32x4*)((GAIN) + col); const f32x4 scv = *(const f32x4*)(modl + (MULADD_SLOT) * 12288 + (SCOFF) + col); \
                add[jj] = *(const f32x4*)(modl + (MULADD_SLOT) * 12288 + (SHOFF) + col); mul[jj] = gg * (scv + 1.0f); }
#define LD8_BF16(V0, V1, P) do { const u32x4 w_ = *(const u32x4*)(P); V0 = (f32x4){bf_lo(w_[0]), bf_hi(w_[0]), bf_lo(w_[1]), bf_hi(w_[1])}; V1 = (f32x4){bf_lo(w_[2]), bf_hi(w_[2]), bf_lo(w_[3]), bf_hi(w_[3])}; } while (0)
#define NORM_ROWS(P32, S32, GAIN, SHOFF, SCOFF, MODE, NPART, PGATE, PMODE) do { constexpr int MODE_ = MODE; \
        { const int row0 = gw * 16; const int slot = slot_of_row(row0); \
            NORM_LOADP(slot, GAIN, SHOFF, SCOFF) \
            for (int rr = 0; rr < 16; rr += 2) { \
                f32x4 va[8], vb[8]; float sa = 0.f, sb = 0.f; \
                if (P32) { const float* xs = args.in[I_XP] + (size_t)(row0 + rr) * DM; \
                    _Pragma("unroll") for (int jj = 0; jj < 8; ++jj) { va[jj] = *(const f32x4*)(xs + NCOL(jj)); vb[jj] = *(const f32x4*)(xs + DM + NCOL(jj)); } } \
                else { const bf16_t* xh = XBs + (size_t)(row0 + rr) * DM + 8 * lane; \
                    _Pragma("unroll") for (int j = 0; j < 4; ++j) { LD8_BF16(va[2 * j], va[2 * j + 1], xh + 512 * j); LD8_BF16(vb[2 * j], vb[2 * j + 1], xh + DM + 512 * j); } } \
                _Pragma("unroll") for (int jj = 0; jj < 8; ++jj) { sa += (va[jj].x * va[jj].x + va[jj].y * va[jj].y) + (va[jj].z * va[jj].z + va[jj].w * va[jj].w); sb += (vb[jj].x * vb[jj].x + vb[jj].y * vb[jj].y) + (vb[jj].z * vb[jj].z + vb[jj].w * vb[jj].w); } \
                sa = wave_sum(sa, lane); sb = wave_sum(sb, lane); \
                { const float rstd = 1.0f / sqrtf(sa * (1.0f / DM) + EPS); if (MODE_ == 1) NORM_STAGE(va, rr); else NORM_STORE(va, row0 + rr, rr); } \
                { const float rstd = 1.0f / sqrtf(sb * (1.0f / DM) + EPS); if (MODE_ == 1) NORM_STAGE(vb, rr + 1); else NORM_STORE(vb, row0 + rr + 1, rr + 1); } \
                if (MODE_ == 1 && (rr & 2)) NORM_FLUSH(rr & ~3); } } \
        if (gw < 512) { const int row = NPROMPT + gw; const int slot = 4 + (gw >> 6); const int np_ = (NPART); \
              \
            f32x4 v[8]; float ss = 0.f; \
            if (S32) { _Pragma("unroll") for (int jj = 0; jj < 8; ++jj) v[jj] = *(const f32x4*)(args.in[I_XS] + (size_t)gw * DM + NCOL(jj)); } \
            else { const bf16_t* xh = XBs + (size_t)row * DM + 8 * lane; u32x4 xr_[4]; _Pragma("unroll") for (int j = 0; j < 4; ++j) xr_[j] = *(const u32x4*)(xh + 512 * j); asm volatile("" ::: "memory"); \
                _Pragma("unroll") for (int j = 0; j < 4; ++j) { v[2 * j] = (f32x4){bf_lo(xr_[j][0]), bf_hi(xr_[j][0]), bf_lo(xr_[j][1]), bf_hi(xr_[j][1])}; v[2 * j + 1] = (f32x4){bf_lo(xr_[j][2]), bf_hi(xr_[j][2]), bf_lo(xr_[j][3]), bf_hi(xr_[j][3])}; } } \
            if (np_ > 0) { const int pm_ = (PMODE); \
                f32x4 sp[8]; _Pragma("unroll") for (int jj = 0; jj < 8; ++jj) sp[jj] = (f32x4){0.f, 0.f, 0.f, 0.f}; \
                if (pm_ == 0) { \
                    for (int ks = 0; ks < np_; ++ks) { f32x4 t_[8]; _Pragma("unroll") for (int jj = 0; jj < 8; ++jj) t_[jj] = *(const f32x4*)(PART + ((size_t)ks * 512 + gw) * DM + NCOL(jj)); asm volatile("" ::: "memory"); \
                        _Pragma("unroll") for (int jj = 0; jj < 8; ++jj) sp[jj] += t_[jj]; } \
                } else { \
                    _Pragma("unroll") for (int h_ = 0; h_ < 2; ++h_) { f32x4 sg[4]; _Pragma("unroll") for (int q = 0; q < 4; ++q) sg[q] = (f32x4){0.f, 0.f, 0.f, 0.f}; \
                        for (int ks = 0; ks < np_; ++ks) { f32x4 t_[4], u_[4]; \
                            _Pragma("unroll") for (int q = 0; q < 4; ++q) { const int col = NCOL(4 * h_ + q); const float* pp = PART + ((size_t)ks * 512 + gw) * 4096 + (col >> 7) * 256 + (col & 127); t_[q] = *(const f32x4*)pp; u_[q] = *(const f32x4*)(pp + 128); } \
                            asm volatile("" ::: "memory"); \
                            _Pragma("unroll") for (int q = 0; q < 4; ++q) { sp[4 * h_ + q] += t_[q]; sg[q] += u_[q]; } } \
                        _Pragma("unroll") for (int q = 0; q < 4; ++q) _Pragma("unroll") for (int e = 0; e < 4; ++e) sp[4 * h_ + q][e] *= fast_sigmoid(sg[q][e]); } } \
                { f32x4 gt_[8]; _Pragma("unroll") for (int jj = 0; jj < 8; ++jj) gt_[jj] = *(const f32x4*)((PGATE) + (size_t)slot * 12288 + NCOL(jj)); asm volatile("" ::: "memory"); \
                  _Pragma("unroll") for (int jj = 0; jj < 8; ++jj) v[jj] += gt_[jj] * sp[jj]; } \
                _Pragma("unroll") for (int j = 0; j < 4; ++j) { const u32x4 w_ = pg8::pack8(v[2 * j], v[2 * j + 1]); *(u32x4*)(XBs + (size_t)row * DM + 8 * lane + 512 * j) = w_;     \
                    v[2 * j] = (f32x4){bf_lo(w_[0]), bf_hi(w_[0]), bf_lo(w_[1]), bf_hi(w_[1])}; v[2 * j + 1] = (f32x4){bf_lo(w_[2]), bf_hi(w_[2]), bf_lo(w_[3]), bf_hi(w_[3])}; } } \
            _Pragma("unroll") for (int jj = 0; jj < 8; ++jj) ss += (v[jj].x * v[jj].x + v[jj].y * v[jj].y) + (v[jj].z * v[jj].z + v[jj].w * v[jj].w); \
            const float rstd = 1.0f / sqrtf(wave_sum(ss, lane) * (1.0f / DM) + EPS); \
            NORM_LOADP(slot, GAIN, SHOFF, SCOFF) \
            NORM_STORE(v, row, row & 15); } } while (0)
#define PREV_GATE_F (MOD + (size_t)(l - 1) * NSLOT * 12288 + 10240)

        if ((l & 1) == 0) {
#define wb (ws + WS_MLA + li * WSZ_MLA)
            PH_BEGIN
#ifndef NO_A0
            NORM_ROWS(l == 0, l == 0, args.in[I_GMIX] + l * DM, 0, 2048, 0, (l > 0 ? 11 : 0), PREV_GATE_F, 0);
#endif
            PH_END
            PH_BEGIN
#ifndef NO_A1
            { pg8::Gemm g = pg8::gemm_rm(Hb, (const bf16_t*)wb, DM, DM, DM); pg8::StaticOrder S; S.init(128, 4, G, bx); pg8::EpiA1 E{QKVA, QA, STATQ};
              pg8::gemm_phase<pg8::EpiA1, pg8::StaticOrder, true>(lds, g, S, E, tid); }
            { pg8::Gemm g = pg8::gemm_rm(Hb, (const bf16_t*)wb, DM, DM, 512); pg8::SplitOrder S{bx, 4, 4, (size_t)1024}; pg8::EpiPartial E{PART, 1024};
              pg8::gemm_phase<pg8::EpiPartial, pg8::SplitOrder, true>(lds, g, S, E, tid); }
#endif
            PH_END
            PH_BEGIN
#ifndef NO_A2
            {
                const float* gqa = args.in[I_GQA] + li * QLORA; const float* gkva = args.in[I_GKVA] + li * KVLORA; const float* gkn = args.in[I_GKN] + li * DQK;
                for (int it = gw; it < NTOK + 8 * PAST; it += NGW) {
                    int kvrow, pos; f32x4 kr = (f32x4){0.f, 0.f, 0.f, 0.f};
                    if (it < NTOK) {
                        const int row = it;
                        f32x4 v[4];
                        const bool pr = row < NPROMPT;
                        if (pr) { const float* src = QKVA + (size_t)row * 1024;
                            v[0] = v[1] = (f32x4){0.f, 0.f, 0.f, 0.f};
#pragma unroll
                            for (int j = 2; j < 4; ++j) v[j] = *(const f32x4*)(src + 4 * lane + 256 * j); }
                        else { const float* src = PART + (size_t)(row - NPROMPT) * 1024;
#pragma unroll
                            for (int j = 0; j < 4; ++j) v[j] = (*(const f32x4*)(src + 4 * lane + 256 * j) + *(const f32x4*)(src + 512 * 1024 + 4 * lane + 256 * j)) + (*(const f32x4*)(src + 2 * 512 * 1024 + 4 * lane + 256 * j) + *(const f32x4*)(src + 3 * 512 * 1024 + 4 * lane + 256 * j)); }
                        float sq = 0.f, sk = 0.f;
#pragma unroll
                        for (int j = 0; j < 2; ++j) sq += (v[j].x * v[j].x + v[j].y * v[j].y) + (v[j].z * v[j].z + v[j].w * v[j].w);
                        if (pr) sq = lane < 8 ? STATQ[(size_t)row * 8 + lane] : 0.f;
                        sk = (v[2].x * v[2].x + v[2].y * v[2].y) + (v[2].z * v[2].z + v[2].w * v[2].w);
                        const float rq = 1.0f / sqrtf(wave_sum(sq, lane) * (1.0f / QLORA) + EPS), rk = 1.0f / sqrtf(wave_sum(sk, lane) * (1.0f / KVLORA) + EPS);
                        if (!pr) {
#pragma unroll
                            for (int j = 0; j < 2; ++j) { const f32x4 h = v[j] * rq; u32x2 w; w.x = cvt_pk_bf16(h.x, h.y); w.y = cvt_pk_bf16(h.z, h.w);
                                *(u32x2*)(QA + (size_t)row * QLORA + 4 * lane + 256 * j) = w; } }
                        if (lane == 0) RSTDQ[row] = pr ? rq : 1.0f;
                        const f32x4 gk = *(const f32x4*)(gkva + 4 * lane); const f32x4 ck = v[2] * rk * gk;
                        int t;
                        if (row < NPROMPT) { kvrow = row; t = row & (SEQ - 1); pos = t; const int b = row >> 13;
                            *(f32x4*)(out + O_CKVP + ((size_t)(li * 4 + b) * SEQ + t) * KVLORA + 4 * lane) = ck;
                            if (lane < 16) *(f32x4*)(out + O_KRP + ((size_t)(li * 4 + b) * SEQ + t) * 64 + 4 * lane) = v[3]; }
                        else { const int r2 = row - NPROMPT, b = r2 >> 6; t = r2 & 63; kvrow = NPROMPT + b * SKV + PAST + t; pos = PAST + t;
                            *(f32x4*)(out + O_CKVS + ((size_t)(li * 8 + b) * DSEQ + t) * KVLORA + 4 * lane) = ck;
                            if (lane < 16) *(f32x4*)(out + O_KRS + ((size_t)(li * 8 + b) * DSEQ + t) * 64 + 4 * lane) = v[3]; }
                        u32x2 w; w.x = cvt_pk_bf16(ck.x, ck.y); w.y = cvt_pk_bf16(ck.z, ck.w); *(u32x2*)(CKV + (size_t)kvrow * KVLORA + 4 * lane) = w;
                        kr = v[3];
                    } else {
                        const int c2 = it - NTOK, b = c2 >> 12, p = c2 & (PAST - 1); kvrow = NPROMPT + b * SKV + p; pos = p;
                        const f32x4 ck = *(const f32x4*)(args.in[I_CCKV] + ((size_t)(li * 8 + b) * PAST + p) * KVLORA + 4 * lane);
                        u32x2 w; w.x = cvt_pk_bf16(ck.x, ck.y); w.y = cvt_pk_bf16(ck.z, ck.w); *(u32x2*)(CKV + (size_t)kvrow * KVLORA + 4 * lane) = w;
                        if (lane < 16) kr = *(const f32x4*)(args.in[I_CKR] + ((size_t)(li * 8 + b) * PAST + p) * 64 + 4 * lane);
                    }
                    float ssk = (lane < 16) ? (kr.x * kr.x + kr.y * kr.y) + (kr.z * kr.z + kr.w * kr.w) : 0.f;
                    ssk = sum16(ssk, lane);
                    const f32x4 gr = (lane < 16) ? *(const f32x4*)(gkn + 128 + 4 * lane) : (f32x4){0.f, 0.f, 0.f, 0.f};
                    const f32x4 kg = kr * gr;
                    f32x4 other; other.x = shx(kg.x, 8, lane); other.y = shx(kg.y, 8, lane); other.z = shx(kg.z, 8, lane); other.w = shx(kg.w, 8, lane);
                    if (lane < 16) {
                        const int jb = 4 * (lane & 7); f32x4 o;
#pragma unroll
                        for (int e = 0; e < 4; ++e) { const f32x2 cs = *(const f32x2*)(ROPE + ((size_t)pos * 32 + jb + e) * 2); const float c = cs.x, s = cs.y;
                            o[e] = (lane < 8) ? kg[e] * c - other[e] * s : other[e] * s + kg[e] * c; }
                        *(f32x4*)(Rr + (size_t)kvrow * 64 + 4 * lane) = o;
                        if (lane == 0) KRSS[kvrow] = ssk;
                    }
                }
            }
#endif
            PH_END
            PH_BEGIN
#ifndef NO_A3
            { pg8::Gemm g = pg8::gemm_rm(QA, (const bf16_t*)(wb + WSZ_DQKV), QLORA, QLORA, QLORA); pg8::StaticOrder S; S.init(NTOK / 256, 12, G, bx); pg8::EpiBf16 E{Qb, 3072, RSTDQ};
              pg8::gemm_phase<pg8::EpiBf16, pg8::StaticOrder, true>(lds, g, S, E, tid); }
            { pg8::Gemm g = pg8::gemm_rm(CKV, (const bf16_t*)(wb + WSZ_DQKV + WSZ_UQ), KVLORA, KVLORA, KVLORA); pg8::StaticOrder S; S.init(NKV / 256, 16, G, (G % 8 == 0 && G > 64) ? (bx + 32) % G : bx);     pg8::EpiKV E{KB, KRSS, Rr, args.in[I_GKN] + li * DQK, (LAS float*)(lds + MISC_OFF + 1024)};
              pg8::gemm_phase<pg8::EpiKV, pg8::StaticOrder, true>(lds, g, S, E, tid); }
#endif
            PH_END
            PH_BEGIN
#ifndef NO_A5
            {
                bool fx_ok;
                { float gq = 0.f, gk = 0.f;
                  for (int e = lane; e < DQK; e += 64) { gq = fmaxf(gq, fabsf(args.in[I_GQN][li * DQK + e])); gk = fmaxf(gk, fabsf(args.in[I_GKN][li * DQK + e])); }
#pragma unroll
                  for (int o_ = 1; o_ < 64; o_ <<= 1) { gq = fmaxf(gq, shx(gq, o_, lane)); gk = fmaxf(gk, shx(gk, o_, lane)); }
                  fx_ok = __builtin_amdgcn_readfirstlane(__float_as_int(gq * gk * (1.4427f * 13.8564f * 1.03f))) < __float_as_int(60.0f); }
                const int nun = ((vcu & 1) == 0) ? 9 : 8;
                for (int un = 0; un < nun; ++un) {
                    const bf16_t* q_; const bf16_t* k_; const bf16_t* v_; bf16_t* o_; int NT_, NTr_, nv_, wq_, pos0_, rev_;
                    if (un < 8) { const int x = vcu >> 5, i = vcu & 31; const int bh = x * 8 + (un >> 1) * 2 + (un & 1), b = bh >> 4, h = bh & 15; const int qb = (un & 1) == 0 ? i : ((un >> 1) < 2 ? 31 - (i ^ 1) : 31 - i);     const size_t qrow = (size_t)b * SEQ + 256 * qb;
                        q_ = Qb + qrow * 3072 + h * DQK; k_ = KB + (size_t)b * SEQ * 5120 + h * 320; v_ = k_ + 192; o_ = Hb + qrow * DM + h * 128;
                        NT_ = 4 * (qb + 1); NTr_ = NT_; nv_ = 4 * qb + (wave >> 1) + 1; wq_ = wave; pos0_ = 256 * qb; rev_ = un & 1; }
                    else { const int su = vcu >> 1, b = su >> 4, h = su & 15; const size_t qrow = NPROMPT + (size_t)b * DSEQ, kvr = NPROMPT + (size_t)b * SKV;
                        q_ = Qb + qrow * 3072 + h * DQK; k_ = KB + kvr * 5120 + h * 320; v_ = k_ + 192; o_ = Hb + qrow * DM + h * 128;
                        NT_ = 66; NTr_ = 65; nv_ = wave < 2 ? 65 : 0; wq_ = wave & 1; pos0_ = PAST; rev_ = 0; }
                    if (fx_ok) att::attn_unit<true>(q_, k_, v_, o_, NT_, NTr_, nv_, wq_, rev_, (LAS char*)lds, tid, args.in[I_GQN] + li * DQK, ROPE, pos0_);
                    else att::attn_unit<false>(q_, k_, v_, o_, NT_, NTr_, nv_, wq_, rev_, (LAS char*)lds, tid, args.in[I_GQN] + li * DQK, ROPE, pos0_);
                }
            }
#endif
            PH_END
            PH_BEGIN
#ifndef NO_A6
            { pg8::Gemm g = pg8::gemm_rm(Hb, (const bf16_t*)(wb + WSZ_DQKV + WSZ_UQ + WSZ_UKV), DM, DM, DM); pg8::StaticOrder S; S.init(128, 8, G, bx); pg8::EpiResid E{args.in[I_XP], out, XBs, modl + 4096, (l == 0) ? 1 : 0, 0};
              pg8::gemm_phase<pg8::EpiResid, pg8::StaticOrder, true>(lds, g, S, E, tid); }
            { pg8::Gemm g = pg8::gemm_rm(Hb, (const bf16_t*)(wb + WSZ_DQKV + WSZ_UQ + WSZ_UKV), DM, DM, 512); pg8::SplitOrder S{bx, 8, 4, (size_t)1024}; pg8::EpiPartial E{PART, DM};
              pg8::gemm_phase<pg8::EpiPartial, pg8::SplitOrder, true>(lds, g, S, E, tid); }
#endif
            PH_END
        } else {
#undef wb
#define wb (ws + WS_S5 + li * WSZ_S5)
            PH_BEGIN
#ifndef NO_S0
            NORM_ROWS(false, false, args.in[I_GMIX] + l * DM, 0, 2048, 1, 11, PREV_GATE_F, 0);
#endif
            PH_END
            PH_BEGIN
#ifndef NO_S1
            { pg8::Gemm g = pg8::gemm_rm(UP, (const bf16_t*)(wb + WSZ_GG + WSZ_BTY), 384, 256, 256); pg8::GroupOrder S{G, bx}; pg8::EpiXloc E{XLOC};
              pg8::gemm_phase<pg8::EpiXloc, pg8::GroupOrder, true>(lds, g, S, E, tid); }
#endif
            PH_END
            PH_BEGIN
#ifndef NO_S2
            {
                for (int it = gw; it < NSLOT * NGRP; it += NGW) {
                    const int slot = it >> 7, g = it & 127, n = lane;
                    const float ar = A16[((li * NGRP + g) * 64 + n) * 2], ai = A16[((li * NGRP + g) * 64 + n) * 2 + 1];
                    float xr = 0.f, xi = 0.f; int c0, nc;
                    if (slot < 4) { c0 = slot * 512; nc = 512; }
                    else { const int b = slot - 4; c0 = 2048 + 4 * b; nc = 4; xr = args.in[I_SRE][((size_t)(li * 8 + b) * NGRP + g) * 64 + n]; xi = args.in[I_SIM][((size_t)(li * 8 + b) * NGRP + g) * 64 + n]; }
                    const bf16_t* xl = XLOC + ((size_t)g * NSUB + c0) * 128; bf16_t* up = UP + ((size_t)g * NSUB + c0) * 384 + 256;
#define S2_STEP(LR, LI, Q) do { const unsigned pk = cvt_pk_bf16(xr, xi); up[(size_t)(c + (Q)) * 384 + n] = (bf16_t)(pk & 0xffffu); up[(size_t)(c + (Q)) * 384 + 64 + n] = (bf16_t)(pk >> 16); \
                            const float nr = ar * xr - ai * xi + (LR), ni = ar * xi + ai * xr + (LI); xr = nr; xi = ni; } while (0)
                    if (nc == 4) { const int c = 0; float lr[4], lim[4];
#pragma unroll
                        for (int q = 0; q < 4; ++q) { lr[q] = bf_lo((unsigned)xl[(size_t)q * 128 + n]); lim[q] = bf_lo((unsigned)xl[(size_t)q * 128 + 64 + n]); }
#pragma unroll
                        for (int q = 0; q < 4; ++q) S2_STEP(lr[q], lim[q], q);
                    } else {
                        float lr[16], lim[16];
#pragma unroll
                        for (int q = 0; q < 16; ++q) { lr[q] = bf_lo((unsigned)xl[(size_t)q * 128 + n]); lim[q] = bf_lo((unsigned)xl[(size_t)q * 128 + 64 + n]); }
                        for (int c = 0; c < nc; c += 16) {
                            float nr_[16], ni_[16]; const int cn = c + 16 < nc ? c + 16 : c;
#pragma unroll
                            for (int q = 0; q < 16; ++q) { nr_[q] = bf_lo((unsigned)xl[(size_t)(cn + q) * 128 + n]); ni_[q] = bf_lo((unsigned)xl[(size_t)(cn + q) * 128 + 64 + n]); }
#pragma unroll
                            for (int q = 0; q < 16; ++q) S2_STEP(lr[q], lim[q], q);
#pragma unroll
                            for (int q = 0; q < 16; ++q) { lr[q] = nr_[q]; lim[q] = ni_[q]; }
                        }
                    }
#undef S2_STEP
                    if (slot < 4) { out[O_REP + ((size_t)(li * 4 + slot) * NGRP + g) * 64 + n] = xr; out[O_IMP + ((size_t)(li * 4 + slot) * NGRP + g) * 64 + n] = xi; }
                    else { out[O_RES + ((size_t)(li * 8 + slot - 4) * NGRP + g) * 64 + n] = xr; out[O_IMS + ((size_t)(li * 8 + slot - 4) * NGRP + g) * 64 + n] = xi; }
                }
            }
#endif
            PH_END
            PH_BEGIN
#ifndef NO_S3
            { pg8::Gemm g = pg8::gemm_rm(UP, (const bf16_t*)(wb + WSZ_GG), 384, 384, 384); pg8::GroupOrder S{G, bx}; pg8::EpiY E{UP, Hb, args.in[I_SD] + li * DM};
              pg8::gemm_phase<pg8::EpiY, pg8::GroupOrder, true>(lds, g, S, E, tid); }
#endif
            PH_END
            PH_BEGIN
#ifndef NO_S4
            { pg8::Gemm g = pg8::gemm_rm(Hb, (const bf16_t*)wb, DM, DM, DM); pg8::StaticOrder S; S.init(128, 16, G, bx); pg8::EpiGlu E{XBs, modl + 4096};
              pg8::gemm_phase<pg8::EpiGlu, pg8::StaticOrder, true>(lds, g, S, E, tid); }
            { pg8::Gemm g = pg8::gemm_rm(Hb, (const bf16_t*)wb, DM, DM, 512); pg8::SplitOrder S{bx, 16, 4, (size_t)1024}; pg8::EpiPartial E{PART, 4096};
              pg8::gemm_phase<pg8::EpiPartial, pg8::SplitOrder, true>(lds, g, S, E, tid); }
#endif
            PH_END
        }
        {
#undef wb
#define wb (ws + WS_FFN + l * WSZ_FFN)
            PH_BEGIN
#ifndef NO_F0
            NORM_ROWS(false, l == 0, args.in[I_GFFN] + l * DM, 6144, 8192, 0, 4, modl + 4096, (l & 1));
#endif
            PH_END
            PH_BEGIN
#ifndef NO_F1
            { pg8::Gemm g = pg8::gemm_rm(Hb, (const bf16_t*)wb, DM, DM, DM); pg8::StaticOrder S; S.init(128, 44, G, bx);
              pg8::EpiFfn E{HID, args.in[I_FCW] + (size_t)l * 3 * DFF, args.in[I_FCB] + (size_t)l * DFF, out + O_CONVP + (size_t)l * 4 * 2 * DFF, GBND, DEFC, DEFU, (LAS float*)(lds + MISC_OFF + 1024)};
              pg8::gemm_phase<pg8::EpiFfn, pg8::StaticOrder, true>(lds, g, S, E, tid); }
            { pg8::Gemm g = pg8::gemm_rm(Hb, (const bf16_t*)wb, DM, DM, 1024); pg8::SplitOrder S{bx, 44, 2, (size_t)2048}; pg8::EpiPartial E{PGU, 2 * DFF};
              pg8::gemm_phase<pg8::EpiPartial, pg8::SplitOrder, true>(lds, g, S, E, tid); }
#endif
            PH_END
            PH_BEGIN
#ifndef NO_F2
            for (int it = gw; it < 512 * 22; it += NGW) { const int r = it / 22, c = (it - r * 22) * 256 + 4 * lane; const int b = r >> 6, t = r & 63;
                const float* cwp = args.in[I_FCW] + (size_t)l * 3 * DFF + c; const f32x4 w0 = *(const f32x4*)cwp, w1 = *(const f32x4*)(cwp + DFF), w2 = *(const f32x4*)(cwp + 2 * DFF), cbv = *(const f32x4*)(args.in[I_FCB] + (size_t)l * DFF + c);
                const float* pg = PGU + (size_t)r * (2 * DFF) + (c >> 7) * 256 + (c & 127); const size_t ps = (size_t)512 * 2 * DFF;
                const float* cc = args.in[I_CCONV] + ((size_t)(l * 8 + b) * 2) * DFF + c;
                const f32x4 g2 = *(const f32x4*)pg + *(const f32x4*)(pg + ps);
                const f32x4 g1 = t >= 1 ? *(const f32x4*)(pg - 2 * DFF) + *(const f32x4*)(pg - 2 * DFF + ps) : *(const f32x4*)(cc + DFF);
                const f32x4 g0 = t >= 2 ? *(const f32x4*)(pg - 4 * DFF) + *(const f32x4*)(pg - 4 * DFF + ps) : *(const f32x4*)(cc + (t == 1 ? DFF : 0));
                const f32x4 uu = *(const f32x4*)(pg + 128) + *(const f32x4*)(pg + 128 + ps);
                f32x4 h;
#pragma unroll
                for (int e = 0; e < 4; ++e) { const float gc = cbv[e] + w0[e] * g0[e] + w1[e] * g1[e] + w2[e] * g2[e]; h[e] = -1.4426950408889634f * (gc * fast_sigmoid(gc) * uu[e]); }
                u32x2 w; w.x = cvt_pk_bf16(h[0], h[1]); w.y = cvt_pk_bf16(h[2], h[3]);
                *(u32x2*)(HID + pg8::tiled_off(NPROMPT + r, c, DFF / 64)) = w;
                if (t >= DSEQ - 2) *(f32x4*)(out + O_CONVS + ((size_t)(l * 8 + b) * 2 + (t - (DSEQ - 2))) * DFF + c) = g2; }
            for (int it = gw * 64 + lane; it < 128 * 2 * (DFF / 4); it += NGW * 64) { const int pm = it / (2 * (DFF / 4)), rem = it - pm * (2 * (DFF / 4)), rr = rem / (DFF / 4), c = (rem - rr * (DFF / 4)) * 4;
                if ((pm & 31) == 0) continue;
                const float* cwp = args.in[I_FCW] + (size_t)l * 3 * DFF + c; const f32x4 w0 = *(const f32x4*)cwp, w1 = *(const f32x4*)(cwp + DFF);
                const f32x4 p254 = *(const f32x4*)(GBND + (size_t)((pm - 1) * 2) * DFF + c), p255 = *(const f32x4*)(GBND + (size_t)((pm - 1) * 2 + 1) * DFF + c);
                const f32x4 cp = *(const f32x4*)(DEFC + (size_t)(pm * 2 + rr) * DFF + c), uu = *(const f32x4*)(DEFU + (size_t)(pm * 2 + rr) * DFF + c);
                f32x4 h;
#pragma unroll
                for (int e = 0; e < 4; ++e) { const float gc = rr == 0 ? cp[e] + -1.4426950408889634f * (w0[e] * p254[e] + w1[e] * p255[e]) : cp[e] + -1.4426950408889634f * (w0[e] * p255[e]); h[e] = gc * __builtin_amdgcn_rcpf(1.0f + __builtin_amdgcn_exp2f(gc)) * uu[e]; }
                u32x2 w; w.x = cvt_pk_bf16(h[0], h[1]); w.y = cvt_pk_bf16(h[2], h[3]);
                *(u32x2*)(HID + pg8::tiled_off(pm * 256 + rr, c, DFF / 64)) = w; }
#endif
            PH_END
            PH_BEGIN
#ifndef NO_F3
            { pg8::Gemm g{HID, (const bf16_t*)(wb + 2 * WSZ_FF1), 64, 64, DFF, 32768, 32768, (size_t)88 * 32768, (size_t)88 * 32768};
              pg8::StaticOrder S; S.init(128, 8, G, bx); pg8::EpiResid E{args.in[I_XP], out, XBs, modl + 10240, 0, (l == 3) ? 1 : 0};
              pg8::gemm_phase<pg8::EpiResid, pg8::StaticOrder, true>(lds, g, S, E, tid); }
            { pg8::Gemm g{HID, (const bf16_t*)(wb + 2 * WSZ_FF1), 64, 64, 512, 32768, 32768, (size_t)88 * 32768, (size_t)88 * 32768};
              pg8::SplitOrder S{bx, 8, 11, (size_t)8 * 32768}; pg8::EpiPartial E{PART, DM};
              pg8::gemm_phase<pg8::EpiPartial, pg8::SplitOrder, true>(lds, g, S, E, tid); }
#endif
            PH_END
        }
    }
    PH_BEGIN
    if (gw < 512) { const int row = NPROMPT + gw; const int slot = 4 + (gw >> 6); const float* pg = MOD + (size_t)(3 * NSLOT + slot) * 12288 + 10240;
        f32x4 sp[8];
#pragma unroll
        for (int j = 0; j < 8; ++j) sp[j] = (f32x4){0.f, 0.f, 0.f, 0.f};
        u32x2 xw[8]; f32x4 gq[8];
#pragma unroll
        for (int j = 0; j < 8; ++j) { xw[j] = *(const u32x2*)(XBs + (size_t)row * DM + 4 * lane + 256 * j); gq[j] = *(const f32x4*)(pg + 4 * lane + 256 * j); }
        for (int ks = 0; ks < 11; ++ks) { f32x4 t_[8];
#pragma unroll
            for (int j = 0; j < 8; ++j) t_[j] = *(const f32x4*)(PART + ((size_t)ks * 512 + gw) * DM + 4 * lane + 256 * j);
            asm volatile("" ::: "memory");
#pragma unroll
            for (int j = 0; j < 8; ++j) sp[j] += t_[j]; }
#pragma unroll
        for (int j = 0; j < 8; ++j) { const f32x4 xv = (f32x4){bf_lo(xw[j].x), bf_hi(xw[j].x), bf_lo(xw[j].y), bf_hi(xw[j].y)};
            *(f32x4*)(out + (size_t)row * DM + 4 * lane + 256 * j) = xv + gq[j] * sp[j]; } }
    PH_END
#undef wb
#undef PH_BEGIN
#undef PH_END
}

constexpr int NPHASES = 1 + 2 * (6 + 4) + 2 * (5 + 4) + 1;

extern "C" void kernel_launch(void* const* d_in, const int* in_sizes, int n_in, void* d_out, int out_size, void* d_ws, size_t ws_size, hipStream_t stream) {
    static int grid = 0;
    if (grid == 0) {
        if (n_in != 37 || (size_t)out_size != O_END || ws_size < WS_END) { fprintf(stderr, "kernel_launch: unexpected shapes (n_in %d out %d ws %zu)\n", n_in, out_size, ws_size); grid = -1; return; }
        int dev = 0, cus = 0, per_cu = 0;
        if (hipGetDevice(&dev) != hipSuccess || hipDeviceGetAttribute(&cus, hipDeviceAttributeMultiprocessorCount, dev) != hipSuccess) { grid = -1; return; }
        if (hipFuncSetAttribute((const void*)fwd_kernel, hipFuncAttributeMaxDynamicSharedMemorySize, LDS_BYTES) != hipSuccess) { fprintf(stderr, "kernel_launch: hipFuncSetAttribute failed\n"); grid = -1; return; }
        if (hipOccupancyMaxActiveBlocksPerMultiprocessor(&per_cu, (const void*)fwd_kernel, NWAVES * 64, LDS_BYTES) != hipSuccess || per_cu < 1) { fprintf(stderr, "kernel_launch: occupancy query says %d\n", per_cu); }
        (void)hipGetLastError();
        grid = cus;
    }
    if (grid < 0) return;
    (void)hipMemsetAsync((char*)d_ws + WS_CTL, 0, CTL_ZERO_BYTES, stream);
    Args a{};
    for (int i = 0; i < 37; ++i) a.in[i] = (const float*)d_in[i];
    a.out = (float*)d_out; a.ws = (unsigned char*)d_ws;
#if MK_PER_PHASE
    for (int p = 0; p < NPHASES; ++p) { a.ph_lo = p; a.ph_hi = p + 1; hipLaunchKernelGGL(fwd_kernel, dim3(grid), dim3(NWAVES * 64), LDS_BYTES, stream, a); }
#else
    a.ph_lo = 0; a.ph_hi = NPHASES;
    hipLaunchKernelGGL(fwd_kernel, dim3(grid), dim3(NWAVES * 64), LDS_BYTES, stream, a);
#endif
    const hipError_t le = hipPeekAtLastError();
    if (le != hipSuccess) fprintf(stderr, "kernel_launch: launch failed: %s\n", hipGetErrorName(le));
}
```

```cpp
#include <hip/hip_runtime.h>
#include <cstdio>
#include <cstdint>

#ifndef MK_PER_PHASE
#define MK_PER_PHASE 0
#endif

#define LAS __attribute__((address_space(3)))
#define GAS __attribute__((address_space(1)))
typedef unsigned short bf16_t;
typedef short bf16x8 __attribute__((ext_vector_type(8)));
typedef short s16x4 __attribute__((ext_vector_type(4)));
typedef float f32x4 __attribute__((ext_vector_type(4)));
typedef float f32x2 __attribute__((ext_vector_type(2)));
typedef float f32x16 __attribute__((ext_vector_type(16)));
typedef unsigned u32x4 __attribute__((ext_vector_type(4)));
typedef unsigned u32x2 __attribute__((ext_vector_type(2)));

constexpr int DM = 2048, NPROMPT = 32768, NTOK = 33280, SEQ = 8192, DSEQ = 64, PAST = 4096, SKV = 4160, NKV = 66048, DFF = 5632;
constexpr int NH = 16, DQK = 192, QLORA = 512, KVLORA = 256;
constexpr int NSLOT = 12;
constexpr int NWAVES = 8;
constexpr float EPS = 1e-6f;
constexpr int NGRP = 128, NSUB = 2304;

constexpr size_t O_Y = 0, O_CKVP = 68157440, O_KRP = 84934656, O_CKVS = 89128960, O_KRS = 89391104, O_REP = 89456640, O_IMP = 89522176,
                 O_RES = 89587712, O_IMS = 89718784, O_CONVP = 89849856, O_CONVS = 90030080, O_END = 90390528;

constexpr size_t MiB = 1u << 20;
constexpr size_t WS_CTL = 0, CTL_ZERO_BYTES = 1 * MiB, WS_ZGATE = 128 * 1024;
constexpr size_t WS_MOD = 1 * MiB;
constexpr size_t WS_A16 = 4 * MiB;
constexpr size_t WS_KRSS = 5 * MiB;
constexpr size_t WS_ROPE = 6 * MiB;
constexpr size_t WS_W = 8 * MiB;
constexpr size_t WSZ_DQKV = 4 * MiB, WSZ_UQ = 3 * MiB, WSZ_UKV = 2 * MiB, WSZ_WO = 8 * MiB, WSZ_MLA = 17 * MiB;
constexpr size_t WS_MLA = WS_W;
constexpr size_t WSZ_GG = 16 * MiB, WSZ_BTY = 24 * MiB, WSZ_BTX = 16 * MiB, WSZ_S5 = 56 * MiB;
constexpr size_t WS_S5 = WS_MLA + 2 * WSZ_MLA;
constexpr size_t WSZ_FF1 = 22 * MiB, WSZ_FFN = 66 * MiB;
constexpr size_t WS_FFN = WS_S5 + 2 * WSZ_S5;
constexpr size_t WS_H = WS_FFN + 4 * WSZ_FFN;
constexpr size_t WS_XB = WS_H + 130 * MiB;
constexpr size_t WS_BIG = WS_XB + 130 * MiB;
constexpr size_t OY_QA = 0;
constexpr size_t OY_CKV = 33 * MiB;
constexpr size_t OY_STATQ = 100 * MiB;
constexpr size_t OY_RSTDQ = 102 * MiB;
constexpr size_t OY_R = 66 * MiB;
constexpr size_t WS_Q = WS_BIG;
constexpr size_t WS_KB = WS_Q + 195 * MiB;
constexpr size_t WS_QKVA = WS_KB;
constexpr size_t WS_G = WS_BIG;
constexpr size_t WS_HID = WS_BIG + 358 * MiB;
constexpr size_t WS_PART = WS_BIG + 716 * MiB;
constexpr size_t WS_PGU = WS_BIG + 764 * MiB;
constexpr size_t WS_UP = WS_BIG;
constexpr size_t WS_XLOC = WS_BIG + 216 * MiB;
constexpr size_t WS_END = WS_KB + 645 * MiB;
static_assert(WS_END <= 1536 * MiB, "workspace map");
static_assert(WS_HID + 358 * MiB <= WS_PART && WS_PART + 48 * MiB <= WS_PGU && WS_PGU + 48 * MiB <= WS_END && WS_XLOC + 144 * MiB <= WS_PART, "aliases");

constexpr int RING_BYTES = 131072;
constexpr int MISC_OFF = RING_BYTES;
constexpr int PAR_OFF = RING_BYTES + 1024 + 4096;
constexpr int LDS_BYTES = RING_BYTES + 1024 + 4096 + 2048;

#define RLX_AGENT __ATOMIC_RELAXED, __HIP_MEMORY_SCOPE_AGENT
#define LDS_WAIT() asm volatile("s_waitcnt lgkmcnt(0)" ::: "memory")
#define VM_WAIT() asm volatile("s_waitcnt vmcnt(0)" ::: "memory")

__device__ __forceinline__ unsigned cvt_pk_bf16(float lo, float hi) { unsigned r; asm volatile("v_cvt_pk_bf16_f32 %0, %1, %2" : "=v"(r) : "v"(lo), "v"(hi)); return r; }
__device__ __forceinline__ float bf_lo(unsigned w) { return __uint_as_float(w << 16); }
__device__ __forceinline__ float bf_hi(unsigned w) { return __uint_as_float(w & 0xffff0000u); }
__device__ __forceinline__ float bf1(bf16_t b) { return __uint_as_float(((unsigned)b) << 16); }
__device__ __forceinline__ float shx(float v, int m, int lane) { return __int_as_float(__builtin_amdgcn_ds_bpermute((lane ^ m) << 2, __float_as_int(v))); }
template <int CTRL> __device__ __forceinline__ float dpp_rotf(float v) { return __int_as_float(__builtin_amdgcn_mov_dpp(__float_as_int(v), CTRL, 0xF, 0xF, true)); }
__device__ __forceinline__ float row_sum16(float v) { v += dpp_rotf<0x128>(v); v += dpp_rotf<0x124>(v); v += dpp_rotf<0x122>(v); v += dpp_rotf<0x121>(v); return v; }
__device__ __forceinline__ float wave_sum(float v, int lane) { (void)lane;
    v = row_sum16(v);
    const float s0 = __int_as_float(__builtin_amdgcn_readlane(__float_as_int(v), 0)), s1 = __int_as_float(__builtin_amdgcn_readlane(__float_as_int(v), 16)),
                s2 = __int_as_float(__builtin_amdgcn_readlane(__float_as_int(v), 32)), s3 = __int_as_float(__builtin_amdgcn_readlane(__float_as_int(v), 48));
    return (s0 + s1) + (s2 + s3);
}
__device__ __forceinline__ float sum16(float v, int lane) { (void)lane; return row_sum16(v); }
__device__ __forceinline__ float sum16_old(float v, int lane) {
#pragma unroll
    for (int o = 1; o < 16; o <<= 1) v += shx(v, o, lane);
    return v;
}
__device__ __forceinline__ int slot_of_row(int r) { return r < NPROMPT ? (r >> 13) : 4 + ((r - NPROMPT) >> 6); }
__device__ __forceinline__ float fast_sigmoid(float x) { return __builtin_amdgcn_rcpf(1.0f + __builtin_amdgcn_exp2f(-1.4426950408889634f * x)); }

#ifndef GEMM_SP2
#define GEMM_SP2 true
#endif
namespace pg8 {
constexpr int BM = 256, BK = 64, HALF = 128, HTB = HALF * BK * 2, STAGE_BYTES = 8 * HTB, NXCD = 8, WGM = 8;
__host__ __device__ __forceinline__ int lds_byte(int r, int c) { const int st = (r >> 4) * 2 + (c >> 5), rr = r & 15, cc = c & 31, ob = rr * 64 + cc * 2; return st * 1024 + (ob ^ (((ob >> 9) & 1) << 5)); }
__host__ __device__ __forceinline__ void stage_rc(int b, int& R, int& C) { const int st = b / 1024, sb = b % 1024, swz = sb ^ (((sb >> 9) & 1) << 5); R = (st >> 1) * 16 + swz / 64; C = (st & 1) * 32 + (swz % 64) / 2; }
__host__ __device__ __forceinline__ int perm32(int rho) { const int n = rho >> 4, i = rho & 15; return 8 * (i >> 2) + 4 * n + (i & 3); }

struct Unit { int pm, pn, ks; size_t koff; };
struct Gemm { const bf16_t* A; const bf16_t* Bt; int lda, ldb, K; size_t ksA, ksB, tsA, tsB; };
__device__ __forceinline__ Gemm gemm_rm(const bf16_t* A, const bf16_t* Bt, int lda, int ldb, int K) { return Gemm{A, Bt, lda, ldb, K, 128, 128, (size_t)512 * lda, (size_t)512 * ldb}; }
__device__ __forceinline__ size_t tiled_off(int row, int col, int nkt) { return (((size_t)(row >> 8) * nkt + (col >> 6)) * 256 + (row & 255)) * 64 + (col & 63); }

struct StaticOrder {
    int nM, nN, nwg, G, c;
    __device__ void init(int nM_, int nN_, int G_, int c_) { nM = nM_; nN = nN_; nwg = nM * nN; G = G_; c = c_; }
    __device__ bool next(int i, Unit& u) const {
        const long L = (long)i * G + c; if (L >= nwg) return false;
        int wgid = (int)L; { const int q = nwg / NXCD, r = nwg % NXCD, xcd = wgid % NXCD, off = wgid / NXCD; wgid = (xcd < r ? xcd * (q + 1) : r * (q + 1) + (xcd - r) * q) + off; }
        const int nig = WGM * nN, gid = wgid / nig, fm = gid * WGM, gsz = (nM - fm) < WGM ? (nM - fm) : WGM;
        u.pm = fm + ((wgid % nig) % gsz); u.pn = (wgid % nig) / gsz; u.ks = 0; u.koff = 0; return true;
    }
};
struct SplitOrder {
    int c, nN, nsplit; size_t kbytes;
    __device__ bool next(int i, Unit& u) const { if (i > 0 || c >= 2 * nN * nsplit) return false; const int ks = c % nsplit, t = c / nsplit; u.pm = 128 + t / nN; u.pn = t % nN; u.ks = ks; u.koff = ks * kbytes; return true; }
};
struct GroupOrder {
    int G, c;
    __device__ bool next(int i, Unit& u) const { const int L = i * G + c; if (L >= NGRP * 9) return false; const int g = L < NGRP * 8 ? L >> 3 : L - NGRP * 8, p = L < NGRP * 8 ? (L & 7) : 8;
        u.pm = 9 * g + p; u.pn = g; u.ks = 0; u.koff = 0; return true; }
};

template <class Epi, class Sched, bool ALIGN_EPI, bool SP2 = GEMM_SP2>
__device__ __forceinline__ void gemm_phase(LAS unsigned char* lds, const Gemm g, const Sched& S, const Epi& E, const int tid) {
    const int wid = __builtin_amdgcn_readfirstlane(tid >> 6), lane = tid & 63, wr = wid >> 2, wc = wid & 3, fr = lane & 15, fq = lane >> 4;
    const int K = g.K, nt = K / BK;
    unsigned voffA[2], voffB[2];
#pragma unroll
    for (int i = 0; i < 2; ++i) { int R, C; stage_rc(tid * 16 + i * 8192, R, C); const int Rb = Epi::PERM ? ((R & ~31) + perm32(R & 31)) : R;
        const int Ra = Epi::PERMA ? ((R & ~63) + ((R & 15) << 2) + ((R >> 4) & 3)) : R;
        voffA[i] = (unsigned)(Ra * g.lda + C) * 2u; voffB[i] = (unsigned)(Rb * g.ldb + C) * 2u; }
    const size_t kstepA = g.ksA, kstepB = g.ksB;
    const size_t hstepA = (size_t)HALF * g.lda * 2, hstepB = (size_t)HALF * g.ldb * 2;
    const size_t tstepA = g.tsA, tstepB = g.tsB;
    const unsigned ldsw = (unsigned)wid * 1024u;
    const int aoff = lds_byte(wr * 64 + fr, fq * 8), boff = lds_byte(wc * 32 + fr, fq * 8);
#define PG8_SA(b, h) (((b) * 2 + (h)) * HTB)
#define PG8_SB(b, h) ((4 + (b) * 2 + (h)) * HTB)
#define PG8_STAGE(bufoff, gbase, voff) do { _Pragma("unroll") for (int _i = 0; _i < 2; ++_i) \
        __builtin_amdgcn_global_load_lds((const unsigned*)((const char*)(gbase) + (voff)[_i]), (LAS unsigned*)(lds + (bufoff) + ldsw + _i * 8192), 16, 0, 0); } while (0)
#define PG8_LDA(dst, b, h) do { _Pragma("unroll") for (int m = 0; m < 4; ++m) _Pragma("unroll") for (int k = 0; k < 2; ++k) dst[m][k] = *(const LAS bf16x8*)(lds + PG8_SA(b, h) + aoff + m * 2048 + k * 1024); } while (0)
#define PG8_LDB(dst, b, h) do { _Pragma("unroll") for (int n = 0; n < 2; ++n) _Pragma("unroll") for (int k = 0; k < 2; ++k) dst[n][k] = *(const LAS bf16x8*)(lds + PG8_SB(b, h) + boff + n * 2048 + k * 1024); } while (0)
#define PG8_MMA(ai, bj, At, Bt) do { __builtin_amdgcn_s_setprio(1); _Pragma("unroll") for (int m = 0; m < 4; ++m) _Pragma("unroll") for (int n = 0; n < 2; ++n) _Pragma("unroll") for (int k = 0; k < 2; ++k) \
        acc[ai][bj][m][n] = __builtin_amdgcn_mfma_f32_16x16x32_bf16(Bt[n][k], At[m][k], acc[ai][bj][m][n], 0, 0, 0); __builtin_amdgcn_s_setprio(0); } while (0)
#define PG8_WAIT_V(n) asm volatile("s_waitcnt vmcnt(" #n ")" ::: "memory")
#define PG8_WAIT_L(n) asm volatile("s_waitcnt lgkmcnt(" #n ")" ::: "memory")
#define PG8_WAIT_VP(n) do { if constexpr (Epi::NPRE == 0) { PG8_WAIT_V(n); } else { static_assert(Epi::NPRE == 1 && n == 8, "counts"); if (pf) PG8_WAIT_V(9); else PG8_WAIT_V(8); } } while (0)
#define PG8_BAR __builtin_amdgcn_s_barrier()
#define PG8_SCHED __builtin_amdgcn_sched_barrier(0)
    Unit cur, nxt; int ui = 0;
    if (!S.next(0, cur)) return;
    f32x4 acc[2][2][4][2];
#pragma unroll
    for (int a = 0; a < 2; ++a)
#pragma unroll
        for (int b = 0; b < 2; ++b)
#pragma unroll
            for (int m = 0; m < 4; ++m)
#pragma unroll
                for (int n = 0; n < 2; ++n) acc[a][b][m][n] = (f32x4){0.f, 0.f, 0.f, 0.f};
    bf16x8 At[4][2], B0[2][2], B1[2][2];
    const char* cA = (const char*)g.A + (size_t)cur.pm * tstepA + cur.koff; const char* cB = (const char*)g.Bt + (size_t)cur.pn * tstepB + cur.koff;
    if constexpr (SP2) {
    PG8_STAGE(PG8_SB(0, 0), cB, voffB); PG8_STAGE(PG8_SB(0, 1), cB + hstepB, voffB); PG8_STAGE(PG8_SA(0, 0), cA, voffA); PG8_STAGE(PG8_SA(0, 1), cA + hstepA, voffA);
    if (wr == 1) PG8_BAR;
    PG8_WAIT_V(2); PG8_BAR;
    PG8_STAGE(PG8_SB(1, 0), cB + kstepB, voffB); PG8_STAGE(PG8_SA(1, 0), cA + kstepA, voffA); PG8_STAGE(PG8_SB(1, 1), cB + hstepB + kstepB, voffB);
    PG8_WAIT_V(6); PG8_BAR;
    } else {
    PG8_STAGE(PG8_SB(0, 0), cB, voffB); PG8_STAGE(PG8_SA(0, 0), cA, voffA); PG8_STAGE(PG8_SB(0, 1), cB + hstepB, voffB); PG8_STAGE(PG8_SA(0, 1), cA + hstepA, voffA);
    if (wr == 1) PG8_BAR;
    PG8_WAIT_V(4); PG8_BAR;
    PG8_STAGE(PG8_SB(1, 0), cB + kstepB, voffB); PG8_STAGE(PG8_SA(1, 0), cA + kstepA, voffA); PG8_STAGE(PG8_SB(1, 1), cB + hstepB + kstepB, voffB);
    PG8_WAIT_V(6); PG8_BAR;
    }
    for (;;) {
        const bool has_next = S.next(ui + 1, nxt);
        const char* nA = has_next ? (const char*)g.A + (size_t)nxt.pm * tstepA + nxt.koff : cA; const char* nB = has_next ? (const char*)g.Bt + (size_t)nxt.pn * tstepB + nxt.koff : cB;
#pragma unroll 1
        for (int t = 0; t < nt; t += 2) {
            const bool last = (t == nt - 2);
            const char* a1 = cA + (size_t)(t + 1) * kstepA;
            const char* a2 = last ? nA : cA + (size_t)(t + 2) * kstepA; const char* b2 = last ? nB : cB + (size_t)(t + 2) * kstepB;
            const char* a3 = a2 + kstepA; const char* b3 = b2 + kstepB;
            const bool pf = Epi::NPRE > 0 && (t == nt - 4);
            if constexpr (Epi::NPRE > 0) { if (pf) E.prefetch(lds, cur, wid, lane); }
            if constexpr (SP2) {
            PG8_LDB(B0, 0, 0); PG8_LDB(B1, 0, 1); PG8_SCHED; PG8_LDA(At, 0, 0); PG8_STAGE(PG8_SA(1, 1), a1 + hstepA, voffA);
            PG8_WAIT_VP(8); PG8_WAIT_L(0); PG8_BAR; PG8_MMA(0, 0, At, B0); PG8_MMA(0, 1, At, B1); PG8_BAR; PG8_SCHED;
            PG8_LDA(At, 0, 1); PG8_STAGE(PG8_SB(0, 0), b2, voffB); PG8_STAGE(PG8_SB(0, 1), b2 + hstepB, voffB); PG8_STAGE(PG8_SA(0, 0), a2, voffA);
            PG8_WAIT_VP(8); PG8_WAIT_L(0); PG8_BAR; PG8_MMA(1, 0, At, B0); PG8_MMA(1, 1, At, B1); PG8_BAR; PG8_SCHED;
            PG8_LDB(B0, 1, 0); PG8_LDB(B1, 1, 1); PG8_SCHED; PG8_LDA(At, 1, 0); PG8_STAGE(PG8_SA(0, 1), a2 + hstepA, voffA);
            PG8_WAIT_VP(8); PG8_WAIT_L(0); PG8_BAR; PG8_MMA(0, 0, At, B0); PG8_MMA(0, 1, At, B1); PG8_BAR; PG8_SCHED;
            PG8_LDA(At, 1, 1); PG8_STAGE(PG8_SB(1, 0), b3, voffB); PG8_STAGE(PG8_SB(1, 1), b3 + hstepB, voffB); PG8_STAGE(PG8_SA(1, 0), a3, voffA);
            PG8_WAIT_VP(8); PG8_WAIT_L(0); PG8_BAR; PG8_MMA(1, 0, At, B0); PG8_MMA(1, 1, At, B1); PG8_BAR; PG8_SCHED;
            } else {
            PG8_LDB(B0, 0, 0); PG8_SCHED; PG8_LDA(At, 0, 0); PG8_STAGE(PG8_SA(1, 1), a1 + hstepA, voffA);
            PG8_WAIT_L(8); PG8_BAR; PG8_WAIT_L(0); PG8_MMA(0, 0, At, B0); PG8_BAR; PG8_SCHED;
            PG8_LDB(B1, 0, 1); PG8_STAGE(PG8_SB(0, 0), b2, voffB);
            PG8_BAR; PG8_WAIT_L(0); PG8_MMA(0, 1, At, B1); PG8_BAR;
            PG8_LDA(At, 0, 1); PG8_STAGE(PG8_SA(0, 0), a2, voffA);
            PG8_BAR; PG8_WAIT_L(0); PG8_MMA(1, 0, At, B0); PG8_BAR; PG8_SCHED;
            PG8_STAGE(PG8_SB(0, 1), b2 + hstepB, voffB);
            PG8_WAIT_V(6); PG8_BAR; PG8_MMA(1, 1, At, B1); PG8_BAR;
            PG8_LDB(B0, 1, 0); PG8_SCHED; PG8_LDA(At, 1, 0); PG8_STAGE(PG8_SA(0, 1), a2 + hstepA, voffA);
            PG8_WAIT_L(8); PG8_BAR; PG8_WAIT_L(0); PG8_MMA(0, 0, At, B0); PG8_BAR; PG8_SCHED;
            PG8_LDB(B1, 1, 1); PG8_STAGE(PG8_SB(1, 0), b3, voffB);
            PG8_BAR; PG8_WAIT_L(0); PG8_MMA(0, 1, At, B1); PG8_BAR;
            PG8_LDA(At, 1, 1); PG8_STAGE(PG8_SA(1, 0), a3, voffA);
            PG8_BAR; PG8_WAIT_L(0); PG8_MMA(1, 0, At, B0); PG8_BAR; PG8_SCHED;
            PG8_STAGE(PG8_SB(1, 1), b3 + hstepB, voffB);
            PG8_WAIT_V(6); PG8_BAR; PG8_MMA(1, 1, At, B1); PG8_BAR;
            }
        }
        if constexpr (ALIGN_EPI) { if (wr == 0) PG8_BAR; }
        E(acc, cur, wr, wc, fr, fq);
        if (!has_next) break;
#pragma unroll
        for (int a = 0; a < 2; ++a)
#pragma unroll
            for (int b = 0; b < 2; ++b)
#pragma unroll
                for (int m = 0; m < 4; ++m)
#pragma unroll
                    for (int n = 0; n < 2; ++n) acc[a][b][m][n] = (f32x4){0.f, 0.f, 0.f, 0.f};
        cur = nxt; cA = nA; cB = nB; ++ui;
        if constexpr (ALIGN_EPI) { if (wr == 1) PG8_BAR; }
    }
    PG8_WAIT_V(0);
    if constexpr (!ALIGN_EPI) { if (wr == 0) PG8_BAR; }
    PG8_BAR;
#undef PG8_SA
#undef PG8_SB
#undef PG8_STAGE
#undef PG8_LDA
#undef PG8_LDB
#undef PG8_MMA
#undef PG8_WAIT_V
#undef PG8_WAIT_VP
#undef PG8_WAIT_L
#undef PG8_BAR
#undef PG8_SCHED
}

typedef f32x4 Acc[2][2][4][2];

struct EpiF32 {
    static constexpr int NPRE = 0; static constexpr bool PERMA = false;
    static constexpr bool PERM = false;
    float* C; int ldc;
    __device__ __forceinline__ void operator()(const Acc& acc, const Unit& u, int wr, int wc, int fr, int fq) const {
        const int row0 = u.pm * BM + wr * 64 + fr, col0 = u.pn * BM + wc * 32 + 4 * fq;
#pragma unroll
        for (int ai = 0; ai < 2; ++ai)
#pragma unroll
            for (int m = 0; m < 4; ++m) { float* rowp = C + (size_t)(row0 + ai * HALF + m * 16) * ldc + col0;
#pragma unroll
                for (int bj = 0; bj < 2; ++bj)
#pragma unroll
                    for (int n = 0; n < 2; ++n) *(f32x4*)(rowp + bj * HALF + n * 16) = acc[ai][bj][m][n]; }
    }
};
__device__ __forceinline__ u32x4 pack8(const f32x4& v0, const f32x4& v1) { u32x4 w; w.x = cvt_pk_bf16(v0[0], v0[1]); w.y = cvt_pk_bf16(v0[2], v0[3]); w.z = cvt_pk_bf16(v1[0], v1[1]); w.w = cvt_pk_bf16(v1[2], v1[3]); return w; }
struct EpiBf16 {
    static constexpr int NPRE = 0; static constexpr bool PERMA = false;
    static constexpr bool PERM = true;
    bf16_t* O; int ldc; const float* rs;
    __device__ __forceinline__ void operator()(const Acc& acc, const Unit& u, int wr, int wc, int fr, int fq) const {
        const int row0 = u.pm * BM + wr * 64 + fr, col0 = u.pn * BM + wc * 32 + 8 * fq;
        float sc[2][4];
#pragma unroll
        for (int ai = 0; ai < 2; ++ai)
#pragma unroll
            for (int m = 0; m < 4; ++m) sc[ai][m] = rs[row0 + ai * HALF + m * 16];
#pragma unroll
        for (int ai = 0; ai < 2; ++ai)
#pragma unroll
            for (int m = 0; m < 4; ++m) { bf16_t* rowp = O + (size_t)(row0 + ai * HALF + m * 16) * ldc + col0;
#pragma unroll
                for (int bj = 0; bj < 2; ++bj) *(u32x4*)(rowp + bj * HALF) = pack8(acc[ai][bj][m][0] * sc[ai][m], acc[ai][bj][m][1] * sc[ai][m]); }
    }
};
struct EpiA1 {
    static constexpr int NPRE = 0; static constexpr bool PERMA = false;
    static constexpr bool PERM = true;
    float* C; bf16_t* Q; float* stat;
    __device__ __forceinline__ void operator()(const Acc& acc, const Unit& u, int wr, int wc, int fr, int fq) const {
        const int lane = fr + 16 * fq;
        const int row0 = u.pm * BM + wr * 64 + fr, col0 = u.pn * BM + wc * 32 + 8 * fq;
        if (u.pn < 2) {
#pragma unroll
            for (int ai = 0; ai < 2; ++ai)
#pragma unroll
                for (int m = 0; m < 4; ++m) { const int row = row0 + ai * HALF + m * 16; float ss = 0.f;
#pragma unroll
                    for (int bj = 0; bj < 2; ++bj) { const f32x4 a = acc[ai][bj][m][0], b = acc[ai][bj][m][1];
                        *(u32x4*)(Q + (size_t)row * QLORA + col0 + bj * HALF) = pack8(a, b);
                        ss += ((a[0] * a[0] + a[1] * a[1]) + (a[2] * a[2] + a[3] * a[3])) + ((b[0] * b[0] + b[1] * b[1]) + (b[2] * b[2] + b[3] * b[3])); }
                    ss += shx(ss, 16, lane); ss += shx(ss, 32, lane);
                    if (fq == 0) stat[(size_t)row * 8 + u.pn * 4 + wc] = ss; }
        } else {
#pragma unroll
            for (int ai = 0; ai < 2; ++ai)
#pragma unroll
                for (int m = 0; m < 4; ++m) { float* rowp = C + (size_t)(row0 + ai * HALF + m * 16) * 1024 + col0;
#pragma unroll
                    for (int bj = 0; bj < 2; ++bj) { *(f32x4*)(rowp + bj * HALF) = acc[ai][bj][m][0]; *(f32x4*)(rowp + bj * HALF + 4) = acc[ai][bj][m][1]; } }
        }
    }
};
struct EpiKV {
    static constexpr int NPRE = 0; static constexpr bool PERMA = false;
    static constexpr bool PERM = true;
    bf16_t* KV; const float* krss; const float* R; const float* gkn; LAS float* scr;
    __device__ __forceinline__ void operator()(const Acc& acc, const Unit& u, int wr, int wc, int fr, int fq) const {
        const int lane = fr + 16 * fq;
#pragma unroll
        for (int ai = 0; ai < 2; ++ai)
#pragma unroll
            for (int m = 0; m < 4; ++m) { const f32x4 a = acc[ai][0][m][0], b = acc[ai][0][m][1];
                float s = (a[0] * a[0] + a[1] * a[1]) + (a[2] * a[2] + a[3] * a[3]) + (b[0] * b[0] + b[1] * b[1]) + (b[2] * b[2] + b[3] * b[3]);
                s += shx(s, 16, lane); s += shx(s, 32, lane);
                if (fq == 0) scr[(ai * HALF + wr * 64 + m * 16 + fr) * 4 + wc] = s; }
        const int row0 = u.pm * BM + wr * 64 + fr;
        bf16_t* base = KV + (size_t)row0 * 5120 + u.pn * 320;
        const f32x4 g0 = *(const f32x4*)(gkn + wc * 32 + 8 * fq), g1 = *(const f32x4*)(gkn + wc * 32 + 8 * fq + 4);
        float kr[2][4]; f32x4 rv[2][4];
#pragma unroll
        for (int ai = 0; ai < 2; ++ai)
#pragma unroll
            for (int m = 0; m < 4; ++m) { const size_t row = (size_t)(row0 + ai * HALF + m * 16); kr[ai][m] = krss[row]; rv[ai][m] = *(const f32x4*)(R + row * 64 + wc * 16 + 4 * fq); }
        asm volatile("s_waitcnt lgkmcnt(0)\n\ts_barrier" ::: "memory");
#pragma unroll
        for (int ai = 0; ai < 2; ++ai)
#pragma unroll
            for (int m = 0; m < 4; ++m) { const int rl = ai * HALF + m * 16;
                const f32x4 sp = *(const LAS f32x4*)(scr + (rl + wr * 64 + fr) * 4);
                const float r = 1.0f / sqrtf(((sp[0] + sp[1]) + (sp[2] + sp[3]) + kr[ai][m]) * (1.0f / 192.0f) + EPS);
                bf16_t* rowp = base + (size_t)rl * 5120;
                *(u32x4*)(rowp + wc * 32 + 8 * fq) = pack8(acc[ai][0][m][0] * g0 * r, acc[ai][0][m][1] * g1 * r);
                *(u32x4*)(rowp + 192 + wc * 32 + 8 * fq) = pack8(acc[ai][1][m][0], acc[ai][1][m][1]);
                const f32x4 rr = rv[ai][m] * r;
                u32x2 w; w.x = cvt_pk_bf16(rr[0], rr[1]); w.y = cvt_pk_bf16(rr[2], rr[3]);
                *(u32x2*)(rowp + 128 + wc * 16 + 4 * fq) = w; }
    }
};
struct EpiResid {
    static constexpr int NPRE = 0; static constexpr bool PERMA = false;
    static constexpr bool PERM = true;
    const float* xin32; float* xout32; bf16_t* xb; const float* gate; int inf32, outf32;
    __device__ __forceinline__ void operator()(const Acc& acc, const Unit& u, int wr, int wc, int fr, int fq) const {
        const int col0 = u.pn * BM + wc * 32 + 8 * fq;
#pragma unroll
        for (int ai = 0; ai < 2; ++ai) {
            const int rbase = u.pm * BM + ai * HALF + wr * 64; const float* gp = gate + (size_t)slot_of_row(rbase) * 12288 + col0;
            const size_t off0 = (size_t)(rbase + fr) * DM + col0;
            f32x4 xi[4][2][2];
            if (inf32) {
#pragma unroll
                for (int m = 0; m < 4; ++m)
#pragma unroll
                    for (int bj = 0; bj < 2; ++bj)
#pragma unroll
                        for (int n = 0; n < 2; ++n) xi[m][bj][n] = *(const f32x4*)(xin32 + off0 + (size_t)m * 16 * DM + bj * HALF + n * 4);
            } else { u32x4 xr[4][2];
#pragma unroll
                for (int m = 0; m < 4; ++m)
#pragma unroll
                    for (int bj = 0; bj < 2; ++bj) xr[m][bj] = *(const u32x4*)(xb + off0 + (size_t)m * 16 * DM + bj * HALF);
#pragma unroll
                for (int m = 0; m < 4; ++m)
#pragma unroll
                    for (int bj = 0; bj < 2; ++bj) { xi[m][bj][0] = (f32x4){bf_lo(xr[m][bj].x), bf_hi(xr[m][bj].x), bf_lo(xr[m][bj].y), bf_hi(xr[m][bj].y)}; xi[m][bj][1] = (f32x4){bf_lo(xr[m][bj].z), bf_hi(xr[m][bj].z), bf_lo(xr[m][bj].w), bf_hi(xr[m][bj].w)}; } }
            f32x4 gv[2][2];
#pragma unroll
            for (int bj = 0; bj < 2; ++bj)
#pragma unroll
                for (int n = 0; n < 2; ++n) gv[bj][n] = *(const f32x4*)(gp + bj * HALF + n * 4);
#pragma unroll
            for (int m = 0; m < 4; ++m)
#pragma unroll
                for (int bj = 0; bj < 2; ++bj) { const f32x4 x0 = xi[m][bj][0] + gv[bj][0] * acc[ai][bj][m][0], x1 = xi[m][bj][1] + gv[bj][1] * acc[ai][bj][m][1]; const size_t o = off0 + (size_t)m * 16 * DM + bj * HALF;
                    if (outf32) { *(f32x4*)(xout32 + o) = x0; *(f32x4*)(xout32 + o + 4) = x1; } else *(u32x4*)(xb + o) = pack8(x0, x1); }
            asm volatile("" ::: "memory");
        }
    }
};
struct EpiGlu {
    static constexpr int NPRE = 0; static constexpr bool PERMA = false;
    static constexpr bool PERM = true;
    bf16_t* xb; const float* gate;
    __device__ __forceinline__ void operator()(const Acc& acc, const Unit& u, int wr, int wc, int fr, int fq) const {
        const int col0 = u.pn * HALF + wc * 32 + 8 * fq;
        u32x4 xr[2][4];
#pragma unroll
        for (int ai = 0; ai < 2; ++ai)
#pragma unroll
            for (int m = 0; m < 4; ++m) xr[ai][m] = *(const u32x4*)(xb + (size_t)(u.pm * BM + ai * HALF + wr * 64 + m * 16 + fr) * DM + col0);
#pragma unroll
        for (int ai = 0; ai < 2; ++ai) {
            const int rbase = u.pm * BM + ai * HALF + wr * 64; const float* gp = gate + (size_t)slot_of_row(rbase) * 12288 + col0;
            f32x4 gv[2];
#pragma unroll
            for (int n = 0; n < 2; ++n) gv[n] = *(const f32x4*)(gp + n * 4);
#pragma unroll
            for (int m = 0; m < 4; ++m) { const size_t off = (size_t)(rbase + m * 16 + fr) * DM + col0; f32x4 o[2];
#pragma unroll
                for (int n = 0; n < 2; ++n) { const f32x4 a = acc[ai][0][m][n], b = acc[ai][1][m][n]; const unsigned lo = n == 0 ? xr[ai][m].x : xr[ai][m].z, hi = n == 0 ? xr[ai][m].y : xr[ai][m].w;
                    const f32x4 xi = (f32x4){bf_lo(lo), bf_hi(lo), bf_lo(hi), bf_hi(hi)};
#pragma unroll
                    for (int j = 0; j < 4; ++j) o[n][j] = xi[j] + gv[n][j] * a[j] * fast_sigmoid(b[j]); }
                *(u32x4*)(xb + off) = pack8(o[0], o[1]); }
        }
    }
};
struct EpiGate {
    static constexpr int NPRE = 0; static constexpr bool PERMA = false;
    static constexpr bool PERM = true;
    bf16_t* G; float* convp; float* convs;
    __device__ __forceinline__ void operator()(const Acc& acc, const Unit& u, int wr, int wc, int fr, int fq) const {
        const int col0 = u.pn * BM + wc * 32 + 8 * fq;
#pragma unroll
        for (int ai = 0; ai < 2; ++ai) {
            const int rbase = u.pm * BM + ai * HALF + wr * 64; const int slot = slot_of_row(rbase);
#pragma unroll
            for (int m = 0; m < 4; ++m) { const int row = rbase + m * 16 + fr; bf16_t* rowp = G + (size_t)(row + 2 * (slot + 1)) * DFF + col0;
#pragma unroll
                for (int bj = 0; bj < 2; ++bj) *(u32x4*)(rowp + bj * HALF) = pack8(acc[ai][bj][m][0], acc[ai][bj][m][1]);
                if (m == 3 && fr >= 14) {
                    const bool lastp = (slot < 4) && ((row & (SEQ - 1)) >= SEQ - 2); const bool lasts = (slot >= 4);
                    if (lastp || lasts) { float* cp = (slot < 4 ? convp + (size_t)(slot * 2 + (row & 1)) * DFF : convs + (size_t)((slot - 4) * 2 + (row & 1)) * DFF) + col0;
#pragma unroll
                        for (int bj = 0; bj < 2; ++bj) { *(f32x4*)(cp + bj * HALF) = acc[ai][bj][m][0]; *(f32x4*)(cp + bj * HALF + 4) = acc[ai][bj][m][1]; } }
                }
            }
        }
    }
};
struct EpiUp {
    static constexpr int NPRE = 0; static constexpr bool PERMA = false;
    static constexpr bool PERM = true;
    const bf16_t* G; bf16_t* HID; const float* cw; const float* cb;
    __device__ __forceinline__ void operator()(const Acc& acc, const Unit& u, int wr, int wc, int fr, int fq) const {
        u32x4 ga[3], gb[3];
        const bf16_t* gbase = G + (size_t)(u.pm * BM + wr * 64 + fr) * DFF + u.pn * BM + wc * 32 + 8 * fq;
        const int sl0 = 2 * (slot_of_row(u.pm * BM + wr * 64) + 1), sl1 = 2 * (slot_of_row(u.pm * BM + HALF + wr * 64) + 1);
#define EU_LOAD(DST, B) do { const bf16_t* gp_ = gbase + (size_t)((((B) >> 2) & 1) * HALF + ((B) & 3) * 16 + ((((B) >> 2) & 1) ? sl1 : sl0)) * DFF + ((B) >> 3) * HALF; \
            DST[2] = *(const u32x4*)gp_; DST[1] = *(const u32x4*)(gp_ - DFF); DST[0] = *(const u32x4*)(gp_ - 2 * DFF); } while (0)
#define EU_COMP(SRC, B) do { constexpr int bj_ = (B) >> 3, ai_ = ((B) >> 2) & 1, m_ = (B) & 3; const int col_ = u.pn * BM + bj_ * HALF + wc * 32 + 8 * fq; \
            const int row_ = u.pm * BM + ai_ * HALF + wr * 64 + m_ * 16 + fr; float o_[8]; \
            _Pragma("unroll") for (int q = 0; q < 4; ++q) { \
                const float c0 = bb[2 * q] + w0[2 * q] * bf_lo(SRC[0][q]) + w1[2 * q] * bf_lo(SRC[1][q]) + w2[2 * q] * bf_lo(SRC[2][q]); \
                const float c1 = bb[2 * q + 1] + w0[2 * q + 1] * bf_hi(SRC[0][q]) + w1[2 * q + 1] * bf_hi(SRC[1][q]) + w2[2 * q + 1] * bf_hi(SRC[2][q]); \
                o_[2 * q] = c0 * fast_sigmoid(c0); o_[2 * q + 1] = c1 * fast_sigmoid(c1); } \
            const f32x4 a0 = acc[ai_][bj_][m_][0], a1 = acc[ai_][bj_][m_][1]; \
            u32x4 w_; w_.x = cvt_pk_bf16(o_[0] * a0[0], o_[1] * a0[1]); w_.y = cvt_pk_bf16(o_[2] * a0[2], o_[3] * a0[3]); w_.z = cvt_pk_bf16(o_[4] * a1[0], o_[5] * a1[1]); w_.w = cvt_pk_bf16(o_[6] * a1[2], o_[7] * a1[3]); \
            *(u32x4*)(HID + tiled_off(row_, col_, DFF / 64)) = w_; } while (0)
#define EU_PARAMS(BJ) do { const int col_ = u.pn * BM + (BJ) * HALF + wc * 32 + 8 * fq; _Pragma("unroll") for (int h = 0; h < 2; ++h) { const f32x4 a = *(const f32x4*)(cw + col_ + 4 * h), b = *(const f32x4*)(cw + DFF + col_ + 4 * h), c = *(const f32x4*)(cw + 2 * DFF + col_ + 4 * h), d = *(const f32x4*)(cb + col_ + 4 * h); \
            _Pragma("unroll") for (int j = 0; j < 4; ++j) { w0[4 * h + j] = a[j]; w1[4 * h + j] = b[j]; w2[4 * h + j] = c[j]; bb[4 * h + j] = d[j]; } } } while (0)
#define EU_STEP2(B) do { EU_LOAD(gb, (B) + 1); asm volatile("" ::: "memory"); EU_COMP(ga, B); EU_LOAD(ga, (B) + 2); asm volatile("" ::: "memory"); EU_COMP(gb, (B) + 1); } while (0)
        float w0[8], w1[8], w2[8], bb[8];
        EU_LOAD(ga, 0); EU_PARAMS(0);
        EU_STEP2(0); EU_STEP2(2); EU_STEP2(4);
        EU_LOAD(gb, 7); asm volatile("" ::: "memory"); EU_COMP(ga, 6); EU_LOAD(ga, 8); asm volatile("" ::: "memory"); EU_COMP(gb, 7);
        EU_PARAMS(1);
        EU_STEP2(8); EU_STEP2(10); EU_STEP2(12);
        EU_LOAD(gb, 15); asm volatile("" ::: "memory"); EU_COMP(ga, 14); EU_COMP(gb, 15);
#undef EU_LOAD
#undef EU_COMP
#undef EU_PARAMS
#undef EU_STEP2
    }
};
template <int CTRL> __device__ __forceinline__ float dpp_upd(float old, float src) { return __int_as_float(__builtin_amdgcn_update_dpp(__float_as_int(old), __float_as_int(src), CTRL, 0xF, 0xF, false)); }
template <int CTRL> __device__ __forceinline__ float dpp_rot(float src) { return __int_as_float(__builtin_amdgcn_mov_dpp(__float_as_int(src), CTRL, 0xF, 0xF, true)); }
struct EpiFfn {
    static constexpr bool PERM = true; static constexpr bool PERMA = true;
    static constexpr int NPRE = 1;
    __device__ __forceinline__ void prefetch(LAS unsigned char* lds, const Unit& u, int wid, int lane) const { const int a = wid >> 1; const float* src = (a < 3 ? cw + (size_t)a * DFF : cb) + u.pn * HALF + (wid & 1) * 64 + lane;
        __builtin_amdgcn_global_load_lds((const unsigned*)src, (LAS unsigned*)(lds + PAR_OFF + wid * 256), 4, 0, 0); }
    bf16_t* HID; const float* cw; const float* cb; float* convp; float* gbnd; float* defc; float* defu; LAS float* scr;
    __device__ __forceinline__ void operator()(const Acc& acc, const Unit& u, int wr, int wc, int fr, int fq) const {
        const int ch0 = u.pn * HALF + wc * 32 + 8 * fq;
#pragma unroll
        for (int ai = 0; ai < 2; ++ai) { const int k = ai * 2 + wr;
            if (fr == 15) {
#pragma unroll
                for (int rr = 0; rr < 2; ++rr) {
                    if (k < 3) { LAS float* p = scr + ((((k * 4 + wc) * 4 + fq) * 2 + rr) * 8); *(LAS f32x4*)p = acc[ai][0][2 + rr][0]; *(LAS f32x4*)(p + 4) = acc[ai][0][2 + rr][1]; }
                    else { float* p = gbnd + (size_t)(u.pm * 2 + rr) * DFF + ch0; *(f32x4*)p = acc[ai][0][2 + rr][0]; *(f32x4*)(p + 4) = acc[ai][0][2 + rr][1];
                        if ((u.pm & 31) == 31) { float* cp = convp + (size_t)((u.pm >> 5) * 2 + rr) * DFF + ch0; *(f32x4*)cp = acc[ai][0][2 + rr][0]; *(f32x4*)(cp + 4) = acc[ai][0][2 + rr][1]; } } } } }
        float w0[8], w1[8], w2[8], bb[8];
        { const LAS float* par = (const LAS float*)((LAS unsigned char*)scr + 4096) + wc * 32 + 8 * fq;
#pragma unroll
        for (int h = 0; h < 2; ++h) { const f32x4 a = *(const LAS f32x4*)(par + 4 * h), b = *(const LAS f32x4*)(par + 128 + 4 * h), c = *(const LAS f32x4*)(par + 256 + 4 * h), d = *(const LAS f32x4*)(par + 384 + 4 * h);
#pragma unroll
            for (int j = 0; j < 4; ++j) { w0[4 * h + j] = -1.4426950408889634f * a[j]; w1[4 * h + j] = -1.4426950408889634f * b[j]; w2[4 * h + j] = -1.4426950408889634f * c[j]; bb[4 * h + j] = -1.4426950408889634f * d[j]; } } }
        asm volatile("s_waitcnt lgkmcnt(0)\n\ts_barrier" ::: "memory");
#pragma unroll
        for (int ai = 0; ai < 2; ++ai) { const int k = ai * 2 + wr;
            float bm1[8], bm2[8];
            if (k >= 1) { const LAS float* p = scr + ((((k - 1) * 4 + wc) * 4 + fq) * 2) * 8; const f32x4 a = *(const LAS f32x4*)p, b = *(const LAS f32x4*)(p + 4), c = *(const LAS f32x4*)(p + 8), d = *(const LAS f32x4*)(p + 12);
#pragma unroll
                for (int j = 0; j < 4; ++j) { bm2[j] = a[j]; bm2[4 + j] = b[j]; bm1[j] = c[j]; bm1[4 + j] = d[j]; } }
            else {
#pragma unroll
                for (int e = 0; e < 8; ++e) { bm1[e] = 0.f; bm2[e] = 0.f; } }
            float s3[8], s2[8];
#pragma unroll
            for (int n = 0; n < 2; ++n)
#pragma unroll
                for (int j = 0; j < 4; ++j) { const int e = 4 * n + j; s3[e] = dpp_upd<0x111>(bm1[e], acc[ai][0][3][n][j]); s2[e] = dpp_upd<0x111>(bm2[e], acc[ai][0][2][n][j]); }
#pragma unroll
            for (int m = 0; m < 4; ++m) { const int row = u.pm * BM + ai * HALF + wr * 64 + 4 * fr + m;
                float cc[8], o[8];
#pragma unroll
                for (int n = 0; n < 2; ++n)
#pragma unroll
                    for (int j = 0; j < 4; ++j) { const int e = 4 * n + j; const float g = acc[ai][0][m][n][j];
                        const float g1 = m == 0 ? s3[e] : acc[ai][0][m > 0 ? m - 1 : 0][n][j], g2 = m == 0 ? s2[e] : (m == 1 ? s3[e] : acc[ai][0][m > 1 ? m - 2 : 0][n][j]);
                        const float c = bb[e] + w0[e] * g2 + w1[e] * g1 + w2[e] * g; cc[e] = c; o[e] = c * __builtin_amdgcn_rcpf(1.0f + __builtin_amdgcn_exp2f(c)) * acc[ai][1][m][n][j]; }
                u32x4 w_; w_.x = cvt_pk_bf16(o[0], o[1]); w_.y = cvt_pk_bf16(o[2], o[3]); w_.z = cvt_pk_bf16(o[4], o[5]); w_.w = cvt_pk_bf16(o[6], o[7]);
                *(u32x4*)(HID + tiled_off(row, ch0, DFF / 64)) = w_;
                if (m < 2 && k == 0 && fr == 0) { float* pc = defc + (size_t)(u.pm * 2 + m) * DFF + ch0; float* pu = defu + (size_t)(u.pm * 2 + m) * DFF + ch0;
                    *(f32x4*)pc = (f32x4){cc[0], cc[1], cc[2], cc[3]}; *(f32x4*)(pc + 4) = (f32x4){cc[4], cc[5], cc[6], cc[7]}; *(f32x4*)pu = acc[ai][1][m][0]; *(f32x4*)(pu + 4) = acc[ai][1][m][1]; } }
        }
    }
};
struct EpiPartial {
    static constexpr int NPRE = 0; static constexpr bool PERMA = false;
    static constexpr bool PERM = false;
    float* P; int ldc;
    __device__ __forceinline__ void operator()(const Acc& acc, const Unit& u, int wr, int wc, int fr, int fq) const {
        const int row0 = (u.pm - 128) * BM + wr * 64 + fr, col0 = u.pn * BM + wc * 32 + 4 * fq;
        float* base = P + ((size_t)u.ks * 512 + row0) * ldc + col0;
#pragma unroll
        for (int ai = 0; ai < 2; ++ai)
#pragma unroll
            for (int m = 0; m < 4; ++m) { float* rowp = base + (size_t)(ai * HALF + m * 16) * ldc;
#pragma unroll
                for (int bj = 0; bj < 2; ++bj)
#pragma unroll
                    for (int n = 0; n < 2; ++n) *(f32x4*)(rowp + bj * HALF + n * 16) = acc[ai][bj][m][n]; }
    }
};
struct EpiXloc {
    static constexpr int NPRE = 0; static constexpr bool PERMA = false;
    static constexpr bool PERM = true;
    bf16_t* X;
    __device__ __forceinline__ void operator()(const Acc& acc, const Unit& u, int wr, int wc, int fr, int fq) const {
        const int row0 = u.pm * BM + wr * 64 + fr, col0 = wc * 32 + 8 * fq;
#pragma unroll
        for (int ai = 0; ai < 2; ++ai)
#pragma unroll
            for (int m = 0; m < 4; ++m) *(u32x4*)(X + (size_t)(row0 + ai * HALF + m * 16) * 128 + col0) = pack8(acc[ai][0][m][0], acc[ai][0][m][1]);
    }
};
struct EpiY {
    static constexpr int NPRE = 0; static constexpr bool PERMA = false;
    static constexpr bool PERM = true;
    const bf16_t* UP; bf16_t* Z; const float* Dv;
    __device__ __forceinline__ void operator()(const Acc& acc, const Unit& u, int wr, int wc, int fr, int fq) const {
        const int g = u.pn, cbase = (u.pm - 9 * g) * BM;
        const int q0 = (8 * fq) & 15;
        const f32x4 d0 = *(const f32x4*)(Dv + 16 * g + q0), d1 = *(const f32x4*)(Dv + 16 * g + q0 + 4);
#pragma unroll
        for (int ai = 0; ai < 2; ++ai) {
            const int c0 = cbase + ai * HALF + wr * 64 + fr;
            u32x4 uq[4][2];
#pragma unroll
            for (int m = 0; m < 4; ++m) { const int c = c0 + m * 16 < 2080 ? c0 + m * 16 : 2079;
#pragma unroll
                for (int bj = 0; bj < 2; ++bj) uq[m][bj] = *(const u32x4*)(UP + ((size_t)g * NSUB + c) * 384 + bj * HALF + wc * 32 + 8 * fq); }
#pragma unroll
            for (int m = 0; m < 4; ++m) { const int c = c0 + m * 16;
                if (c < 2080) {
#pragma unroll
                    for (int bj = 0; bj < 2; ++bj) { const int cc = bj * HALF + wc * 32 + 8 * fq; const int t = cc >> 4;
                        const u32x4 uu = uq[m][bj];
                        const f32x4 a0 = acc[ai][bj][m][0], a1 = acc[ai][bj][m][1];
                        float y[8];
                        y[0] = a0[0] + d0[0] * bf_lo(uu[0]); y[1] = a0[1] + d0[1] * bf_hi(uu[0]); y[2] = a0[2] + d0[2] * bf_lo(uu[1]); y[3] = a0[3] + d0[3] * bf_hi(uu[1]);
                        y[4] = a1[0] + d1[0] * bf_lo(uu[2]); y[5] = a1[1] + d1[1] * bf_hi(uu[2]); y[6] = a1[2] + d1[2] * bf_lo(uu[3]); y[7] = a1[3] + d1[3] * bf_hi(uu[3]);
#pragma unroll
                        for (int j = 0; j < 8; ++j) { const float v = y[j]; const float w2 = v * (-2.3022081983f + -0.1029432395f * (v * v)); y[j] = v * __builtin_amdgcn_rcpf(1.0f + __builtin_amdgcn_exp2f(w2)); }
                        u32x4 w; w.x = cvt_pk_bf16(y[0], y[1]); w.y = cvt_pk_bf16(y[2], y[3]); w.z = cvt_pk_bf16(y[4], y[5]); w.w = cvt_pk_bf16(y[6], y[7]);
                        *(u32x4*)(Z + (size_t)(16 * c + t) * DM + 16 * g + q0) = w; }
                } }
            asm volatile("" ::: "memory");
        }
    }
};
}

namespace att {
constexpr int SHM_V = 64 * 128 * 2, SHM_K = 64 * 384, OFF_V = 0, OFF_K = 3 * SHM_V, OFF_SCR = OFF_K + 3 * SHM_K, ATT_LDS = OFF_SCR + 8 * 256;
static_assert(ATT_LDS <= 131072, "attention LDS");
constexpr float THR2 = 11.54f;
#define SBAR() __builtin_amdgcn_sched_barrier(0)
__device__ __forceinline__ int crow(int r, int hi) { return (r & 3) + 8 * (r >> 2) + 4 * hi; }
__device__ __forceinline__ int kswz(int row, int c16) { return row * 384 + ((c16 ^ ((row >> 1) & 7)) << 4); }
template <bool FX> __device__ __forceinline__ void partialSM(f32x16& p0, f32x16& p1, float& m_reg, float& mn, float& alpha, bool vis) {
  if (!vis) {
#pragma unroll
    for (int r = 0; r < 16; ++r) { p0[r] = -__builtin_inff(); p1[r] = -__builtin_inff(); } }
  if constexpr (FX) { mn = 0.f; alpha = 1.f;
#pragma unroll
    for (int r = 0; r < 16; ++r) p0[r] = __builtin_amdgcn_exp2f(p0[r]);
    return; }
  float pmax = p0[0];
#pragma unroll
  for (int r = 1; r < 16; ++r) pmax = fmaxf(pmax, p0[r]);
#pragma unroll
  for (int r = 0; r < 16; ++r) pmax = fmaxf(pmax, p1[r]);
  { auto rr = __builtin_amdgcn_permlane32_swap(__float_as_uint(pmax), __float_as_uint(pmax), false, false);
    pmax = fmaxf(__uint_as_float(rr[0]), __uint_as_float(rr[1])); }
  if (__builtin_expect(__all(pmax - m_reg <= THR2), 1)) { mn = m_reg; alpha = 1.f; }
  else { mn = fmaxf(m_reg, pmax); alpha = __builtin_amdgcn_exp2f(m_reg - mn); m_reg = mn; }
#pragma unroll
  for (int r = 0; r < 16; ++r) p0[r] = __builtin_amdgcn_exp2f(p0[r] - mn);
#pragma unroll
  for (int r = 0; r < 16; ++r) p1[r] = p1[r] - mn;
}
__device__ __forceinline__ void finishSM(f32x16& p0, f32x16& p1, float alpha, float& l_reg, bf16x8& pa0, bf16x8& pa1, bf16x8& pa2, bf16x8& pa3) {
#pragma unroll
  for (int r = 0; r < 16; ++r) p1[r] = __builtin_amdgcn_exp2f(p1[r]);
  float ps = 0;
#pragma unroll
  for (int r = 0; r < 16; ++r) ps += p0[r];
#pragma unroll
  for (int r = 0; r < 16; ++r) ps += p1[r];
  { auto rr = __builtin_amdgcn_permlane32_swap(__float_as_uint(ps), __float_as_uint(ps), false, false);
    ps = __uint_as_float(rr[0]) + __uint_as_float(rr[1]); }
  l_reg = l_reg * alpha + ps;
#define PK4(P, BASE, OUT) do { unsigned a0 = cvt_pk_bf16(P[BASE + 0], P[BASE + 1]), a1 = cvt_pk_bf16(P[BASE + 2], P[BASE + 3]);   \
    unsigned b0 = cvt_pk_bf16(P[BASE + 4], P[BASE + 5]), b1 = cvt_pk_bf16(P[BASE + 6], P[BASE + 7]);                              \
    auto r0 = __builtin_amdgcn_permlane32_swap(a0, b0, false, false); auto r1 = __builtin_amdgcn_permlane32_swap(a1, b1, false, false); \
    u32x4 w = {r0[0], r1[0], r0[1], r1[1]}; OUT = *reinterpret_cast<bf16x8*>(&w); } while (0)
  PK4(p0, 0, pa0); PK4(p0, 8, pa1); PK4(p1, 0, pa2); PK4(p1, 8, pa3);
#undef PK4
}
__device__ __forceinline__ void qkt(f32x16& p0, f32x16& p1, const bf16x8* qr, const int* kb, int so) {
  p0 = f32x16{}; p1 = f32x16{};
  const int k0 = kb[0] + so, k1 = kb[1] + so, k2 = kb[2] + so, k3 = kb[3] + so;
  bf16x8 fa[4], fb[4];
#define KADDR(d0) (((d0) & 3) == 0 ? k0 : ((d0) & 3) == 1 ? k1 : ((d0) & 3) == 2 ? k2 : k3)
#define LOADK(F, d0) do { F[0] = *(const LAS bf16x8*)(uintptr_t)(unsigned)(KADDR(d0) + ((d0) >> 2) * 128); F[1] = *(const LAS bf16x8*)(uintptr_t)(unsigned)(KADDR(d0) + ((d0) >> 2) * 128 + 32 * 384); \
    F[2] = *(const LAS bf16x8*)(uintptr_t)(unsigned)(KADDR((d0) + 1) + (((d0) + 1) >> 2) * 128); F[3] = *(const LAS bf16x8*)(uintptr_t)(unsigned)(KADDR((d0) + 1) + (((d0) + 1) >> 2) * 128 + 32 * 384); } while (0)
#define MMAK(F, d0) do { p0 = __builtin_amdgcn_mfma_f32_32x32x16_bf16(F[0], qr[d0], p0, 0, 0, 0); p1 = __builtin_amdgcn_mfma_f32_32x32x16_bf16(F[1], qr[d0], p1, 0, 0, 0); \
    p0 = __builtin_amdgcn_mfma_f32_32x32x16_bf16(F[2], qr[(d0) + 1], p0, 0, 0, 0); p1 = __builtin_amdgcn_mfma_f32_32x32x16_bf16(F[3], qr[(d0) + 1], p1, 0, 0, 0); } while (0)
  LOADK(fa, 0); SBAR(); LOADK(fb, 2); SBAR();
  MMAK(fa, 0); SBAR(); LOADK(fa, 4); SBAR();
  MMAK(fb, 2); SBAR(); LOADK(fb, 6); SBAR();
  MMAK(fa, 4); SBAR(); LOADK(fa, 8); SBAR();
  MMAK(fb, 6); SBAR(); LOADK(fb, 10); SBAR();
  MMAK(fa, 8); SBAR();
  MMAK(fb, 10); SBAR();
#undef KADDR
#undef LOADK
#undef MMAK
}
__device__ __forceinline__ int v_st(int k, int c) { const int kk = (k & ~0xC) | ((k & 4) << 1) | ((k & 8) >> 1); return ((kk >> 3) * 4 + (c >> 5)) * 512 + ((kk & 7) * 32 + (c & 31)) * 2; }
__device__ __forceinline__ int v_rd_base(int lane) { return ((lane & 3) << 3) | (((lane >> 2) & 3) << 6) | (((lane >> 4) & 1) << 5) | (((lane >> 5) & 1) << 8); }
constexpr int v_rd_off(int d0, int ks, int half) { return d0 * 512 + ks * 4096 + half * 2048; }
typedef short v4i16_t __attribute__((ext_vector_type(4)));
template <int OFF> __device__ __forceinline__ s16x4 tr_read(int vb) {
  return __builtin_bit_cast(s16x4, __builtin_amdgcn_ds_read_tr16_b64_v4i16((LAS v4i16_t*)(uintptr_t)(unsigned)(vb + OFF)));
}
template <int D0> __device__ __forceinline__ void pv_load(s16x4* f, int vb) {
  f[0] = tr_read<v_rd_off(D0, 0, 0)>(vb); f[1] = tr_read<v_rd_off(D0, 0, 1)>(vb); f[2] = tr_read<v_rd_off(D0, 1, 0)>(vb); f[3] = tr_read<v_rd_off(D0, 1, 1)>(vb);
  f[4] = tr_read<v_rd_off(D0, 2, 0)>(vb); f[5] = tr_read<v_rd_off(D0, 2, 1)>(vb); f[6] = tr_read<v_rd_off(D0, 3, 0)>(vb); f[7] = tr_read<v_rd_off(D0, 3, 1)>(vb);
}
__device__ __forceinline__ void pv_mma(f32x16& od, const s16x4* f, bf16x8 pa0, bf16x8 pa1, bf16x8 pa2, bf16x8 pa3) {
#define PK(L, H) (bf16x8){L[0], L[1], L[2], L[3], H[0], H[1], H[2], H[3]}
  od = __builtin_amdgcn_mfma_f32_32x32x16_bf16(pa0, PK(f[0], f[1]), od, 0, 0, 0);
  od = __builtin_amdgcn_mfma_f32_32x32x16_bf16(pa1, PK(f[2], f[3]), od, 0, 0, 0);
  od = __builtin_amdgcn_mfma_f32_32x32x16_bf16(pa2, PK(f[4], f[5]), od, 0, 0, 0);
  od = __builtin_amdgcn_mfma_f32_32x32x16_bf16(pa3, PK(f[6], f[7]), od, 0, 0, 0);
#undef PK
}
__device__ __forceinline__ void pv_d0(f32x16* o, int vb, bf16x8 pa0, bf16x8 pa1, bf16x8 pa2, bf16x8 pa3) {
  s16x4 va[8], vbf[8];
  pv_load<0>(va, vb); SBAR(); pv_load<1>(vbf, vb); SBAR();
  pv_mma(o[0], va, pa0, pa1, pa2, pa3); SBAR(); pv_load<2>(va, vb); SBAR();
  pv_mma(o[1], vbf, pa0, pa1, pa2, pa3); SBAR(); pv_load<3>(vbf, vb); SBAR();
  pv_mma(o[2], va, pa0, pa1, pa2, pa3); SBAR();
  pv_mma(o[3], vbf, pa0, pa1, pa2, pa3); SBAR();
}
__device__ __forceinline__ int k_src(int s) { const int row = s / 24, cp = s - row * 24, c = cp ^ ((row >> 1) & 7); return row * 5120 + c * 8; }
__device__ __forceinline__ int v_src(int s) { const int sub = s >> 5, w = s & 31, kk = (sub >> 2) * 8 + (w >> 2), c = (sub & 3) * 32 + (w & 3) * 8; const int k = (kk & ~0xC) | ((kk & 4) << 1) | ((kk & 8) >> 1); return k * 5120 + c; }
template <bool FX> __device__ __forceinline__ void attn_unit(const bf16_t* __restrict__ Qb, const bf16_t* __restrict__ Kh, const bf16_t* __restrict__ Vh, bf16_t* __restrict__ Ob,
                                          int NT, int NTreal, int nvis, int wq, int rev, LAS char* lds, const int tid, const float* __restrict__ gqn, const float* __restrict__ rope, int pos0) {
  int lane_ = tid & 63; asm volatile("" : "+v"(lane_));
  const int wid = __builtin_amdgcn_readfirstlane(tid >> 6), lane = lane_, r32 = lane & 31, hi = lane >> 5, grp = wid >> 2;
  LAS char* V_lds = lds + OFF_V; LAS char* K_lds = lds + OFF_K;
  LAS float* ws = (LAS float*)(lds + OFF_SCR) + wid * 64; LAS float* li_l = ws; LAS float* al_l = ws + 32;
  float m_reg = -1e30f, l_reg = 0; f32x16 o[4] = {}; bf16x8 qr[12];
  const bf16_t* Qw = Qb + (size_t)(wq * 32 + r32) * 3072 + hi * 8;
  {
    u32x4 raw[12];
#pragma unroll
    for (int d0 = 0; d0 < 12; ++d0) raw[d0] = *(const u32x4*)(Qw + d0 * 16);
    float ss = 0.f;
#pragma unroll
    for (int d0 = 0; d0 < 12; ++d0)
#pragma unroll
      for (int e = 0; e < 4; ++e) { const float a = bf_lo(raw[d0][e]), b = bf_hi(raw[d0][e]); ss += a * a + b * b; }
    { auto rr = __builtin_amdgcn_permlane32_swap(__float_as_uint(ss), __float_as_uint(ss), false, false); ss = __uint_as_float(rr[0]) + __uint_as_float(rr[1]); }
    const float rq = (1.0f / sqrtf(ss * (1.0f / 192.0f) + EPS)) * (0.07216878364870323f * 1.4426950408889634f);
#pragma unroll
    for (int d0 = 0; d0 < 8; ++d0) { const f32x4 g0 = *(const f32x4*)(gqn + d0 * 16 + hi * 8), g1 = *(const f32x4*)(gqn + d0 * 16 + hi * 8 + 4); u32x4 w;
      w.x = cvt_pk_bf16(bf_lo(raw[d0][0]) * rq * g0[0], bf_hi(raw[d0][0]) * rq * g0[1]); w.y = cvt_pk_bf16(bf_lo(raw[d0][1]) * rq * g0[2], bf_hi(raw[d0][1]) * rq * g0[3]);
      w.z = cvt_pk_bf16(bf_lo(raw[d0][2]) * rq * g1[0], bf_hi(raw[d0][2]) * rq * g1[1]); w.w = cvt_pk_bf16(bf_lo(raw[d0][3]) * rq * g1[2], bf_hi(raw[d0][3]) * rq * g1[3]);
      qr[d0] = *reinterpret_cast<bf16x8*>(&w); }
    const float* rt = rope + (size_t)(pos0 + wq * 32 + r32) * 64;
#pragma unroll
    for (int dd = 0; dd < 2; ++dd) {
      u32x4 w1, w2;
#pragma unroll
      for (int e2 = 0; e2 < 4; ++e2) { const int j = 16 * dd + 8 * hi + 2 * e2;
        const f32x4 cs = *(const f32x4*)(rt + 2 * j);
        const f32x2 ga = *(const f32x2*)(gqn + 128 + j), gb = *(const f32x2*)(gqn + 160 + j);
        const float x10 = bf_lo(raw[8 + dd][e2]) * rq * ga.x, x11 = bf_hi(raw[8 + dd][e2]) * rq * ga.y, x20 = bf_lo(raw[10 + dd][e2]) * rq * gb.x, x21 = bf_hi(raw[10 + dd][e2]) * rq * gb.y;
        w1[e2] = cvt_pk_bf16(x10 * cs[0] - x20 * cs[1], x11 * cs[2] - x21 * cs[3]);
        w2[e2] = cvt_pk_bf16(x10 * cs[1] + x20 * cs[0], x11 * cs[3] + x21 * cs[2]); }
      qr[8 + dd] = *reinterpret_cast<bf16x8*>(&w1); qr[10 + dd] = *reinterpret_cast<bf16x8*>(&w2); }
  }
  int kb[4];
#pragma unroll
  for (int v = 0; v < 4; ++v) kb[v] = (int)(uintptr_t)K_lds + r32 * 384 + ((((2 * v) | hi) ^ ((r32 >> 1) & 7)) << 4);
  unsigned kg[3], vg[2];
#pragma unroll
  for (int i = 0; i < 3; ++i) kg[i] = (unsigned)k_src((wid * 3 + i) * 64 + lane) * 2u;
#pragma unroll
  for (int i = 0; i < 2; ++i) vg[i] = (unsigned)v_src((wid * 2 + i) * 64 + lane) * 2u;
  const int vb0 = (int)(uintptr_t)V_lds + v_rd_base(lane);
#define DMA(jt, st) do { const int _p = rev ? NT - 1 - (jt) : (jt); const int _t = _p < NTreal ? _p : NTreal - 1; const char* _k = (const char*)(Kh + (size_t)_t * 64 * 5120); const char* _v = (const char*)(Vh + (size_t)_t * 64 * 5120); \
    _Pragma("unroll") for (int _i = 0; _i < 3; ++_i) __builtin_amdgcn_global_load_lds((const unsigned*)(_k + kg[_i]), (LAS unsigned*)(K_lds + (st) * SHM_K + (wid * 3 + _i) * 1024), 16, 0, 0); \
    _Pragma("unroll") for (int _i = 0; _i < 2; ++_i) __builtin_amdgcn_global_load_lds((const unsigned*)(_v + vg[_i]), (LAS unsigned*)(V_lds + (st) * SHM_V + (wid * 2 + _i) * 1024), 16, 0, 0); } while (0)
#define WAITBAR(N) asm volatile("s_waitcnt vmcnt(" #N ")\n\ts_barrier" ::: "memory")
#define RESC(a) do { if constexpr (!FX) if (__any((a) < 1.f)) { if (hi == 0) al_l[r32] = (a); asm volatile("s_waitcnt lgkmcnt(0)" ::: "memory"); \
    _Pragma("unroll") for (int d = 0; d < 4; ++d) _Pragma("unroll") for (int r = 0; r < 16; ++r) o[d][r] *= al_l[crow(r, hi)]; } } while (0)
#define VIS(j) ((rev ? NT - 1 - (j) : (j)) < nvis)
  if (grp) __builtin_amdgcn_s_setprio(1);
  f32x16 pA0, pA1, pB0, pB1; float mnA, mnB, alA, alB; bf16x8 pa0, pa1, pa2, pa3;
  int sp = 0, sc = 1, sn = 2;
  DMA(0, 0); DMA(1, 1);
  WAITBAR(5);
  if (VIS(0)) qkt(pA0, pA1, qr, kb, 0);
  partialSM<FX>(pA0, pA1, m_reg, mnA, alA, VIS(0));
  for (int j = 1; j + 1 < NT; j += 2) {
    WAITBAR(0);
    DMA(j + 1, sn);
    SBAR(); if (VIS(j)) qkt(pB0, pB1, qr, kb, sc * SHM_K);
    finishSM(pA0, pA1, alA, l_reg, pa0, pa1, pa2, pa3); SBAR();
    if (VIS(j - 1)) pv_d0(o, vb0 + sp * SHM_V, pa0, pa1, pa2, pa3);
    partialSM<FX>(pB0, pB1, m_reg, mnB, alB, VIS(j));
    RESC(alB);
    { const int t = sp; sp = sc; sc = sn; sn = t; }
    WAITBAR(0);
    DMA(j + 2, sn);
    SBAR(); if (VIS(j + 1)) qkt(pA0, pA1, qr, kb, sc * SHM_K);
    finishSM(pB0, pB1, alB, l_reg, pa0, pa1, pa2, pa3); SBAR();
    if (VIS(j)) pv_d0(o, vb0 + sp * SHM_V, pa0, pa1, pa2, pa3);
    partialSM<FX>(pA0, pA1, m_reg, mnA, alA, VIS(j + 1));
    RESC(alA);
    { const int t = sp; sp = sc; sc = sn; sn = t; }
  }
  WAITBAR(0);
  SBAR(); if (VIS(NT - 1)) qkt(pB0, pB1, qr, kb, sc * SHM_K);
  finishSM(pA0, pA1, alA, l_reg, pa0, pa1, pa2, pa3); SBAR();
  if (VIS(NT - 2)) pv_d0(o, vb0 + sp * SHM_V, pa0, pa1, pa2, pa3);
  partialSM<FX>(pB0, pB1, m_reg, mnB, alB, VIS(NT - 1));
  RESC(alB);
  finishSM(pB0, pB1, alB, l_reg, pa0, pa1, pa2, pa3); SBAR();
  if (VIS(NT - 1)) pv_d0(o, vb0 + sc * SHM_V, pa0, pa1, pa2, pa3);
  if (nvis > 0) {
    if (hi == 0) li_l[r32] = l_reg; asm volatile("s_waitcnt lgkmcnt(0)" ::: "memory");
    bf16_t* Ow = Ob + (size_t)(wq * 32) * 2048;
    const bool odd = (lane & 1) != 0;
#pragma unroll
    for (int r = 0; r < 16; r += 2) {
      const float ra = __builtin_amdgcn_rcpf(li_l[crow(r, hi)]), rb = __builtin_amdgcn_rcpf(li_l[crow(r + 1, hi)]);
      const int orow = odd ? crow(r + 1, hi) : crow(r, hi);
#pragma unroll
      for (int d0 = 0; d0 < 4; ++d0) {
        const float e = o[d0][r] * ra, f = o[d0][r + 1] * rb;
        const float keep = odd ? f : e, send = odd ? e : f;
        const float got = __int_as_float(__builtin_amdgcn_mov_dpp(__float_as_int(send), 0xB1, 0xF, 0xF, true));
        const unsigned w = odd ? cvt_pk_bf16(got, keep) : cvt_pk_bf16(keep, got);
        *(unsigned*)(Ow + (size_t)orow * 2048 + d0 * 32 + (r32 & ~1)) = w; } }
  }
  __builtin_amdgcn_s_setprio(0);
  asm volatile("s_waitcnt lgkmcnt(0)\n\ts_barrier" ::: "memory");
#undef DMA
#undef VIS
#undef WAITBAR
#undef RESC
}
}

#define XB_TMO      128
#define XB_XCNT(j)  (256  + 64 * (j))
#define XB_XSUB(j)  (1280 + 64 * (j))
#define XB_XGEN(j)  (2304 + 64 * (j))
#define XB_TOP      3328
#define XB_TOPGEN   3392
#define XCD_BAR_WORDS 3456
#define XB_SPIN_CAP (1u << 18)
__device__ __forceinline__ unsigned xb_ld(unsigned* p)              { return __hip_atomic_load(p, __ATOMIC_RELAXED, __HIP_MEMORY_SCOPE_AGENT); }
__device__ __forceinline__ unsigned xb_add(unsigned* p, unsigned v) { return __hip_atomic_fetch_add(p, v, __ATOMIC_RELAXED, __HIP_MEMORY_SCOPE_AGENT); }
__device__ __forceinline__ unsigned xb_xcc_id() { return (unsigned)__builtin_amdgcn_s_getreg((3 << 11) | 20) & 0xFu; }
#define XB_SPIN(cond, bar) do { unsigned _sp = 0; while (cond) { __builtin_amdgcn_s_sleep(1); \
    if ((++_sp & 255u) == 0u) { if (xb_ld(&(bar)[XB_TMO])) break; if (_sp > XB_SPIN_CAP) { atomicAdd(&(bar)[XB_TMO], 1u); break; } } } } while (0)
struct XcdBarrier { unsigned* bar; unsigned x; volatile LAS unsigned* st; };
__device__ __forceinline__ XcdBarrier xcd_barrier_post(unsigned* bar, volatile LAS unsigned* st) {
    XcdBarrier b; b.bar = bar; b.x = xb_xcc_id(); b.st = st;
    if (threadIdx.x == 0) (void)xb_add(&bar[XB_XCNT(b.x)], 1u);
    return b;
}
__device__ __forceinline__ void xcd_barrier_complete(unsigned* bar, unsigned x, unsigned& nloc, unsigned& nx) {
    const unsigned G = gridDim.x * gridDim.y * gridDim.z;
    unsigned sum, cnt, mine, sp = 0u;
    for (;;) {
        sum = 0u; cnt = 0u; mine = 0u;
#pragma unroll
        for (unsigned j = 0; j < 16; ++j) { const unsigned c = xb_ld(&bar[XB_XCNT(j)]); sum += c; cnt += (c > 0u) ? 1u : 0u; mine = (j == x) ? c : mine; }
        if (sum == G) break;
        __builtin_amdgcn_s_sleep(1);
        if ((++sp & 255u) == 0u) { if (xb_ld(&bar[XB_TMO])) break; if (sp > XB_SPIN_CAP) { atomicAdd(&bar[XB_TMO], 1u); break; } }
    }
    nloc = mine > 0u ? mine : 1u; nx = cnt > 0u ? cnt : 1u;
}
__device__ __forceinline__ void xcd_barrier(const XcdBarrier& b, const int tid) {
    asm volatile("s_waitcnt vmcnt(0)" ::: "memory");
    __syncthreads();
    if (tid == 0) {
        unsigned* bar = b.bar; asm volatile("" : "+s"(bar));
        __builtin_amdgcn_s_waitcnt(0);
        unsigned nloc = b.st[0], nx = b.st[1];
        if (nloc == 0u) { xcd_barrier_complete(bar, b.x, nloc, nx); b.st[0] = nloc; b.st[1] = nx; }
        const unsigned old = xb_add(&bar[XB_XSUB(b.x)], 1u);
        const unsigned gen = old / nloc;
        if (old + 1u == (gen + 1u) * nloc) {
            __builtin_amdgcn_fence(__ATOMIC_RELEASE, "agent");
            asm volatile("s_waitcnt vmcnt(0)" ::: "memory");
            const unsigned og = xb_add(&bar[XB_TOP], 1u);
            const unsigned tg = og / nx;
            if (og + 1u == (tg + 1u) * nx) xb_add(&bar[XB_TOPGEN], 1u);
            else XB_SPIN(xb_ld(&bar[XB_TOPGEN]) == tg, bar);
            __builtin_amdgcn_fence(__ATOMIC_ACQUIRE, "agent");
            xb_add(&bar[XB_XGEN(b.x)], 1u);
            asm volatile("s_waitcnt vmcnt(0)" ::: "memory");
        } else {
            XB_SPIN(xb_ld(&bar[XB_XGEN(b.x)]) == gen, bar);
            __builtin_amdgcn_fence(__ATOMIC_ACQUIRE, "agent");
            asm volatile("s_waitcnt vmcnt(0)" ::: "memory");
        }
    }
    __syncthreads();
}

struct Args { const float* in[37]; float* out; unsigned char* ws; int ph_lo, ph_hi; };
enum { I_XP = 0, I_XS, I_CCKV, I_CKR, I_SRE, I_SIM, I_CCONV, I_CP, I_CS, I_WMOD, I_BMOD, I_GMIX, I_GFFN, I_WDQ, I_GQA, I_WUQ, I_GQN, I_WDKV, I_GKVA, I_WUKV, I_GKN, I_WO,
       I_ARE, I_AIM, I_LDT, I_BRE, I_BIM, I_CRE, I_CIM, I_SD, I_WGLU, I_WSG, I_FG, I_FU, I_FCW, I_FCB, I_FD };

__device__ const double ROPE_INV[32] = {
 1.0, 0.7498942093324559, 0.5623413251903491, 0.4216965034285822, 0.31622776601683794, 0.23713737056616552, 0.1778279410038923, 0.1333521432163324,
 0.1, 0.07498942093324558, 0.05623413251903491, 0.04216965034285822, 0.03162277660168379, 0.023713737056616554, 0.01778279410038923, 0.01333521432163324,
 0.01, 0.007498942093324558, 0.005623413251903491, 0.004216965034285823, 0.0031622776601683794, 0.0023713737056616554, 0.0017782794100389228, 0.001333521432163324,
 0.001, 0.0007498942093324559, 0.0005623413251903491, 0.0004216965034285823, 0.00031622776601683794, 0.00023713737056616554, 0.00017782794100389227, 0.0001333521432163324 };
__device__ __forceinline__ void sincos_red(double a, float& s, float& c) {
    const double k = __builtin_rint(a * 0.15915494309189535);
    const float r = (float)__builtin_fma(-k, 6.283185307179586, a);
    s = __sinf(r); c = __cosf(r);
}

__device__ __forceinline__ void transpose_item(const float* W, int K, int N, bf16_t* WT, int row_off, int mode, LAS float* scr, int item, int lane, const float sc = 1.0f, const float* ksc = nullptr) {
    const int nblk = N / 32, kb = item / nblk, nb = item - kb * nblk, k0 = 64 * kb, n0 = 32 * nb;
#pragma unroll 8
    for (int i = 0; i < 32; ++i) { const int kk = 2 * i + (lane >> 5); scr[kk * 33 + (lane & 31)] = W[(size_t)(k0 + kk) * N + n0 + (lane & 31)] * (ksc ? ksc[k0 + kk] : 1.0f); }
    LDS_WAIT(); asm volatile("" ::: "memory");
    const int c = lane & 7;
#pragma unroll
    for (int j = 0; j < 4; ++j) { const int n = (lane >> 3) + 8 * j; const LAS float* s = scr + (8 * c) * 33 + n;
        u32x4 o; o.x = cvt_pk_bf16(sc * s[0 * 33], sc * s[1 * 33]); o.y = cvt_pk_bf16(sc * s[2 * 33], sc * s[3 * 33]); o.z = cvt_pk_bf16(sc * s[4 * 33], sc * s[5 * 33]); o.w = cvt_pk_bf16(sc * s[6 * 33], sc * s[7 * 33]);
        const int nn = n0 + n; const int drow = mode == 0 ? row_off + nn : ((nn >> 7) * 256 + (nn & 127) + (mode == 2 ? 128 : 0));
        if (mode == 3) *(u32x4*)(WT + pg8::tiled_off(nn, k0 + 8 * c, K / 64)) = o;
        else *(u32x4*)(WT + (size_t)drow * K + k0 + 8 * c) = o; }
    LDS_WAIT(); asm volatile("" ::: "memory");
}

__global__ void __launch_bounds__(NWAVES * 64, 2) fwd_kernel(Args args) {
    extern __shared__ __attribute__((aligned(16))) unsigned char lds_raw[];
    LAS unsigned char* lds = (LAS unsigned char*)lds_raw;
    volatile LAS unsigned* MISC = (volatile LAS unsigned*)(lds + MISC_OFF);
    const int tid0 = threadIdx.x; const int wave0 = __builtin_amdgcn_readfirstlane(tid0 >> 6);
    const int G = gridDim.x; const int bx = blockIdx.x; const int vcu = (G % 8 == 0) ? (bx % 8) * (G / 8) + bx / 8 : bx;
    const int NGW = G * NWAVES;
    unsigned char* ws0 = args.ws; float* out0 = args.out;
    unsigned* ctl = (unsigned*)(ws0 + WS_CTL);
    for (int u = tid0; u < 64; u += NWAVES * 64) ((LAS unsigned*)(lds + MISC_OFF))[u] = 0u;
    __syncthreads();
    XcdBarrier bar; bar.bar = ctl + 1024; bar.x = 0; bar.st = nullptr;
    if (!MK_PER_PHASE) bar = xcd_barrier_post(ctl + 1024, MISC + 8);
    const int lo = args.ph_lo, hi = args.ph_hi;
    int ph = 0;
#define PH_BEGIN if (lo <= ph && ph < hi) { int tid; asm volatile("v_mbcnt_lo_u32_b32 %0, -1, 0\n\tv_mbcnt_hi_u32_b32 %0, -1, %0" : "=v"(tid)); tid |= wave0 << 6; \
    const int lane = tid & 63, wave = __builtin_amdgcn_readfirstlane(tid >> 6), gw = vcu * NWAVES + wave; (void)lane; (void)gw; \
    __attribute__((address_space(1))) unsigned char* wsg_; __attribute__((address_space(1))) float* outg_; asm volatile("s_mov_b64 %0, %1" : "=s"(wsg_) : "s"(ws0)); asm volatile("s_mov_b64 %0, %1" : "=s"(outg_) : "s"(out0)); unsigned char* ws = (unsigned char*)wsg_; float* out = (float*)outg_; (void)ws; (void)out;
#define PH_END if (ph + 1 < hi) xcd_barrier(bar, tid); } ++ph;

#define MOD ((float*)(ws + WS_MOD))
#define A16 ((float*)(ws + WS_A16))
#define KRSS ((float*)(ws + WS_KRSS))
#define ROPE ((float*)(ws + WS_ROPE))
#define Hb ((bf16_t*)(ws + WS_H))
#define QA ((bf16_t*)((unsigned char*)out + OY_QA))
#define CKV ((bf16_t*)((unsigned char*)out + OY_CKV))
#define Rr ((float*)((unsigned char*)out + OY_R))
#define STATQ ((float*)((unsigned char*)out + OY_STATQ))
#define RSTDQ ((float*)((unsigned char*)out + OY_RSTDQ))
#define XBs ((bf16_t*)(ws + WS_XB))
#define Qb ((bf16_t*)(ws + WS_Q))
#define KB ((bf16_t*)(ws + WS_KB))
#define QKVA ((float*)(ws + WS_QKVA))
#define Gb ((bf16_t*)(ws + WS_G))
#define HID ((bf16_t*)(ws + WS_HID))
#define GBND ((float*)(ws + WS_G))
#define DEFC ((float*)(ws + WS_G + 8 * MiB))
#define DEFU ((float*)(ws + WS_G + 16 * MiB))
#define UP ((bf16_t*)(ws + WS_UP))
#define XLOC ((bf16_t*)(ws + WS_XLOC))
#define PART ((float*)(ws + WS_PART))
#define PGU ((float*)(ws + WS_PGU))

    PH_BEGIN
#ifndef NO_P0
    {
        for (int it = vcu; it < 4 * 64; it += G) {
            const int l = it >> 6, cb = it & 63;
            LAS float* sc = (LAS float*)lds;
            for (int e = tid; e < NSLOT * DM; e += NWAVES * 64) { const int s = e >> 11, k = e & 2047; const float c = s < 4 ? args.in[I_CP][s * DM + k] : args.in[I_CS][(s - 4) * DM + k]; sc[e] = c * fast_sigmoid(c); }
            __syncthreads();
            f32x4 acc[NSLOT];
#pragma unroll
            for (int s = 0; s < NSLOT; ++s) acc[s] = (f32x4){0.f, 0.f, 0.f, 0.f};
            const int lc = lane < 48 ? lane : 47;
            const float* Wp = args.in[I_WMOD] + (size_t)l * DM * 12288 + (size_t)(wave * 256) * 12288 + cb * 192 + 4 * lc;
            for (int k0 = 0; k0 < 256; k0 += 8) {
                f32x4 w[8];
#pragma unroll
                for (int kk = 0; kk < 8; ++kk) w[kk] = *(const f32x4*)(Wp + (size_t)(k0 + kk) * 12288);
#pragma unroll
                for (int s = 0; s < NSLOT; ++s) { const f32x4 c0 = *(const LAS f32x4*)(sc + s * DM + wave * 256 + k0), c1 = *(const LAS f32x4*)(sc + s * DM + wave * 256 + k0 + 4);
#pragma unroll
                    for (int kk = 0; kk < 4; ++kk) { acc[s] += c0[kk] * w[kk]; acc[s] += c1[kk] * w[4 + kk]; } }
            }
            __syncthreads();
            LAS float* red = (LAS float*)lds;
            if (lane < 48) {
#pragma unroll
                for (int s = 0; s < NSLOT; ++s) *(LAS f32x4*)(red + (wave * NSLOT + s) * 192 + 4 * lane) = acc[s]; }
            __syncthreads();
            for (int e = tid; e < NSLOT * 192; e += NWAVES * 64) { const int s = e / 192, c = e - s * 192; float v = args.in[I_BMOD][l * 12288 + cb * 192 + c];
#pragma unroll
                for (int w8 = 0; w8 < 8; ++w8) v += red[(w8 * NSLOT + s) * 192 + c];
                MOD[(size_t)(l * NSLOT + s) * 12288 + cb * 192 + c] = v; }
            __syncthreads();
        }
        for (int e = gw * 64 + lane; e < SEQ * 32; e += NGW * 64) { float s, c; sincos_red((double)(e >> 5) * ROPE_INV[e & 31], s, c); *(f32x2*)(ROPE + 2 * (size_t)e) = (f32x2){c, s}; }
        for (int it = vcu; it < 2 * NGRP; it += G) {
            const int i = it >> 7, g = it & 127;
            LAS float* pwr = (LAS float*)lds;
            LAS float* pwi = pwr + 17 * 64;
            LAS float* bbr = pwi + 17 * 64;
            LAS float* bbi = bbr + 1024;
            LAS float* ccr = bbi + 1024;
            LAS float* cci = ccr + 1024;
            LAS float* kd = cci + 1024;
            const float dt = expf(args.in[I_LDT][i * NGRP + g]);
            if (tid < 64) {
                const int n = tid; const float are = args.in[I_ARE][(i * NGRP + g) * 64 + n], aim = args.in[I_AIM][(i * NGRP + g) * 64 + n];
                const double xr = (double)are * (double)dt, xi = (double)aim * (double)dt;
                for (int d = 0; d <= 16; ++d) { float s, c; sincos_red(xi * d, s, c); const float e = expf((float)(xr * d)); pwr[d * 64 + n] = e * c; pwi[d * 64 + n] = e * s; }
                A16[((i * NGRP + g) * 64 + n) * 2] = pwr[16 * 64 + n]; A16[((i * NGRP + g) * 64 + n) * 2 + 1] = pwi[16 * 64 + n];
                const float nr = pwr[64 + n] - 1.0f, ni = pwi[64 + n]; const float den = 1.0f / (are * are + aim * aim);
                const float fr_ = (nr * are + ni * aim) * den, fi_ = (ni * are - nr * aim) * den;
                for (int p = 0; p < 16; ++p) { const float br = args.in[I_BRE][((size_t)(i * NGRP + g) * 64 + n) * 16 + p], bi = args.in[I_BIM][((size_t)(i * NGRP + g) * 64 + n) * 16 + p];
                    bbr[n * 16 + p] = fr_ * br - fi_ * bi; bbi[n * 16 + p] = fr_ * bi + fi_ * br; }
            } else {
                for (int e = tid - 64; e < 1024; e += NWAVES * 64 - 64) { ccr[e] = args.in[I_CRE][(size_t)(i * NGRP + g) * 1024 + e]; cci[e] = args.in[I_CIM][(size_t)(i * NGRP + g) * 1024 + e]; }
            }
            __syncthreads();
            for (int e = tid; e < 4096; e += NWAVES * 64) { const int d = e >> 8, q = (e >> 4) & 15, p = e & 15; float s = 0.f;
                for (int n = 0; n < 64; ++n) { const float mr = pwr[d * 64 + n] * bbr[n * 16 + p] - pwi[d * 64 + n] * bbi[n * 16 + p], mi = pwr[d * 64 + n] * bbi[n * 16 + p] + pwi[d * 64 + n] * bbr[n * 16 + p];
                    s += ccr[q * 64 + n] * mr - cci[q * 64 + n] * mi; }
                kd[e] = s; }
            __syncthreads();
            bf16_t* BtY = (bf16_t*)(ws + WS_S5 + i * WSZ_S5 + WSZ_GG) + (size_t)g * 256 * 384;
            bf16_t* BtX = (bf16_t*)(ws + WS_S5 + i * WSZ_S5 + WSZ_GG + WSZ_BTY) + (size_t)g * 256 * 256;
            for (int e = tid; e < 256 * 192; e += NWAVES * 64) { const int rr = e / 192, k2 = (e - rr * 192) * 2; const int t = rr >> 4, q = rr & 15; float v[2];
#pragma unroll
                for (int z = 0; z < 2; ++z) { const int k = k2 + z;
                    if (k < 256) { const int s = k >> 4, p = k & 15; v[z] = (s <= t) ? kd[((t - s) * 16 + q) * 16 + p] : 0.f; }
                    else if (k < 320) { const int n = k - 256; v[z] = ccr[q * 64 + n] * pwr[(t + 1) * 64 + n] - cci[q * 64 + n] * pwi[(t + 1) * 64 + n]; }
                    else { const int n = k - 320; v[z] = -(ccr[q * 64 + n] * pwi[(t + 1) * 64 + n] + cci[q * 64 + n] * pwr[(t + 1) * 64 + n]); } }
                *(unsigned*)(BtY + (size_t)rr * 384 + k2) = cvt_pk_bf16(v[0], v[1]); }
            for (int e = tid; e < 256 * 128; e += NWAVES * 64) { const int rr = e >> 7, k2 = (e & 127) * 2; float v[2];
#pragma unroll
                for (int z = 0; z < 2; ++z) { const int k = k2 + z, s = k >> 4, p = k & 15;
                    if (rr < 64) { const int n = rr; v[z] = pwr[(15 - s) * 64 + n] * bbr[n * 16 + p] - pwi[(15 - s) * 64 + n] * bbi[n * 16 + p]; }
                    else if (rr < 128) { const int n = rr - 64; v[z] = pwr[(15 - s) * 64 + n] * bbi[n * 16 + p] + pwi[(15 - s) * 64 + n] * bbr[n * 16 + p]; }
                    else v[z] = 0.f; }
                *(unsigned*)(BtX + (size_t)rr * 256 + k2) = cvt_pk_bf16(v[0], v[1]); }
            __syncthreads();
        }
        {
            LAS float* scr = (LAS float*)(lds + wave * 16384);
            constexpr int I_DQ_ = 32 * 16, I_DKV_ = 32 * 10, I_UQ_ = 8 * 96, I_UKV_ = 4 * 128, I_O_ = 32 * 64, I_MLA_ = I_DQ_ + I_DKV_ + I_UQ_ + I_UKV_ + I_O_;
            constexpr int I_GL_ = 32 * 64, I_S5_ = 2 * I_GL_;
            constexpr int I_FG_ = 32 * 176, I_FD_ = 88 * 64, I_FFN_ = 2 * I_FG_ + I_FD_;
            constexpr int NIT = 2 * I_MLA_ + 2 * I_S5_ + 4 * I_FFN_;
            for (int it = gw; it < NIT; it += NGW) {
                int r = it;
                if (r < 2 * I_MLA_) { const int i = r / I_MLA_; r -= i * I_MLA_; unsigned char* wb = ws + WS_MLA + i * WSZ_MLA;
                    if (r < I_DQ_) { transpose_item(args.in[I_WDQ] + (size_t)i * DM * QLORA, DM, QLORA, (bf16_t*)wb, 0, 0, scr, r, lane); continue; } r -= I_DQ_;
                    if (r < I_DKV_) { transpose_item(args.in[I_WDKV] + (size_t)i * DM * 320, DM, 320, (bf16_t*)wb, 512, 0, scr, r, lane); continue; } r -= I_DKV_;
                    if (r < I_UQ_) { transpose_item(args.in[I_WUQ] + (size_t)i * QLORA * 3072, QLORA, 3072, (bf16_t*)(wb + WSZ_DQKV), 0, 0, scr, r, lane, 1.0f, args.in[I_GQA] + i * QLORA); continue; }     r -= I_UQ_;
                    if (r < I_UKV_) { transpose_item(args.in[I_WUKV] + (size_t)i * KVLORA * 4096, KVLORA, 4096, (bf16_t*)(wb + WSZ_DQKV + WSZ_UQ), 0, 0, scr, r, lane); continue; } r -= I_UKV_;
                    transpose_item(args.in[I_WO] + (size_t)i * DM * DM, DM, DM, (bf16_t*)(wb + WSZ_DQKV + WSZ_UQ + WSZ_UKV), 0, 0, scr, r, lane); continue; }
                r -= 2 * I_MLA_;
                if (r < 2 * I_S5_) { const int i = r / I_S5_; r -= i * I_S5_; bf16_t* wb = (bf16_t*)(ws + WS_S5 + i * WSZ_S5);
                    if (r < I_GL_) { transpose_item(args.in[I_WGLU] + (size_t)i * DM * DM, DM, DM, wb, 0, 1, scr, r, lane); continue; } r -= I_GL_;
                    transpose_item(args.in[I_WSG] + (size_t)i * DM * DM, DM, DM, wb, 0, 2, scr, r, lane); continue; }
                r -= 2 * I_S5_;
                { const int l = r / I_FFN_; r -= l * I_FFN_; unsigned char* wb = ws + WS_FFN + l * WSZ_FFN;
                    if (r < I_FG_) { transpose_item(args.in[I_FG] + (size_t)l * DM * DFF, DM, DFF, (bf16_t*)wb, 0, 1, scr, r, lane); continue; } r -= I_FG_;
                    if (r < I_FG_) { transpose_item(args.in[I_FU] + (size_t)l * DM * DFF, DM, DFF, (bf16_t*)wb, 0, 2, scr, r, lane); continue; } r -= I_FG_;
                    transpose_item(args.in[I_FD] + (size_t)l * DFF * DM, DFF, DM, (bf16_t*)(wb + 2 * WSZ_FF1), 0, 3, scr, r, lane, -0.6931471805599453f); }
            }
            for (int i = 0; i < 2; ++i) { u32x4* z = (u32x4*)(ws + WS_MLA + i * WSZ_MLA + (size_t)832 * DM * 2);
                for (int e = gw * 64 + lane; e < 192 * DM * 2 / 16; e += NGW * 64) z[e] = (u32x4){0u, 0u, 0u, 0u}; }
        }
    }
#endif
    PH_END

    for (int l = 0; l < 4; ++l) {
        const int li = l >> 1;
#define modl (MOD + (size_t)l * NSLOT * 12288)

#define NCOL(jj) (8 * lane + 512 * ((jj) >> 1) + 4 * ((jj) & 1))
#define NORM_STORE(V, ROW, RR16) do { \
                _Pragma("unroll") for (int j = 0; j < 4; ++j) { const f32x4 h0 = V[2 * j] * rstd * mul[2 * j] + add[2 * j], h1 = V[2 * j + 1] * rstd * mul[2 * j + 1] + add[2 * j + 1]; const u32x4 w = pg8::pack8(h0, h1); \
                    if (MODE_ == 0) *(u32x4*)(Hb + (size_t)(ROW) * DM + 8 * lane + 512 * j) = w; \
                    else { const int c = ((ROW) >> 4); *(u32x4*)(UP + ((size_t)((lane >> 1) + 32 * j) * NSUB + c) * 384 + (RR16) * 16 + 8 * (lane & 1)) = w; } } } while (0)
#define NORM_STAGE(V, RR16) do { \
                _Pragma("unroll") for (int j = 0; j < 4; ++j) { const f32x4 h0 = V[2 * j] * rstd * mul[2 * j] + add[2 * j], h1 = V[2 * j + 1] * rstd * mul[2 * j + 1] + add[2 * j + 1]; \
                    *(LAS u32x4*)(lds + wave * 16384 + ((RR16) & 3) * 4096 + 16 * lane + 1024 * j) = pg8::pack8(h0, h1); } } while (0)
#define NORM_FLUSH(RR4) do { asm volatile("s_waitcnt lgkmcnt(0)" ::: "memory"); const int t_ = lane >> 4, gl_ = (lane >> 1) & 7, h_ = lane & 1; \
                _Pragma("unroll") for (int i_ = 0; i_ < 16; ++i_) { const int g_ = 8 * i_ + gl_; const u32x4 w_ = *(const LAS u32x4*)(lds + wave * 16384 + t_ * 4096 + g_ * 32 + h_ * 16); \
                    *(u32x4*)(UP + ((size_t)g_ * NSUB + gw) * 384 + ((RR4) + t_) * 16 + 8 * h_) = w_; } \
                asm volatile("s_waitcnt lgkmcnt(0)" ::: "memory"); } while (0)
#define NORM_LOADP(MULADD_SLOT, GAIN, SHOFF, SCOFF) \
            f32x4 mul[8], add[8]; \
            _Pragma("unroll") for (int jj = 0; jj < 8; ++jj) { const int col = NCOL(jj); const f32x4 gg = *(const f32x4*)((GAIN) + col); const f32x4 scv = *(const f32x4*)(modl + (MULADD_SLOT) * 12288 + (SCOFF) + col); \
                add[jj] = *(const f32x4*)(modl + (MULADD_SLOT) * 12288 + (SHOFF) + col); mul[jj] = gg * (scv + 1.0f); }
#define LD8_BF16(V0, V1, P) do { const u32x4 w_ = *(const u32x4*)(P); V0 = (f32x4){bf_lo(w_[0]), bf_hi(w_[0]), bf_lo(w_[1]), bf_hi(w_[1])}; V1 = (f32x4){bf_lo(w_[2]), bf_hi(w_[2]), bf_lo(w_[3]), bf_hi(w_[3])}; } while (0)
#define NORM_ROWS(P32, S32, GAIN, SHOFF, SCOFF, MODE, NPART, PGATE, PMODE) do { constexpr int MODE_ = MODE; \
        { const int row0 = gw * 16; const int slot = slot_of_row(row0); \
            NORM_LOADP(slot, GAIN, SHOFF, SCOFF) \
            for (int rr = 0; rr < 16; rr += 2) { \
                f32x4 va[8], vb[8]; float sa = 0.f, sb = 0.f; \
                if (P32) { const float* xs = args.in[I_XP] + (size_t)(row0 + rr) * DM; \
                    _Pragma("unroll") for (int jj = 0; jj < 8; ++jj) { va[jj] = *(const f32x4*)(xs + NCOL(jj)); vb[jj] = *(const f32x4*)(xs + DM + NCOL(jj)); } } \
                else { const bf16_t* xh = XBs + (size_t)(row0 + rr) * DM + 8 * lane; \
                    _Pragma("unroll") for (int j = 0; j < 4; ++j) { LD8_BF16(va[2 * j], va[2 * j + 1], xh + 512 * j); LD8_BF16(vb[2 * j], vb[2 * j + 1], xh + DM + 512 * j); } } \
                _Pragma("unroll") for (int jj = 0; jj < 8; ++jj) { sa += (va[jj].x * va[jj].x + va[jj].y * va[jj].y) + (va[jj].z * va[jj].z + va[jj].w * va[jj].w); sb += (vb[jj].x * vb[jj].x + vb[jj].y * vb[jj].y) + (vb[jj].z * vb[jj].z + vb[jj].w * vb[jj].w); } \
                sa = wave_sum(sa, lane); sb = wave_sum(sb, lane); \
                { const float rstd = 1.0f / sqrtf(sa * (1.0f / DM) + EPS); if (MODE_ == 1) NORM_STAGE(va, rr); else NORM_STORE(va, row0 + rr, rr); } \
                { const float rstd = 1.0f / sqrtf(sb * (1.0f / DM) + EPS); if (MODE_ == 1) NORM_STAGE(vb, rr + 1); else NORM_STORE(vb, row0 + rr + 1, rr + 1); } \
                if (MODE_ == 1 && (rr & 2)) NORM_FLUSH(rr & ~3); } } \
        if (gw < 512) { const int row = NPROMPT + gw; const int slot = 4 + (gw >> 6); const int np_ = (NPART); \
              \
            f32x4 v[8]; float ss = 0.f; \
            if (S32) { _Pragma("unroll") for (int jj = 0; jj < 8; ++jj) v[jj] = *(const f32x4*)(args.in[I_XS] + (size_t)gw * DM + NCOL(jj)); } \
            else { const bf16_t* xh = XBs + (size_t)row * DM + 8 * lane; u32x4 xr_[4]; _Pragma("unroll") for (int j = 0; j < 4; ++j) xr_[j] = *(const u32x4*)(xh + 512 * j); asm volatile("" ::: "memory"); \
                _Pragma("unroll") for (int j = 0; j < 4; ++j) { v[2 * j] = (f32x4){bf_lo(xr_[j][0]), bf_hi(xr_[j][0]), bf_lo(xr_[j][1]), bf_hi(xr_[j][1])}; v[2 * j + 1] = (f32x4){bf_lo(xr_[j][2]), bf_hi(xr_[j][2]), bf_lo(xr_[j][3]), bf_hi(xr_[j][3])}; } } \
            if (np_ > 0) { const int pm_ = (PMODE); \
                f32x4 sp[8]; _Pragma("unroll") for (int jj = 0; jj < 8; ++jj) sp[jj] = (f32x4){0.f, 0.f, 0.f, 0.f}; \
                if (pm_ == 0) { \
                    for (int ks = 0; ks < np_; ++ks) { f32x4 t_[8]; _Pragma("unroll") for (int jj = 0; jj < 8; ++jj) t_[jj] = *(const f32x4*)(PART + ((size_t)ks * 512 + gw) * DM + NCOL(jj)); asm volatile("" ::: "memory"); \
                        _Pragma("unroll") for (int jj = 0; jj < 8; ++jj) sp[jj] += t_[jj]; } \
                } else { \
                    _Pragma("unroll") for (int h_ = 0; h_ < 2; ++h_) { f32x4 sg[4]; _Pragma("unroll") for (int q = 0; q < 4; ++q) sg[q] = (f32x4){0.f, 0.f, 0.f, 0.f}; \
                        for (int ks = 0; ks < np_; ++ks) { f32x4 t_[4], u_[4]; \
                            _Pragma("unroll") for (int q = 0; q < 4; ++q) { const int col = NCOL(4 * h_ + q); const float* pp = PART + ((size_t)ks * 512 + gw) * 4096 + (col >> 7) * 256 + (col & 127); t_[q] = *(const f32x4*)pp; u_[q] = *(const f32x4*)(pp + 128); } \
                            asm volatile("" ::: "memory"); \
                            _Pragma("unroll") for (int q = 0; q < 4; ++q) { sp[4 * h_ + q] += t_[q]; sg[q] += u_[q]; } } \
                        _Pragma("unroll") for (int q = 0; q < 4; ++q) _Pragma("unroll") for (int e = 0; e < 4; ++e) sp[4 * h_ + q][e] *= fast_sigmoid(sg[q][e]); } } \
                { f32x4 gt_[8]; _Pragma("unroll") for (int jj = 0; jj < 8; ++jj) gt_[jj] = *(const f32x4*)((PGATE) + (size_t)slot * 12288 + NCOL(jj)); asm volatile("" ::: "memory"); \
                  _Pragma("unroll") for (int jj = 0; jj < 8; ++jj) v[jj] += gt_[jj] * sp[jj]; } \
                _Pragma("unroll") for (int j = 0; j < 4; ++j) { const u32x4 w_ = pg8::pack8(v[2 * j], v[2 * j + 1]); *(u32x4*)(XBs + (size_t)row * DM + 8 * lane + 512 * j) = w_;     \
                    v[2 * j] = (f32x4){bf_lo(w_[0]), bf_hi(w_[0]), bf_lo(w_[1]), bf_hi(w_[1])}; v[2 * j + 1] = (f32x4){bf_lo(w_[2]), bf_hi(w_[2]), bf_lo(w_[3]), bf_hi(w_[3])}; } } \
            _Pragma("unroll") for (int jj = 0; jj < 8; ++jj) ss += (v[jj].x * v[jj].x + v[jj].y * v[jj].y) + (v[jj].z * v[jj].z + v[jj].w * v[jj].w); \
            const float rstd = 1.0f / sqrtf(wave_sum(ss, lane) * (1.0f / DM) + EPS); \
            NORM_LOADP(slot, GAIN, SHOFF, SCOFF) \
            NORM_STORE(v, row, row & 15); } } while (0)
#define PREV_GATE_F (MOD + (size_t)(l - 1) * NSLOT * 12288 + 10240)

        if ((l & 1) == 0) {
#define wb (ws + WS_MLA + li * WSZ_MLA)
            PH_BEGIN
#ifndef NO_A0
            NORM_ROWS(l == 0, l == 0, args.in[I_GMIX] + l * DM, 0, 2048, 0, (l > 0 ? 11 : 0), PREV_GATE_F, 0);
#endif
            PH_END
            PH_BEGIN
#ifndef NO_A1
            { pg8::Gemm g = pg8::gemm_rm(Hb, (const bf16_t*)wb, DM, DM, DM); pg8::StaticOrder S; S.init(128, 4, G, bx); pg8::EpiA1 E{QKVA, QA, STATQ};
              pg8::gemm_phase<pg8::EpiA1, pg8::StaticOrder, true>(lds, g, S, E, tid); }
            { pg8::Gemm g = pg8::gemm_rm(Hb, (const bf16_t*)wb, DM, DM, 512); pg8::SplitOrder S{bx, 4, 4, (size_t)1024}; pg8::EpiPartial E{PART, 1024};
              pg8::gemm_phase<pg8::EpiPartial, pg8::SplitOrder, true>(lds, g, S, E, tid); }
#endif
            PH_END
            PH_BEGIN
#ifndef NO_A2
            {
                const float* gqa = args.in[I_GQA] + li * QLORA; const float* gkva = args.in[I_GKVA] + li * KVLORA; const float* gkn = args.in[I_GKN] + li * DQK;
                const f32x4 gk_ = *(const f32x4*)(gkva + 4 * lane); const f32x4 gr_ = (lane < 16) ? *(const f32x4*)(gkn + 128 + 4 * lane) : (f32x4){0.f, 0.f, 0.f, 0.f};
                for (int it = gw; it < NTOK + 8 * PAST; it += NGW) {
                    int kvrow, pos; f32x4 kr = (f32x4){0.f, 0.f, 0.f, 0.f};
                    if (it < NTOK) {
                        const int row = it;
                        f32x4 v[4];
                        const bool pr = row < NPROMPT;
                        if (pr) { const float* src = QKVA + (size_t)row * 1024;
                            v[0] = v[1] = (f32x4){0.f, 0.f, 0.f, 0.f};
#pragma unroll
                            for (int j = 2; j < 4; ++j) v[j] = *(const f32x4*)(src + 4 * lane + 256 * j); }
                        else { const float* src = PART + (size_t)(row - NPROMPT) * 1024;
#pragma unroll
                            for (int j = 0; j < 4; ++j) v[j] = (*(const f32x4*)(src + 4 * lane + 256 * j) + *(const f32x4*)(src + 512 * 1024 + 4 * lane + 256 * j)) + (*(const f32x4*)(src + 2 * 512 * 1024 + 4 * lane + 256 * j) + *(const f32x4*)(src + 3 * 512 * 1024 + 4 * lane + 256 * j)); }
                        float sq = 0.f, sk = 0.f;
#pragma unroll
                        for (int j = 0; j < 2; ++j) sq += (v[j].x * v[j].x + v[j].y * v[j].y) + (v[j].z * v[j].z + v[j].w * v[j].w);
                        if (pr) sq = lane < 8 ? STATQ[(size_t)row * 8 + lane] : 0.f;
                        sk = (v[2].x * v[2].x + v[2].y * v[2].y) + (v[2].z * v[2].z + v[2].w * v[2].w);
                        const float rq = 1.0f / sqrtf(wave_sum(sq, lane) * (1.0f / QLORA) + EPS), rk = 1.0f / sqrtf(wave_sum(sk, lane) * (1.0f / KVLORA) + EPS);
                        if (!pr) {
#pragma unroll
                            for (int j = 0; j < 2; ++j) { const f32x4 h = v[j] * rq; u32x2 w; w.x = cvt_pk_bf16(h.x, h.y); w.y = cvt_pk_bf16(h.z, h.w);
                                *(u32x2*)(QA + (size_t)row * QLORA + 4 * lane + 256 * j) = w; } }
                        if (lane == 0) RSTDQ[row] = pr ? rq : 1.0f;
                        const f32x4 ck = v[2] * rk * gk_;
                        int t;
                        if (row < NPROMPT) { kvrow = row; t = row & (SEQ - 1); pos = t; const int b = row >> 13;
                            *(f32x4*)(out + O_CKVP + ((size_t)(li * 4 + b) * SEQ + t) * KVLORA + 4 * lane) = ck;
                            if (lane < 16) *(f32x4*)(out + O_KRP + ((size_t)(li * 4 + b) * SEQ + t) * 64 + 4 * lane) = v[3]; }
                        else { const int r2 = row - NPROMPT, b = r2 >> 6; t = r2 & 63; kvrow = NPROMPT + b * SKV + PAST + t; pos = PAST + t;
                            *(f32x4*)(out + O_CKVS + ((size_t)(li * 8 + b) * DSEQ + t) * KVLORA + 4 * lane) = ck;
                            if (lane < 16) *(f32x4*)(out + O_KRS + ((size_t)(li * 8 + b) * DSEQ + t) * 64 + 4 * lane) = v[3]; }
                        u32x2 w; w.x = cvt_pk_bf16(ck.x, ck.y); w.y = cvt_pk_bf16(ck.z, ck.w); *(u32x2*)(CKV + (size_t)kvrow * KVLORA + 4 * lane) = w;
                        kr = v[3];
                    } else {
                        const int c2 = it - NTOK, b = c2 >> 12, p = c2 & (PAST - 1); kvrow = NPROMPT + b * SKV + p; pos = p;
                        const f32x4 ck = *(const f32x4*)(args.in[I_CCKV] + ((size_t)(li * 8 + b) * PAST + p) * KVLORA + 4 * lane);
                        u32x2 w; w.x = cvt_pk_bf16(ck.x, ck.y); w.y = cvt_pk_bf16(ck.z, ck.w); *(u32x2*)(CKV + (size_t)kvrow * KVLORA + 4 * lane) = w;
                        if (lane < 16) kr = *(const f32x4*)(args.in[I_CKR] + ((size_t)(li * 8 + b) * PAST + p) * 64 + 4 * lane);
                    }
                    f32x4 cs01 = (f32x4){0.f, 0.f, 0.f, 0.f}, cs23 = cs01;
                    if (lane < 16) { const float* rp = ROPE + ((size_t)pos * 32 + 4 * (lane & 7)) * 2; cs01 = *(const f32x4*)rp; cs23 = *(const f32x4*)(rp + 4); }
                    float ssk = (lane < 16) ? (kr.x * kr.x + kr.y * kr.y) + (kr.z * kr.z + kr.w * kr.w) : 0.f;
                    ssk = sum16(ssk, lane);
                    const f32x4 kg = kr * gr_;
                    f32x4 other; other.x = dpp_rotf<0x128>(kg.x); other.y = dpp_rotf<0x128>(kg.y); other.z = dpp_rotf<0x128>(kg.z); other.w = dpp_rotf<0x128>(kg.w);
                    if (lane < 16) {
                        f32x4 o; const float cc_[4] = {cs01[0], cs01[2], cs23[0], cs23[2]}, sn_[4] = {cs01[1], cs01[3], cs23[1], cs23[3]};
#pragma unroll
                        for (int e = 0; e < 4; ++e) { const float c = cc_[e], s = sn_[e];
                            o[e] = (lane < 8) ? kg[e] * c - other[e] * s : other[e] * s + kg[e] * c; }
                        *(f32x4*)(Rr + (size_t)kvrow * 64 + 4 * lane) = o;
                        if (lane == 0) KRSS[kvrow] = ssk;
                    }
                }
            }
#endif
            PH_END
            PH_BEGIN
#ifndef NO_A3
            { pg8::Gemm g = pg8::gemm_rm(QA, (const bf16_t*)(wb + WSZ_DQKV), QLORA, QLORA, QLORA); pg8::StaticOrder S; S.init(NTOK / 256, 12, G, bx); pg8::EpiBf16 E{Qb, 3072, RSTDQ};
              pg8::gemm_phase<pg8::EpiBf16, pg8::StaticOrder, true>(lds, g, S, E, tid); }
            { pg8::Gemm g = pg8::gemm_rm(CKV, (const bf16_t*)(wb + WSZ_DQKV + WSZ_UQ), KVLORA, KVLORA, KVLORA); pg8::StaticOrder S; S.init(NKV / 256, 16, G, (G % 8 == 0 && G > 64) ? (bx + 32) % G : bx);     pg8::EpiKV E{KB, KRSS, Rr, args.in[I_GKN] + li * DQK, (LAS float*)(lds + MISC_OFF + 1024)};
              pg8::gemm_phase<pg8::EpiKV, pg8::StaticOrder, true>(lds, g, S, E, tid); }
#endif
            PH_END
            PH_BEGIN
#ifndef NO_A5
            {
                bool fx_ok;
                { float gq = 0.f, gk = 0.f;
                  for (int e = lane; e < DQK; e += 64) { gq = fmaxf(gq, fabsf(args.in[I_GQN][li * DQK + e])); gk = fmaxf(gk, fabsf(args.in[I_GKN][li * DQK + e])); }
#pragma unroll
                  for (int o_ = 1; o_ < 64; o_ <<= 1) { gq = fmaxf(gq, shx(gq, o_, lane)); gk = fmaxf(gk, shx(gk, o_, lane)); }
                  fx_ok = __builtin_amdgcn_readfirstlane(__float_as_int(gq * gk * (1.4427f * 13.8564f * 1.03f))) < __float_as_int(60.0f); }
                const int nun = ((vcu & 1) == 0) ? 9 : 8;
                for (int un = 0; un < nun; ++un) {
                    const bf16_t* q_; const bf16_t* k_; const bf16_t* v_; bf16_t* o_; int NT_, NTr_, nv_, wq_, pos0_, rev_;
                    if (un < 8) { const int x = vcu >> 5, i = vcu & 31; const int bh = x * 8 + (un >> 1) * 2 + (un & 1), b = bh >> 4, h = bh & 15; const int qb = (un & 1) == 0 ? i : ((un >> 1) < 2 ? 31 - (i ^ 1) : 31 - i);     const size_t qrow = (size_t)b * SEQ + 256 * qb;
                        q_ = Qb + qrow * 3072 + h * DQK; k_ = KB + (size_t)b * SEQ * 5120 + h * 320; v_ = k_ + 192; o_ = Hb + qrow * DM + h * 128;
                        NT_ = 4 * (qb + 1); NTr_ = NT_; nv_ = 4 * qb + (wave >> 1) + 1; wq_ = wave; pos0_ = 256 * qb; rev_ = un & 1; }
                    else { const int su = vcu >> 1, b = su >> 4, h = su & 15; const size_t qrow = NPROMPT + (size_t)b * DSEQ, kvr = NPROMPT + (size_t)b * SKV;
                        q_ = Qb + qrow * 3072 + h * DQK; k_ = KB + kvr * 5120 + h * 320; v_ = k_ + 192; o_ = Hb + qrow * DM + h * 128;
                        NT_ = 66; NTr_ = 65; nv_ = wave < 2 ? 65 : 0; wq_ = wave & 1; pos0_ = PAST; rev_ = 0; }
                    if (fx_ok) att::attn_unit<true>(q_, k_, v_, o_, NT_, NTr_, nv_, wq_, rev_, (LAS char*)lds, tid, args.in[I_GQN] + li * DQK, ROPE, pos0_);
                    else att::attn_unit<false>(q_, k_, v_, o_, NT_, NTr_, nv_, wq_, rev_, (LAS char*)lds, tid, args.in[I_GQN] + li * DQK, ROPE, pos0_);
                }
            }
#endif
            PH_END
            PH_BEGIN
#ifndef NO_A6
            { pg8::Gemm g = pg8::gemm_rm(Hb, (const bf16_t*)(wb + WSZ_DQKV + WSZ_UQ + WSZ_UKV), DM, DM, DM); pg8::StaticOrder S; S.init(128, 8, G, bx); pg8::EpiResid E{args.in[I_XP], out, XBs, modl + 4096, (l == 0) ? 1 : 0, 0};
              pg8::gemm_phase<pg8::EpiResid, pg8::StaticOrder, true>(lds, g, S, E, tid); }
            { pg8::Gemm g = pg8::gemm_rm(Hb, (const bf16_t*)(wb + WSZ_DQKV + WSZ_UQ + WSZ_UKV), DM, DM, 512); pg8::SplitOrder S{bx, 8, 4, (size_t)1024}; pg8::EpiPartial E{PART, DM};
              pg8::gemm_phase<pg8::EpiPartial, pg8::SplitOrder, true>(lds, g, S, E, tid); }
#endif
            PH_END
        } else {
#undef wb
#define wb (ws + WS_S5 + li * WSZ_S5)
            PH_BEGIN
#ifndef NO_S0
            NORM_ROWS(false, false, args.in[I_GMIX] + l * DM, 0, 2048, 1, 11, PREV_GATE_F, 0);
#endif
            PH_END
            PH_BEGIN
#ifndef NO_S1
            { pg8::Gemm g = pg8::gemm_rm(UP, (const bf16_t*)(wb + WSZ_GG + WSZ_BTY), 384, 256, 256); pg8::GroupOrder S{G, bx}; pg8::EpiXloc E{XLOC};
              pg8::gemm_phase<pg8::EpiXloc, pg8::GroupOrder, true>(lds, g, S, E, tid); }
#endif
            PH_END
            PH_BEGIN
#ifndef NO_S2
            {
                for (int it = gw; it < NSLOT * NGRP; it += NGW) {
                    const int slot = it >> 7, g = it & 127, n = lane;
                    const float ar = A16[((li * NGRP + g) * 64 + n) * 2], ai = A16[((li * NGRP + g) * 64 + n) * 2 + 1];
                    float xr = 0.f, xi = 0.f; int c0, nc;
                    if (slot < 4) { c0 = slot * 512; nc = 512; }
                    else { const int b = slot - 4; c0 = 2048 + 4 * b; nc = 4; xr = args.in[I_SRE][((size_t)(li * 8 + b) * NGRP + g) * 64 + n]; xi = args.in[I_SIM][((size_t)(li * 8 + b) * NGRP + g) * 64 + n]; }
                    const bf16_t* xl = XLOC + ((size_t)g * NSUB + c0) * 128; bf16_t* up = UP + ((size_t)g * NSUB + c0) * 384 + 256;
#define S2_STEP(LR, LI, Q) do { const unsigned pk = cvt_pk_bf16(xr, xi); up[(size_t)(c + (Q)) * 384 + n] = (bf16_t)(pk & 0xffffu); up[(size_t)(c + (Q)) * 384 + 64 + n] = (bf16_t)(pk >> 16); \
                            const float nr = ar * xr - ai * xi + (LR), ni = ar * xi + ai * xr + (LI); xr = nr; xi = ni; } while (0)
                    if (nc == 4) { const int c = 0; float lr[4], lim[4];
#pragma unroll
                        for (int q = 0; q < 4; ++q) { lr[q] = bf_lo((unsigned)xl[(size_t)q * 128 + n]); lim[q] = bf_lo((unsigned)xl[(size_t)q * 128 + 64 + n]); }
#pragma unroll
                        for (int q = 0; q < 4; ++q) S2_STEP(lr[q], lim[q], q);
                    } else {
                        float lr[16], lim[16];
#pragma unroll
                        for (int q = 0; q < 16; ++q) { lr[q] = bf_lo((unsigned)xl[(size_t)q * 128 + n]); lim[q] = bf_lo((unsigned)xl[(size_t)q * 128 + 64 + n]); }
                        for (int c = 0; c < nc; c += 16) {
                            float nr_[16], ni_[16]; const int cn = c + 16 < nc ? c + 16 : c;
#pragma unroll
                            for (int q = 0; q < 16; ++q) { nr_[q] = bf_lo((unsigned)xl[(size_t)(cn + q) * 128 + n]); ni_[q] = bf_lo((unsigned)xl[(size_t)(cn + q) * 128 + 64 + n]); }
#pragma unroll
                            for (int q = 0; q < 16; ++q) S2_STEP(lr[q], lim[q], q);
#pragma unroll
                            for (int q = 0; q < 16; ++q) { lr[q] = nr_[q]; lim[q] = ni_[q]; }
                        }
                    }
#undef S2_STEP
                    if (slot < 4) { out[O_REP + ((size_t)(li * 4 + slot) * NGRP + g) * 64 + n] = xr; out[O_IMP + ((size_t)(li * 4 + slot) * NGRP + g) * 64 + n] = xi; }
                    else { out[O_RES + ((size_t)(li * 8 + slot - 4) * NGRP + g) * 64 + n] = xr; out[O_IMS + ((size_t)(li * 8 + slot - 4) * NGRP + g) * 64 + n] = xi; }
                }
            }
#endif
            PH_END
            PH_BEGIN
#ifndef NO_S3
            { pg8::Gemm g = pg8::gemm_rm(UP, (const bf16_t*)(wb + WSZ_GG), 384, 384, 384); pg8::GroupOrder S{G, bx}; pg8::EpiY E{UP, Hb, args.in[I_SD] + li * DM};
              pg8::gemm_phase<pg8::EpiY, pg8::GroupOrder, true>(lds, g, S, E, tid); }
#endif
            PH_END
            PH_BEGIN
#ifndef NO_S4
            { pg8::Gemm g = pg8::gemm_rm(Hb, (const bf16_t*)wb, DM, DM, DM); pg8::StaticOrder S; S.init(128, 16, G, bx); pg8::EpiGlu E{XBs, modl + 4096};
              pg8::gemm_phase<pg8::EpiGlu, pg8::StaticOrder, true>(lds, g, S, E, tid); }
            { pg8::Gemm g = pg8::gemm_rm(Hb, (const bf16_t*)wb, DM, DM, 512); pg8::SplitOrder S{bx, 16, 4, (size_t)1024}; pg8::EpiPartial E{PART, 4096};
              pg8::gemm_phase<pg8::EpiPartial, pg8::SplitOrder, true>(lds, g, S, E, tid); }
#endif
            PH_END
        }
        {
#undef wb
#define wb (ws + WS_FFN + l * WSZ_FFN)
            PH_BEGIN
#ifndef NO_F0
            NORM_ROWS(false, l == 0, args.in[I_GFFN] + l * DM, 6144, 8192, 0, 4, modl + 4096, (l & 1));
#endif
            PH_END
            PH_BEGIN
#ifndef NO_F1
            { pg8::Gemm g = pg8::gemm_rm(Hb, (const bf16_t*)wb, DM, DM, DM); pg8::StaticOrder S; S.init(128, 44, G, bx);
              pg8::EpiFfn E{HID, args.in[I_FCW] + (size_t)l * 3 * DFF, args.in[I_FCB] + (size_t)l * DFF, out + O_CONVP + (size_t)l * 4 * 2 * DFF, GBND, DEFC, DEFU, (LAS float*)(lds + MISC_OFF + 1024)};
              pg8::gemm_phase<pg8::EpiFfn, pg8::StaticOrder, true>(lds, g, S, E, tid); }
            { pg8::Gemm g = pg8::gemm_rm(Hb, (const bf16_t*)wb, DM, DM, 1024); pg8::SplitOrder S{bx, 44, 2, (size_t)2048}; pg8::EpiPartial E{PGU, 2 * DFF};
              pg8::gemm_phase<pg8::EpiPartial, pg8::SplitOrder, true>(lds, g, S, E, tid); }
#endif
            PH_END
            PH_BEGIN
#ifndef NO_F2
            for (int it = gw; it < 512 * 22; it += NGW) { const int r = it / 22, c = (it - r * 22) * 256 + 4 * lane; const int b = r >> 6, t = r & 63;
                const float* cwp = args.in[I_FCW] + (size_t)l * 3 * DFF + c; const f32x4 w0 = *(const f32x4*)cwp, w1 = *(const f32x4*)(cwp + DFF), w2 = *(const f32x4*)(cwp + 2 * DFF), cbv = *(const f32x4*)(args.in[I_FCB] + (size_t)l * DFF + c);
                const float* pg = PGU + (size_t)r * (2 * DFF) + (c >> 7) * 256 + (c & 127); const size_t ps = (size_t)512 * 2 * DFF;
                const float* cc = args.in[I_CCONV] + ((size_t)(l * 8 + b) * 2) * DFF + c;
                const f32x4 g2 = *(const f32x4*)pg + *(const f32x4*)(pg + ps);
                const f32x4 g1 = t >= 1 ? *(const f32x4*)(pg - 2 * DFF) + *(const f32x4*)(pg - 2 * DFF + ps) : *(const f32x4*)(cc + DFF);
                const f32x4 g0 = t >= 2 ? *(const f32x4*)(pg - 4 * DFF) + *(const f32x4*)(pg - 4 * DFF + ps) : *(const f32x4*)(cc + (t == 1 ? DFF : 0));
                const f32x4 uu = *(const f32x4*)(pg + 128) + *(const f32x4*)(pg + 128 + ps);
                f32x4 h;
#pragma unroll
                for (int e = 0; e < 4; ++e) { const float gc = cbv[e] + w0[e] * g0[e] + w1[e] * g1[e] + w2[e] * g2[e]; h[e] = -1.4426950408889634f * (gc * fast_sigmoid(gc) * uu[e]); }
                u32x2 w; w.x = cvt_pk_bf16(h[0], h[1]); w.y = cvt_pk_bf16(h[2], h[3]);
                *(u32x2*)(HID + pg8::tiled_off(NPROMPT + r, c, DFF / 64)) = w;
                if (t >= DSEQ - 2) *(f32x4*)(out + O_CONVS + ((size_t)(l * 8 + b) * 2 + (t - (DSEQ - 2))) * DFF + c) = g2; }
            for (int it = gw * 64 + lane; it < 128 * 2 * (DFF / 4); it += NGW * 64) { const int pm = it / (2 * (DFF / 4)), rem = it - pm * (2 * (DFF / 4)), rr = rem / (DFF / 4), c = (rem - rr * (DFF / 4)) * 4;
                if ((pm & 31) == 0) continue;
                const float* cwp = args.in[I_FCW] + (size_t)l * 3 * DFF + c; const f32x4 w0 = *(const f32x4*)cwp, w1 = *(const f32x4*)(cwp + DFF);
                const f32x4 p254 = *(const f32x4*)(GBND + (size_t)((pm - 1) * 2) * DFF + c), p255 = *(const f32x4*)(GBND + (size_t)((pm - 1) * 2 + 1) * DFF + c);
                const f32x4 cp = *(const f32x4*)(DEFC + (size_t)(pm * 2 + rr) * DFF + c), uu = *(const f32x4*)(DEFU + (size_t)(pm * 2 + rr) * DFF + c);
                f32x4 h;
#pragma unroll
                for (int e = 0; e < 4; ++e) { const float gc = rr == 0 ? cp[e] + -1.4426950408889634f * (w0[e] * p254[e] + w1[e] * p255[e]) : cp[e] + -1.4426950408889634f * (w0[e] * p255[e]); h[e] = gc * __builtin_amdgcn_rcpf(1.0f + __builtin_amdgcn_exp2f(gc)) * uu[e]; }
                u32x2 w; w.x = cvt_pk_bf16(h[0], h[1]); w.y = cvt_pk_bf16(h[2], h[3]);
                *(u32x2*)(HID + pg8::tiled_off(pm * 256 + rr, c, DFF / 64)) = w; }
#endif
            PH_END
            PH_BEGIN
#ifndef NO_F3
            { pg8::Gemm g{HID, (const bf16_t*)(wb + 2 * WSZ_FF1), 64, 64, DFF, 32768, 32768, (size_t)88 * 32768, (size_t)88 * 32768};
              pg8::StaticOrder S; S.init(128, 8, G, bx); pg8::EpiResid E{args.in[I_XP], out, XBs, modl + 10240, 0, (l == 3) ? 1 : 0};
              pg8::gemm_phase<pg8::EpiResid, pg8::StaticOrder, true>(lds, g, S, E, tid); }
            { pg8::Gemm g{HID, (const bf16_t*)(wb + 2 * WSZ_FF1), 64, 64, 512, 32768, 32768, (size_t)88 * 32768, (size_t)88 * 32768};
              pg8::SplitOrder S{bx, 8, 11, (size_t)8 * 32768}; pg8::EpiPartial E{PART, DM};
              pg8::gemm_phase<pg8::EpiPartial, pg8::SplitOrder, true>(lds, g, S, E, tid); }
#endif
            PH_END
        }
    }
    PH_BEGIN
    if (gw < 512) { const int row = NPROMPT + gw; const int slot = 4 + (gw >> 6); const float* pg = MOD + (size_t)(3 * NSLOT + slot) * 12288 + 10240;
        f32x4 sp[8];
#pragma unroll
        for (int j = 0; j < 8; ++j) sp[j] = (f32x4){0.f, 0.f, 0.f, 0.f};
        u32x2 xw[8]; f32x4 gq[8];
#pragma unroll
        for (int j = 0; j < 8; ++j) { xw[j] = *(const u32x2*)(XBs + (size_t)row * DM + 4 * lane + 256 * j); gq[j] = *(const f32x4*)(pg + 4 * lane + 256 * j); }
        for (int ks = 0; ks < 11; ++ks) { f32x4 t_[8];
#pragma unroll
            for (int j = 0; j < 8; ++j) t_[j] = *(const f32x4*)(PART + ((size_t)ks * 512 + gw) * DM + 4 * lane + 256 * j);
            asm volatile("" ::: "memory");
#pragma unroll
            for (int j = 0; j < 8; ++j) sp[j] += t_[j]; }
#pragma unroll
        for (int j = 0; j < 8; ++j) { const f32x4 xv = (f32x4){bf_lo(xw[j].x), bf_hi(xw[j].x), bf_lo(xw[j].y), bf_hi(xw[j].y)};
            *(f32x4*)(out + (size_t)row * DM + 4 * lane + 256 * j) = xv + gq[j] * sp[j]; } }
    PH_END
#undef wb
#undef PH_BEGIN
#undef PH_END
}

constexpr int NPHASES = 1 + 2 * (6 + 4) + 2 * (5 + 4) + 1;

extern "C" void kernel_launch(void* const* d_in, const int* in_sizes, int n_in, void* d_out, int out_size, void* d_ws, size_t ws_size, hipStream_t stream) {
    static int grid = 0;
    if (grid == 0) {
        if (n_in != 37 || (size_t)out_size != O_END || ws_size < WS_END) { fprintf(stderr, "kernel_launch: unexpected shapes (n_in %d out %d ws %zu)\n", n_in, out_size, ws_size); grid = -1; return; }
        int dev = 0, cus = 0, per_cu = 0;
        if (hipGetDevice(&dev) != hipSuccess || hipDeviceGetAttribute(&cus, hipDeviceAttributeMultiprocessorCount, dev) != hipSuccess) { grid = -1; return; }
        if (hipFuncSetAttribute((const void*)fwd_kernel, hipFuncAttributeMaxDynamicSharedMemorySize, LDS_BYTES) != hipSuccess) { fprintf(stderr, "kernel_launch: hipFuncSetAttribute failed\n"); grid = -1; return; }
        if (hipOccupancyMaxActiveBlocksPerMultiprocessor(&per_cu, (const void*)fwd_kernel, NWAVES * 64, LDS_BYTES) != hipSuccess || per_cu < 1) { fprintf(stderr, "kernel_launch: occupancy query says %d\n", per_cu); }
        (void)hipGetLastError();
        grid = cus;
    }
    if (grid < 0) return;
    (void)hipMemsetAsync((char*)d_ws + WS_CTL, 0, CTL_ZERO_BYTES, stream);
    Args a{};
    for (int i = 0; i < 37; ++i) a.in[i] = (const float*)d_in[i];
    a.out = (float*)d_out; a.ws = (unsigned char*)d_ws;
#if MK_PER_PHASE
    for (int p = 0; p < NPHASES; ++p) { a.ph_lo = p; a.ph_hi = p + 1; hipLaunchKernelGGL(fwd_kernel, dim3(grid), dim3(NWAVES * 64), LDS_BYTES, stream, a); }
#else
    a.ph_lo = 0; a.ph_hi = NPHASES;
    hipLaunchKernelGGL(fwd_kernel, dim3(grid), dim3(NWAVES * 64), LDS_BYTES, stream, a);
#endif
    const hipError_t le = hipPeekAtLastError();
    if (le != hipSuccess) fprintf(stderr, "kernel_launch: launch failed: %s\n", hipGetErrorName(le));
}
```
